# Optimizing an MI355X kernel written in HIP

```python
import math
import jax, jax.numpy as jnp
from jax import lax
import numpy as np

D_MODEL = 1024
BATCH = 4
SEQ = 4096
DEPTH = 1

D_MIX = D_MODEL
D_CONV = D_MIX // 2
D_ATTN = D_MIX - D_CONV
CONV_WIDTH = 3
CONV_GROUPS = 8
HEAD_DIM = 64
V_DIM = 2 * HEAD_DIM
N_HEADS = D_ATTN // V_DIM
Q_WIDTH = N_HEADS * 2 * HEAD_DIM
D_IN = 3 * D_CONV + 2 * Q_WIDTH + N_HEADS * V_DIM
Q_BLOCK = 128
N_EXPERT_GROUPS = 4
EXPERTS_PER_GROUP = 8
TOP_K = 2
D_EXPERT = D_MODEL // 2
EPS = 1e-6

kernel_name = "hymba_conv_diffattn_hmoe_layer"


def rms_norm(x, g):
    xf = x.astype(jnp.float32)
    y = xf * lax.rsqrt(jnp.mean(xf * xf, axis=-1, keepdims=True) + EPS)
    return (y * g.astype(jnp.float32)).astype(x.dtype)


def lambda_init(layer_idx):
    return 0.8 - 0.6 * math.exp(-0.3 * layer_idx)


def causal_depthwise_conv(u, w):
    K = w.shape[0]
    S = u.shape[1]
    up = jnp.pad(u, ((0, 0), (K - 1, 0), (0, 0)))
    y = up[:, 0:S, :] * w[0]
    for k in range(1, K):
        y = y + up[:, k:k + S, :] * w[k]
    return y


def short_conv_group(xc, b_gate, c_gate, conv_w, conv_out_g):
    y = b_gate * causal_depthwise_conv(c_gate * xc, conv_w)
    Bsz, S, _ = y.shape
    yg = y.reshape(Bsz, S, CONV_GROUPS, D_CONV // CONV_GROUPS)
    yg = rms_norm(yg, jnp.ones((D_CONV // CONV_GROUPS,), y.dtype))
    return yg.reshape(Bsz, S, D_CONV) * conv_out_g.astype(y.dtype)


def diff_attention_group(q, k, v, q_norm_g, k_norm_g, lq1, lk1, lq2, lk2, subln_g, lam_init):
    Bsz, S, _ = q.shape
    q = rms_norm(q.reshape(Bsz, S, N_HEADS, 2, HEAD_DIM), q_norm_g) * (HEAD_DIM ** -0.5)
    k = rms_norm(k.reshape(Bsz, S, N_HEADS, 2, HEAD_DIM), k_norm_g)
    v = v.reshape(Bsz, S, N_HEADS, V_DIM)
    qT = q.transpose(0, 2, 3, 1, 4)
    kT = k.transpose(0, 2, 3, 1, 4)
    vT = v.transpose(0, 2, 1, 3)
    lam = (jnp.exp(jnp.sum(lq1.astype(jnp.float32) * lk1.astype(jnp.float32)))
           - jnp.exp(jnp.sum(lq2.astype(jnp.float32) * lk2.astype(jnp.float32)))
           + lam_init)
    key_pos = jnp.arange(S)
    n_blocks = S // Q_BLOCK

    def one_block(i):
        start = i * Q_BLOCK
        qb = lax.dynamic_slice_in_dim(qT, start, Q_BLOCK, axis=3)
        s = jnp.einsum('bhcqd,bhckd->bhcqk', qb, kT).astype(jnp.float32)
        q_pos = start + jnp.arange(Q_BLOCK)
        mask = key_pos[None, :] <= q_pos[:, None]
        s = jnp.where(mask, s, -jnp.inf)
        p = jax.nn.softmax(s, axis=-1)
        a = (p[:, :, 0] - lam * p[:, :, 1]).astype(vT.dtype)
        return jnp.einsum('bhqk,bhkv->bqhv', a, vT)

    out = lax.map(one_block, jnp.arange(n_blocks))
    out = out.transpose(1, 0, 2, 3, 4).reshape(Bsz, S, N_HEADS, V_DIM)
    out = rms_norm(out, subln_g) * (1.0 - lam_init)
    return out.reshape(Bsz, S, D_ATTN)


def hierarchical_moe(h, w_router_group, w_router_expert, w_gate, w_up, w_down):
    T = h.shape[0]
    G, E = N_EXPERT_GROUPS, EXPERTS_PER_GROUP
    p_group = jax.nn.softmax(jnp.einsum('td,dg->tg', h, w_router_group).astype(jnp.float32), axis=-1)
    g_idx = jnp.argmax(p_group, axis=-1)
    g_gate = jnp.max(p_group, axis=-1)
    logits_e = jnp.einsum('td,de->te', h, w_router_expert).astype(jnp.float32).reshape(T, G, E)
    logits_sel = jnp.take_along_axis(logits_e, g_idx[:, None, None], axis=1)[:, 0]
    top_vals, top_idx = lax.top_k(logits_sel, TOP_K)
    top_w = jax.nn.softmax(top_vals, axis=-1)
    exp_w = jnp.sum(jax.nn.one_hot(top_idx, E, dtype=jnp.float32) * top_w[..., None], axis=1)
    comb = (jax.nn.one_hot(g_idx, G, dtype=jnp.float32)[:, :, None]
            * exp_w[:, None, :] * g_gate[:, None, None]).astype(h.dtype)
    y = jnp.zeros_like(h)
    for g in range(G):
        hg = jnp.einsum('td,edf->tef', h, w_gate[g])
        hu = jnp.einsum('td,edf->tef', h, w_up[g])
        act = jax.nn.silu(hg) * hu * comb[:, g, :, None]
        y = y + jnp.einsum('tef,efd->td', act, w_down[g])
    return y


def setup_inputs(seed: int = 0) -> dict:
    key = jax.random.key(seed)
    ks = jax.random.split(key, 20)
    f32 = jnp.float32
    G, E, F = N_EXPERT_GROUPS, EXPERTS_PER_GROUP, D_EXPERT

    def nrm(k, shape, scale):
        return jax.random.normal(k, shape, f32) * scale

    return {
        "x": nrm(ks[0], (BATCH, SEQ, D_MODEL), 1.0),
        "attn_norm_g": 1.0 + nrm(ks[1], (DEPTH, D_MODEL), 0.02),
        "w_in": nrm(ks[2], (DEPTH, D_MODEL, D_IN), D_MODEL ** -0.5),
        "conv_w": nrm(ks[3], (DEPTH, CONV_WIDTH, D_CONV), CONV_WIDTH ** -0.5),
        "conv_out_g": 1.0 + nrm(ks[4], (DEPTH, D_CONV), 0.02),
        "q_norm_g": 1.0 + nrm(ks[5], (DEPTH, HEAD_DIM), 0.02),
        "k_norm_g": 1.0 + nrm(ks[6], (DEPTH, HEAD_DIM), 0.02),
        "lambda_q1": nrm(ks[7], (DEPTH, HEAD_DIM), 0.1),
        "lambda_k1": nrm(ks[8], (DEPTH, HEAD_DIM), 0.1),
        "lambda_q2": nrm(ks[9], (DEPTH, HEAD_DIM), 0.1),
        "lambda_k2": nrm(ks[10], (DEPTH, HEAD_DIM), 0.1),
        "attn_subln_g": 1.0 + nrm(ks[11], (DEPTH, V_DIM), 0.02),
        "w_out": nrm(ks[12], (DEPTH, D_MIX, D_MODEL), D_MIX ** -0.5),
        "ffn_norm_g": 1.0 + nrm(ks[13], (DEPTH, D_MODEL), 0.02),
        "w_router_group": nrm(ks[14], (DEPTH, D_MODEL, G), D_MODEL ** -0.5),
        "w_router_expert": nrm(ks[15], (DEPTH, D_MODEL, G * E), D_MODEL ** -0.5),
        "w_exp_gate": nrm(ks[16], (DEPTH, G, E, D_MODEL, F), D_MODEL ** -0.5),
        "w_exp_up": nrm(ks[17], (DEPTH, G, E, D_MODEL, F), D_MODEL ** -0.5),
        "w_exp_down": nrm(ks[18], (DEPTH, G, E, F, D_MODEL), F ** -0.5),
    }


def reference(x, attn_norm_g, w_in, conv_w, conv_out_g, q_norm_g, k_norm_g,
              lambda_q1, lambda_k1, lambda_q2, lambda_k2, attn_subln_g, w_out,
              ffn_norm_g, w_router_group, w_router_expert, w_exp_gate, w_exp_up, w_exp_down):
    Bsz, S, D = x.shape
    split_points = [D_CONV, 2 * D_CONV, 3 * D_CONV,
                    3 * D_CONV + Q_WIDTH, 3 * D_CONV + 2 * Q_WIDTH]
    h = x
    for l in range(DEPTH):
        lam_init = lambda_init(l)
        hn = rms_norm(h, attn_norm_g[l])
        proj = jnp.einsum('bsd,de->bse', hn, w_in[l])
        xc, b_gate, c_gate, q, k, v = jnp.split(proj, split_points, axis=-1)
        y_conv = short_conv_group(xc, b_gate, c_gate, conv_w[l], conv_out_g[l])
        y_attn = diff_attention_group(q, k, v, q_norm_g[l], k_norm_g[l],
                                      lambda_q1[l], lambda_k1[l], lambda_q2[l], lambda_k2[l],
                                      attn_subln_g[l], lam_init)
        mix = jnp.concatenate([y_conv, y_attn], axis=-1)
        h = h + jnp.einsum('bse,ed->bsd', mix, w_out[l])
        hn2 = rms_norm(h, ffn_norm_g[l]).reshape(Bsz * S, D)
        y_ffn = hierarchical_moe(hn2, w_router_group[l], w_router_expert[l],
                                 w_exp_gate[l], w_exp_up[l], w_exp_down[l])
        h = h + y_ffn.reshape(Bsz, S, D)
    return h
```

```cpp
#include <hip/hip_runtime.h>
#include <cstdio>
#include <cstdint>

#define EXPERTS_IN_ATTN 1

typedef unsigned short bf16_t;
typedef short bf16x8 __attribute__((ext_vector_type(8)));
typedef float f32x4 __attribute__((ext_vector_type(4)));
typedef unsigned u32x2 __attribute__((ext_vector_type(2)));
typedef unsigned u32x4 __attribute__((ext_vector_type(4)));
typedef int i32x4 __attribute__((ext_vector_type(4)));
typedef int i32x8 __attribute__((ext_vector_type(8)));

constexpr int BATCH = 4, SEQ = 4096, T = BATCH * SEQ, D = 1024, DIN = 3072, DCONV = 512;
constexpr int NH = 4, HD = 64, VD = 128;
constexpr int COL_XC = 0, COL_BG = 512, COL_CG = 1024, COL_Q = 1536, COL_K = 2048, COL_V = 2560;
constexpr int NG = 4, NE = 8, NEXP = NG * NE, F = 512, NLIST = NEXP * 2;
constexpr float EPS = 1e-6f;
constexpr float LOG2E = 1.4426950408889634f;
constexpr float QSCALE = 0.125f * LOG2E;
constexpr float LAM_INIT = 0.2f;
constexpr int NWAVES = 8, NTHREADS = NWAVES * 64;
constexpr int LDS_BYTES = 147456;

constexpr size_t MiB = 1u << 20;
constexpr size_t WS_CTL = 0;
constexpr size_t WS_BAR = 16384;
constexpr size_t CTL_ZERO_BYTES = 32768;
constexpr size_t WS_HIST = 384 * 1024;
constexpr size_t WS_WR = 65536;
constexpr size_t WS_RSTD = 512 * 1024;
constexpr size_t WS_LIST = 1 * MiB;
constexpr size_t WS_WL = 5 * MiB;
constexpr size_t WS_WIN = 9 * MiB;
constexpr size_t WS_WOUT = 15 * MiB;
constexpr size_t WS_WGU = 17 * MiB;
constexpr size_t WS_WD = 81 * MiB;
constexpr size_t WS_XN = 113 * MiB;
constexpr size_t WS_PROJ = 145 * MiB;
constexpr size_t WS_AO = 145 * MiB;
constexpr size_t WS_YB1 = 177 * MiB;
constexpr size_t WS_ENT = 241 * MiB;
constexpr size_t WS_END = 242 * MiB;
constexpr int ACT_ROWS_MAX = 2 * T + NLIST * 256;

struct Params {
    const float* x; const float* attn_norm_g; const float* w_in; const float* conv_w; const float* conv_out_g;
    const float* q_norm_g; const float* k_norm_g; const float* lq1; const float* lk1; const float* lq2; const float* lk2;
    const float* subln_g; const float* w_out; const float* ffn_norm_g; const float* w_rg; const float* w_re;
    const float* w_gate; const float* w_up; const float* w_down;
    float* out; unsigned char* ws;
};

__device__ __forceinline__ unsigned f2bf(float f) { unsigned u = __builtin_bit_cast(unsigned, f); return (u + 0x7fffu + ((u >> 16) & 1u)) >> 16; }
__device__ __forceinline__ unsigned pk2(float lo, float hi) { return f2bf(lo) | (f2bf(hi) << 16); }
__device__ __forceinline__ float bf2f(unsigned short b) { return __builtin_bit_cast(float, (unsigned)b << 16); }
__device__ __forceinline__ float bflo(unsigned w) { return __builtin_bit_cast(float, w << 16); }
__device__ __forceinline__ float bfhi(unsigned w) { return __builtin_bit_cast(float, w & 0xffff0000u); }
__device__ __forceinline__ int my_lane() { int l; asm volatile("v_mbcnt_lo_u32_b32 %0, -1, 0\n\tv_mbcnt_hi_u32_b32 %0, -1, %0" : "=v"(l)); return l & 63; }
__device__ __forceinline__ float lane_get(float v, int src) { return __builtin_bit_cast(float, __builtin_amdgcn_ds_bpermute(src << 2, __builtin_bit_cast(int, v))); }
__device__ __forceinline__ int lane_geti(int v, int src) { return __builtin_amdgcn_ds_bpermute(src << 2, v); }
__device__ __forceinline__ float wave_sum(float v) {
    const int ln = my_lane();
#pragma unroll
    for (int o = 1; o < 64; o <<= 1) v += lane_get(v, ln ^ o);
    return v;
}
__device__ __forceinline__ void unpack8(const u32x4 w, float (&o)[8]) {
    o[0] = bflo(w.x); o[1] = bfhi(w.x); o[2] = bflo(w.y); o[3] = bfhi(w.y); o[4] = bflo(w.z); o[5] = bfhi(w.z); o[6] = bflo(w.w); o[7] = bfhi(w.w);
}

constexpr float W8_SCALE = 32.f, ACT8_SCALE = 16.f;
__device__ __forceinline__ unsigned pk4_fp8(float a, float b, float c, float d) { int v = 0; v = __builtin_amdgcn_cvt_pk_fp8_f32(a, b, v, false); v = __builtin_amdgcn_cvt_pk_fp8_f32(c, d, v, true); return (unsigned)v; }
struct Ctx { int gw, ngw, lane, wave, bid, nb, tid; unsigned char* lds; };

struct TrItem { const float* W; bf16_t* WT; int K, N, k0, n0; };
__device__ __forceinline__ TrItem tr_item(const float* W, int K, int N, bf16_t* WT, int item) { const int nblk = N / 32, kb = item / nblk, nb = item % nblk; return TrItem{W, WT, K, N, 64 * kb, 32 * nb}; }
__device__ __forceinline__ void tr_load(const TrItem& t, f32x4 (&v)[8], int lane) {
#pragma unroll
    for (int i = 0; i < 8; ++i) v[i] = __builtin_nontemporal_load((const f32x4*)(t.W + (size_t)(t.k0 + 8 * i + (lane >> 3)) * t.N + t.n0 + 4 * (lane & 7)));
}
template <class RowFn> __device__ __forceinline__ void tr_finish(const TrItem& t, const f32x4 (&v)[8], RowFn rowfn, float* scr, int lane) {
#pragma unroll
    for (int i = 0; i < 8; ++i) { float* d = scr + (8 * i + (lane >> 3)) * 33 + 4 * (lane & 7); d[0] = v[i].x; d[1] = v[i].y; d[2] = v[i].z; d[3] = v[i].w; }
    asm volatile("s_waitcnt lgkmcnt(0)" ::: "memory");
    const int c = lane & 7;
#pragma unroll
    for (int j = 0; j < 4; ++j) {
        const int n = (lane >> 3) + 8 * j; const float* sp = scr + (8 * c) * 33 + n;
        u32x4 o; o.x = pk2(sp[0 * 33], sp[1 * 33]); o.y = pk2(sp[2 * 33], sp[3 * 33]); o.z = pk2(sp[4 * 33], sp[5 * 33]); o.w = pk2(sp[6 * 33], sp[7 * 33]);
        *(u32x4*)(t.WT + (size_t)rowfn(t.n0 + n) * t.K + t.k0 + 8 * c) = o;
    }
    asm volatile("s_waitcnt lgkmcnt(0)" ::: "memory");
}
template <class RowFn> __device__ __forceinline__ void tr_finish8(const TrItem& t, const f32x4 (&v)[8], RowFn rowfn, float* scr, int lane) {
#pragma unroll
    for (int i = 0; i < 8; ++i) { float* d = scr + (8 * i + (lane >> 3)) * 33 + 4 * (lane & 7); d[0] = v[i].x; d[1] = v[i].y; d[2] = v[i].z; d[3] = v[i].w; }
    asm volatile("s_waitcnt lgkmcnt(0)" ::: "memory");
    const int c = lane & 7; unsigned char* WT8 = (unsigned char*)t.WT;
#pragma unroll
    for (int j = 0; j < 4; ++j) {
        const int n = (lane >> 3) + 8 * j; const float* sp = scr + (8 * c) * 33 + n;
        u32x2 o; o.x = pk4_fp8(sp[0 * 33] * W8_SCALE, sp[1 * 33] * W8_SCALE, sp[2 * 33] * W8_SCALE, sp[3 * 33] * W8_SCALE); o.y = pk4_fp8(sp[4 * 33] * W8_SCALE, sp[5 * 33] * W8_SCALE, sp[6 * 33] * W8_SCALE, sp[7 * 33] * W8_SCALE);
        *(u32x2*)(WT8 + (size_t)rowfn(t.n0 + n) * t.K + t.k0 + 8 * c) = o;
    }
    asm volatile("s_waitcnt lgkmcnt(0)" ::: "memory");
}
template <class RowFn>
__device__ __forceinline__ void transpose_item(const float* __restrict__ W, int K, int N, bf16_t* __restrict__ WT, RowFn rowfn, float* scr, int item, int lane) {
    const TrItem t = tr_item(W, K, N, WT, item); f32x4 v[8]; tr_load(t, v, lane); tr_finish(t, v, rowfn, scr, lane);
}
struct RowId { __device__ __forceinline__ int operator()(int n) const { return n; } };
struct RowWin { __device__ __forceinline__ int operator()(int L) const { return (L & ~255) + ((L >> 5) & 1) * 128 + ((L >> 6) & 3) * 32 + (L & 31); } };
struct RowGU { int isup; __device__ __forceinline__ int operator()(int f) const { return (f >> 7) * 256 + isup * 128 + (f & 127); } };

struct RowGen { int kind; __device__ __forceinline__ int operator()(int f) const { return kind == 0 ? f : (f >> 7) * 256 + (kind - 1) * 128 + (f & 127); } };
__device__ __forceinline__ TrItem expert_item(const Params& p, int it, int& kind) {
    constexpr int I_G = (D / 64) * (F / 32), I_D = (F / 64) * (D / 32);
    unsigned char* Wgu8 = p.ws + WS_WGU; unsigned char* Wd8 = p.ws + WS_WD;
    const int e = it / (2 * I_G + I_D); int r = it - e * (2 * I_G + I_D);
    if (r < I_G) { kind = 1; return tr_item(p.w_gate + (size_t)e * D * F, D, F, (bf16_t*)(Wgu8 + (size_t)e * 1024 * D), r); } r -= I_G;
    if (r < I_G) { kind = 2; return tr_item(p.w_up + (size_t)e * D * F, D, F, (bf16_t*)(Wgu8 + (size_t)e * 1024 * D), r); } r -= I_G;
    kind = 0; return tr_item(p.w_down + (size_t)e * F * D, F, D, (bf16_t*)(Wd8 + (size_t)e * D * F), r);
}
__device__ __forceinline__ void convert_experts(const Params& p, const Ctx& c) {
    float* scr = (float*)(c.lds) + c.wave * (64 * 33);
    constexpr int I_G = (D / 64) * (F / 32), I_D = (F / 64) * (D / 32), NITEMS = NEXP * (2 * I_G + I_D);
    int it = c.gw;
    if (it >= NITEMS) return;
    int ka0, ka1; TrItem ta0 = expert_item(p, it, ka0); const bool ha1 = it + c.ngw < NITEMS; TrItem ta1 = expert_item(p, ha1 ? it + c.ngw : it, ka1);
    f32x4 va0[8], va1[8]; tr_load(ta0, va0, c.lane); tr_load(ta1, va1, c.lane);
    bool hcur1 = ha1;
    for (;;) {
        const int nx = it + 2 * c.ngw; const bool hn0 = nx < NITEMS, hn1 = nx + c.ngw < NITEMS;
        int kb0 = 0, kb1 = 0; TrItem tb0 = ta0, tb1 = ta1; f32x4 vb0[8], vb1[8];
        if (hn0) { tb0 = expert_item(p, nx, kb0); tb1 = expert_item(p, hn1 ? nx + c.ngw : nx, kb1); tr_load(tb0, vb0, c.lane); tr_load(tb1, vb1, c.lane); }
        tr_finish8(ta0, va0, RowGen{ka0}, scr, c.lane);
        if (hcur1) tr_finish8(ta1, va1, RowGen{ka1}, scr, c.lane);
        if (!hn0) break;
        ta0 = tb0; ta1 = tb1; ka0 = kb0; ka1 = kb1; hcur1 = hn1; it = nx;
#pragma unroll
        for (int q = 0; q < 8; ++q) { va0[q] = vb0[q]; va1[q] = vb1[q]; }
    }
}
__device__ __forceinline__ void convert_late(const Params& p, const Ctx& c) {
    float* scr = (float*)(c.lds) + c.wave * (64 * 33);
    bf16_t* Wout_t = (bf16_t*)(p.ws + WS_WOUT);
    constexpr int I_OUT = (D / 64) * (D / 32);
    for (int it = c.gw; it < I_OUT; it += c.ngw) transpose_item(p.w_out, D, D, Wout_t, RowId{}, scr, it, c.lane);
    bf16_t* Wr = (bf16_t*)(p.ws + WS_WR);
    for (int i = c.gw * 64 + c.lane; i < 48 * D; i += c.ngw * 64) {
        const int row = i >> 10, k = i & (D - 1), nf = row >> 4, q = (row >> 2) & 3, j = row & 3;
        float v = 0.f;
        if (nf < 2) v = p.w_re[(size_t)k * 32 + q * 8 + nf * 4 + j]; else if (j == 0) v = p.w_rg[(size_t)k * 4 + q];
        const unsigned hi = f2bf(v); Wr[i] = (bf16_t)hi; Wr[48 * D + i] = (bf16_t)f2bf(v - bf2f((unsigned short)hi));
    }
}
__device__ __forceinline__ void phase0(const Params& p, const Ctx& c) {
    float* scr = (float*)(c.lds) + c.wave * (64 * 33);
    bf16_t* Win_t = (bf16_t*)(p.ws + WS_WIN);
    constexpr int I_IN = (D / 64) * (DIN / 32);
    for (int it = c.gw; it < I_IN; it += c.ngw) transpose_item(p.w_in, D, DIN, Win_t, RowWin{}, scr, it, c.lane);
#if !EXPERTS_IN_ATTN
    convert_experts(p, c); convert_late(p, c);
#endif
    bf16_t* XN = (bf16_t*)(p.ws + WS_XN);
    const f32x4* gr = (const f32x4*)p.attn_norm_g + c.lane;
    for (int m = c.gw; m < T; m += 2 * c.ngw) {
        const int m2 = m + c.ngw;
        const f32x4* xa = (const f32x4*)(p.x + (size_t)m * D) + c.lane; const f32x4* xb = (const f32x4*)(p.x + (size_t)(m2 < T ? m2 : m) * D) + c.lane;
        f32x4 va[4], vb[4]; float sa = 0.f, sb = 0.f;
#pragma unroll
        for (int j = 0; j < 4; ++j) { va[j] = __builtin_nontemporal_load(xa + 64 * j); vb[j] = __builtin_nontemporal_load(xb + 64 * j); }
#pragma unroll
        for (int j = 0; j < 4; ++j) { sa += (va[j].x * va[j].x + va[j].y * va[j].y) + (va[j].z * va[j].z + va[j].w * va[j].w); sb += (vb[j].x * vb[j].x + vb[j].y * vb[j].y) + (vb[j].z * vb[j].z + vb[j].w * vb[j].w); }
        const float ra = rsqrtf(wave_sum(sa) * (1.f / D) + EPS), rb = rsqrtf(wave_sum(sb) * (1.f / D) + EPS);
        u32x2* oa = (u32x2*)(XN + (size_t)m * D) + c.lane; u32x2* ob = (u32x2*)(XN + (size_t)m2 * D) + c.lane;
#pragma unroll
        for (int j = 0; j < 4; ++j) { const f32x4 g = gr[64 * j];
            u32x2 w; w.x = pk2(va[j].x * ra * g.x, va[j].y * ra * g.y); w.y = pk2(va[j].z * ra * g.z, va[j].w * ra * g.w); oa[64 * j] = w;
            if (m2 < T) { u32x2 w2; w2.x = pk2(vb[j].x * rb * g.x, vb[j].y * rb * g.y); w2.y = pk2(vb[j].z * rb * g.z, vb[j].w * rb * g.w); ob[64 * j] = w2; } }
    }
}

namespace pg8 {
#define PG8_LAS __attribute__((address_space(3)))
typedef unsigned short bf16_t;
typedef short bf16x8 __attribute__((ext_vector_type(8)));
typedef float f32x4 __attribute__((ext_vector_type(4)));
typedef unsigned u32x4 __attribute__((ext_vector_type(4)));
constexpr int BM = 256, BK = 64, HALF = 128, HTB = HALF * BK * 2  , STAGE_BYTES = 8 * HTB, NXCD = 8, WGM = 8;

__host__ __device__ __forceinline__ int lds_byte(int r, int c) { const int st = (r >> 4) * 2 + (c >> 5), rr = r & 15, cc = c & 31, ob = rr * 64 + cc * 2; return st * 1024 + (ob ^ (((ob >> 9) & 1) << 5)); }
__host__ __device__ __forceinline__ void stage_rc(int b, int& R, int& C) { const int st = b / 1024, sb = b % 1024, swz = sb ^ (((sb >> 9) & 1) << 5); R = (st >> 1) * 16 + swz / 64; C = (st & 1) * 32 + (swz % 64) / 2; }
__host__ __device__ __forceinline__ int perm32(int rho) { const int n = rho >> 4, i = rho & 15; return 8 * (i >> 2) + 4 * n + (i & 3); }

__device__ __forceinline__ unsigned cvt_pk_bf16(float lo, float hi) { unsigned r; asm volatile("v_cvt_pk_bf16_f32 %0, %1, %2" : "=v"(r) : "v"(lo), "v"(hi)); return r; }
typedef float f32x2 __attribute__((ext_vector_type(2)));

__device__ __forceinline__ void glds16(const void* gbase, unsigned voff, unsigned lds_dst) { unsigned keep;
    asm volatile("s_mov_b32 %0, m0\n\ts_mov_b32 m0, %3\n\ts_nop 0\n\tglobal_load_lds_dwordx4 %1, %2\n\ts_mov_b32 m0, %0" : "=&s"(keep) : "v"(voff), "s"(gbase), "s"(lds_dst) : "memory"); }
struct DenseSched {
    struct Unit { int pm, pn; };
    const char* A; const char* Bt; int K, nM, nN, nwg, G, c;
    __device__ __forceinline__ void init(const void* A_, const void* Bt_, int M, int N, int K_, int G_, int c_) { A = (const char*)A_; Bt = (const char*)Bt_; K = K_; nM = M / BM; nN = N / BM; nwg = nM * nN; G = G_; c = c_; }
    __device__ __forceinline__ bool next(int i, Unit& u) const {
        const long L = (long)i * G + c; if (L >= nwg) return false;
        int wgid = (int)L; { const int q = nwg / NXCD, r = nwg % NXCD, xcd = wgid % NXCD, off = wgid / NXCD; wgid = (xcd < r ? xcd * (q + 1) : r * (q + 1) + (xcd - r) * q) + off; }
        const int nig = WGM * nN, gid = wgid / nig, fm = gid * WGM, gsz = (nM - fm) < WGM ? (nM - fm) : WGM;
        u.pm = fm + ((wgid % nig) % gsz); u.pn = (wgid % nig) / gsz; return true;
    }
    __device__ __forceinline__ const char* a_base(const Unit& u) const { return A + (size_t)u.pm * BM * K * 2; }
    __device__ __forceinline__ const char* b_base(const Unit& u) const { return Bt + (size_t)u.pn * BM * K * 2; }
    __device__ __forceinline__ unsigned rowoff(const Unit&, int) const { return 0u; }
    __device__ __forceinline__ bool half(const Unit&) const { return false; }
    __device__ __forceinline__ void a_ready(const Unit&) const {}
    __device__ __forceinline__ void done(const Unit&) const {}
};
template <class Epi, class Sched, bool ALIGN_EPI = false, bool SP2 = false, bool GATHER = false, int SC_W = 0, int SC_T = 0>
__device__ __forceinline__ void gemm_phase(PG8_LAS unsigned char* lds, const int K, const Sched& S, const Epi& E, const int wave_id) {
    typedef typename Sched::Unit Unit;
    const int tid_ = (wave_id & 7) * 64 + my_lane();
    const int tid = tid_, wid = __builtin_amdgcn_readfirstlane(tid >> 6), lane = tid & 63, wr = wid >> 2, wc = wid & 3, fr = lane & 15, fq = lane >> 4;
    int nt_ = K / BK; if constexpr (SC_W != 0) asm volatile("" : "+s"(nt_));
    const int nt = nt_;
    unsigned voffA[2], voffB[2]; int Rr[2]; unsigned Cc2[2];
#pragma unroll
    for (int i = 0; i < 2; ++i) { int R, C; stage_rc(tid * 16 + i * 8192, R, C); const int Rb = Epi::PERM ? ((R & ~31) + perm32(R & 31)) : R;
        voffA[i] = (unsigned)(R * K + C) * 2u; voffB[i] = (unsigned)(Rb * K + C) * 2u; Rr[i] = R; Cc2[i] = (unsigned)C * 2u; }
    unsigned cv[2][2], nv[2][2];
#define PG8_GATHER(dst, u) do { if constexpr (GATHER) { _Pragma("unroll") for (int h_ = 0; h_ < 2; ++h_) _Pragma("unroll") for (int i_ = 0; i_ < 2; ++i_) dst[h_][i_] = S.rowoff(u, Rr[i_] + HALF * h_) + Cc2[i_]; } } while (0)
    const size_t kstep = (size_t)(BK * 2);
    const size_t hstep = (size_t)HALF * K * 2;
    const unsigned ldsbase = (unsigned)(size_t)lds;
    const unsigned ldsw = (unsigned)wid * 1024u;
    const int aoff = lds_byte(wr * 64 + fr, fq * 8), boff = lds_byte(wc * 32 + fr, fq * 8);
#define PG8_SA(b, h) (((b) * 2 + (h)) * HTB)
#define PG8_SB(b, h) ((4 + (b) * 2 + (h)) * HTB)
#define PG8_STAGE_V(bufoff, gbase, v0, v1) do { const unsigned ld_ = ldsbase + (unsigned)(bufoff) + ldsw; glds16((gbase), (v0), ld_); glds16((gbase), (v1), ld_ + 8192u); } while (0)
#define PG8_STAGE_B(bufoff, gbase) PG8_STAGE_V(bufoff, gbase, voffB[0], voffB[1])
#define PG8_STAGE_A(bufoff, gbase, h, nx) do { if constexpr (GATHER) { PG8_STAGE_V(bufoff, gbase, (nx) ? nv[h][0] : cv[h][0], (nx) ? nv[h][1] : cv[h][1]); } \
        else { PG8_STAGE_V(bufoff, (gbase) + (h) * hstep, voffA[0], voffA[1]); } } while (0)
#define PG8_LDA(dst, b, h) do { _Pragma("unroll") for (int m = 0; m < 4; ++m) _Pragma("unroll") for (int k = 0; k < 2; ++k) dst[m][k] = *(const PG8_LAS bf16x8*)(lds + PG8_SA(b, h) + aoff + m * 2048 + k * 1024); } while (0)
#define PG8_LDB(dst, b, h) do { _Pragma("unroll") for (int n = 0; n < 2; ++n) _Pragma("unroll") for (int k = 0; k < 2; ++k) dst[n][k] = *(const PG8_LAS bf16x8*)(lds + PG8_SB(b, h) + boff + n * 2048 + k * 1024); } while (0)
#define PG8_CAT8(x) __builtin_shufflevector(__builtin_bit_cast(i32x4, x[0]), __builtin_bit_cast(i32x4, x[1]), 0, 1, 2, 3, 4, 5, 6, 7)
#define PG8_MMA(ai, bj, At, Bt) do { __builtin_amdgcn_s_setprio(1); _Pragma("unroll") for (int m = 0; m < 4; ++m) _Pragma("unroll") for (int n = 0; n < 2; ++n) { \
        if constexpr (SC_W != 0) { const i32x8 b8_ = PG8_CAT8(Bt[n]), a8_ = PG8_CAT8(At[m]); \
            asm volatile("v_mfma_scale_f32_16x16x128_f8f6f4 %0, %1, %2, %0, %3, %4 op_sel_hi:[0,0,0]" : "+v"(acc[ai][bj][m][n]) : "v"(b8_), "v"(a8_), "v"(sc_w), "v"(sc_t)); } \
        else { _Pragma("unroll") for (int k = 0; k < 2; ++k) acc[ai][bj][m][n] = __builtin_amdgcn_mfma_f32_16x16x32_bf16(Bt[n][k], At[m][k], acc[ai][bj][m][n], 0, 0, 0); } } __builtin_amdgcn_s_setprio(0); } while (0)
#define PG8_WAIT_V(n) asm volatile("s_waitcnt vmcnt(" #n ")" ::: "memory")
#define PG8_WAIT_L(n) asm volatile("s_waitcnt lgkmcnt(" #n ")" ::: "memory")
#define PG8_BAR __builtin_amdgcn_s_barrier()
#define PG8_SCHED __builtin_amdgcn_sched_barrier(0)
    Unit cur, nxt; int ui = 0;
    if (!S.next(0, cur)) return;
    const int sc_w = SC_W * 0x01010101, sc_t = SC_T * 0x01010101;
    bool hf = S.half(cur);
    f32x4 acc[2][2][4][2];
#pragma unroll
    for (int a = 0; a < 2; ++a)
#pragma unroll
        for (int b = 0; b < 2; ++b)
#pragma unroll
            for (int m = 0; m < 4; ++m)
#pragma unroll
                for (int n = 0; n < 2; ++n) acc[a][b][m][n] = (f32x4){0.f, 0.f, 0.f, 0.f};
    bf16x8 At[4][2], B0[2][2], B1[2][2];
    const char* cA = S.a_base(cur); const char* cB = S.b_base(cur);
    S.a_ready(cur); PG8_GATHER(cv, cur);
    if constexpr (SP2) {
        PG8_STAGE_B(PG8_SB(0, 0), cB); PG8_STAGE_B(PG8_SB(0, 1), cB + hstep); PG8_STAGE_A(PG8_SA(0, 0), cA, 0, false); PG8_STAGE_A(PG8_SA(0, 1), cA, 1, false);
        if (wr == 1) PG8_BAR;
        PG8_WAIT_V(2); PG8_BAR;
        PG8_STAGE_B(PG8_SB(1, 0), cB + kstep); PG8_STAGE_A(PG8_SA(1, 0), cA + kstep, 0, false); PG8_STAGE_B(PG8_SB(1, 1), cB + hstep + kstep);
        PG8_WAIT_V(6); PG8_BAR;
    } else {
        PG8_STAGE_B(PG8_SB(0, 0), cB); PG8_STAGE_A(PG8_SA(0, 0), cA, 0, false); PG8_STAGE_B(PG8_SB(0, 1), cB + hstep); PG8_STAGE_A(PG8_SA(0, 1), cA, 1, false);
        if (wr == 1) PG8_BAR;
        PG8_WAIT_V(4); PG8_BAR;
        PG8_STAGE_B(PG8_SB(1, 0), cB + kstep); PG8_STAGE_A(PG8_SA(1, 0), cA + kstep, 0, false); PG8_STAGE_B(PG8_SB(1, 1), cB + hstep + kstep);
        PG8_WAIT_V(6); PG8_BAR;
    }
    for (;;) {
        const bool has_next = S.next(ui + 1, nxt);
        const char* nA = has_next ? S.a_base(nxt) : cA; const char* nB = has_next ? S.b_base(nxt) : cB;
        if constexpr (GATHER) { if (has_next) { PG8_GATHER(nv, nxt); } else { _Pragma("unroll") for (int h_ = 0; h_ < 2; ++h_) { nv[h_][0] = cv[h_][0]; nv[h_][1] = cv[h_][1]; } } }
        for (int t = 0; t < nt; t += 2) {
            const bool last = (t == nt - 2);
            const char* a1 = cA + (size_t)(t + 1) * kstep;
            const char* a2 = last ? nA : cA + (size_t)(t + 2) * kstep; const char* b2 = last ? nB : cB + (size_t)(t + 2) * kstep;
            const char* a3 = a2 + kstep; const char* b3 = b2 + kstep;
            if (last && has_next) S.a_ready(nxt);
            if constexpr (SP2) {
            PG8_LDB(B0, 0, 0); PG8_LDB(B1, 0, 1); PG8_SCHED; PG8_LDA(At, 0, 0); PG8_STAGE_A(PG8_SA(1, 1), a1, 1, false);
            PG8_WAIT_V(8); PG8_WAIT_L(0); PG8_BAR; PG8_MMA(0, 0, At, B0); PG8_MMA(0, 1, At, B1); PG8_BAR; PG8_SCHED;
            PG8_LDA(At, 0, 1); PG8_STAGE_B(PG8_SB(0, 0), b2); PG8_STAGE_B(PG8_SB(0, 1), b2 + hstep); PG8_STAGE_A(PG8_SA(0, 0), a2, 0, last);
            PG8_WAIT_V(8); PG8_WAIT_L(0); PG8_BAR; if (!hf) { PG8_MMA(1, 0, At, B0); PG8_MMA(1, 1, At, B1); } PG8_BAR; PG8_SCHED;
            PG8_LDB(B0, 1, 0); PG8_LDB(B1, 1, 1); PG8_SCHED; PG8_LDA(At, 1, 0); PG8_STAGE_A(PG8_SA(0, 1), a2, 1, last);
            PG8_WAIT_V(8); PG8_WAIT_L(0); PG8_BAR; PG8_MMA(0, 0, At, B0); PG8_MMA(0, 1, At, B1); PG8_BAR; PG8_SCHED;
            PG8_LDA(At, 1, 1); PG8_STAGE_B(PG8_SB(1, 0), b3); PG8_STAGE_B(PG8_SB(1, 1), b3 + hstep); PG8_STAGE_A(PG8_SA(1, 0), a3, 0, last);
            PG8_WAIT_V(8); PG8_WAIT_L(0); PG8_BAR; if (!hf) { PG8_MMA(1, 0, At, B0); PG8_MMA(1, 1, At, B1); } PG8_BAR; PG8_SCHED;
            } else {
            PG8_LDB(B0, 0, 0); PG8_SCHED; PG8_LDA(At, 0, 0); PG8_STAGE_A(PG8_SA(1, 1), a1, 1, false);
            PG8_WAIT_L(8); PG8_BAR; PG8_WAIT_L(0); PG8_MMA(0, 0, At, B0); PG8_BAR; PG8_SCHED;
            PG8_LDB(B1, 0, 1); PG8_STAGE_B(PG8_SB(0, 0), b2);
            PG8_BAR; PG8_WAIT_L(0); PG8_MMA(0, 1, At, B1); PG8_BAR;
            PG8_LDA(At, 0, 1); PG8_STAGE_A(PG8_SA(0, 0), a2, 0, last);
            PG8_BAR; PG8_WAIT_L(0); PG8_MMA(1, 0, At, B0); PG8_BAR; PG8_SCHED;
            PG8_STAGE_B(PG8_SB(0, 1), b2 + hstep);
            PG8_WAIT_V(6); PG8_BAR; PG8_MMA(1, 1, At, B1); PG8_BAR;
            PG8_LDB(B0, 1, 0); PG8_SCHED; PG8_LDA(At, 1, 0); PG8_STAGE_A(PG8_SA(0, 1), a2, 1, last);
            PG8_WAIT_L(8); PG8_BAR; PG8_WAIT_L(0); PG8_MMA(0, 0, At, B0); PG8_BAR; PG8_SCHED;
            PG8_LDB(B1, 1, 1); PG8_STAGE_B(PG8_SB(1, 0), b3);
            PG8_BAR; PG8_WAIT_L(0); PG8_MMA(0, 1, At, B1); PG8_BAR;
            PG8_LDA(At, 1, 1); PG8_STAGE_A(PG8_SA(1, 0), a3, 0, last);
            PG8_BAR; PG8_WAIT_L(0); PG8_MMA(1, 0, At, B0); PG8_BAR; PG8_SCHED;
            PG8_STAGE_B(PG8_SB(1, 1), b3 + hstep);
            PG8_WAIT_V(6); PG8_BAR; PG8_MMA(1, 1, At, B1); PG8_BAR;
            }
        }
        if constexpr (SC_W != 0) asm volatile("s_nop 15\n\ts_nop 15" ::: "memory");
        if constexpr (ALIGN_EPI) { if (wr == 0) PG8_BAR; }
        if constexpr (!Epi::AFTER_DRAIN) { E(acc, cur, wr, wc, fr, fq); S.done(cur); }
        if (!has_next) break;
#pragma unroll
        for (int a = 0; a < 2; ++a)
#pragma unroll
            for (int b = 0; b < 2; ++b)
#pragma unroll
                for (int m = 0; m < 4; ++m)
#pragma unroll
                    for (int n = 0; n < 2; ++n) acc[a][b][m][n] = (f32x4){0.f, 0.f, 0.f, 0.f};
        cur = nxt; cA = nA; cB = nB; ++ui; hf = S.half(cur);
        if constexpr (GATHER) { _Pragma("unroll") for (int h_ = 0; h_ < 2; ++h_) { cv[h_][0] = nv[h_][0]; cv[h_][1] = nv[h_][1]; } }
        if constexpr (ALIGN_EPI) { if (wr == 1) PG8_BAR; }
    }
    PG8_WAIT_V(0);
    if constexpr (!ALIGN_EPI) { if (wr == 0) PG8_BAR; }
    PG8_BAR;
    if constexpr (Epi::AFTER_DRAIN) { E.fused(acc, cur, wr, wc, fr, fq, lds, wid, lane); S.done(cur); }
#undef PG8_SA
#undef PG8_SB
#undef PG8_STAGE_V
#undef PG8_STAGE_A
#undef PG8_STAGE_B
#undef PG8_GATHER
#undef PG8_LDA
#undef PG8_LDB
#undef PG8_MMA
#undef PG8_CAT8
#undef PG8_WAIT_V
#undef PG8_WAIT_L
#undef PG8_BAR
#undef PG8_SCHED
}
}

struct EpiProj {
    static constexpr bool PERM = true, AFTER_DRAIN = false;
    bf16_t* O; const float* qg; const float* kg;
    __device__ __forceinline__ void operator()(const f32x4 (&acc)[2][2][4][2], const pg8::DenseSched::Unit& u, int wr, int wc, int fr, int fq) const {
        const int cb = u.pn * 256 + wc * 64;
        const bool isq = (cb >= COL_Q) && (cb < COL_K), isk = (cb >= COL_K) && (cb < COL_V);
        f32x4 sc[2][2];
#pragma unroll
        for (int bj = 0; bj < 2; ++bj)
#pragma unroll
            for (int n = 0; n < 2; ++n) sc[bj][n] = (f32x4){1.f, 1.f, 1.f, 1.f};
        if (isq || isk) {
            const float* gn = isq ? qg : kg; const float mlt = isq ? QSCALE : 1.f;
#pragma unroll
            for (int bj = 0; bj < 2; ++bj)
#pragma unroll
                for (int n = 0; n < 2; ++n) sc[bj][n] = *(const f32x4*)(gn + 32 * bj + 8 * fq + 4 * n) * mlt;
        }
#pragma unroll
        for (int ai = 0; ai < 2; ++ai)
#pragma unroll
            for (int m = 0; m < 4; ++m) {
                const int row = u.pm * 256 + ai * 128 + wr * 64 + m * 16 + fr;
                float mul = 1.f;
                if (isq || isk) {
                    float ss = 0.f;
#pragma unroll
                    for (int bj = 0; bj < 2; ++bj)
#pragma unroll
                        for (int n = 0; n < 2; ++n) { const f32x4 x = acc[ai][bj][m][n]; ss += (x.x * x.x + x.y * x.y) + (x.z * x.z + x.w * x.w); }
                    { const int ln = fr + 16 * fq; ss += lane_get(ss, ln ^ 16); ss += lane_get(ss, ln ^ 32); }
                    mul = rsqrtf(ss * (1.f / 64.f) + EPS);
                }
                bf16_t* rowp = O + (size_t)row * DIN + cb + 8 * fq;
#pragma unroll
                for (int bj = 0; bj < 2; ++bj) {
                    const f32x4 v0 = acc[ai][bj][m][0] * sc[bj][0] * mul, v1 = acc[ai][bj][m][1] * sc[bj][1] * mul;
                    u32x4 w; w.x = pg8::cvt_pk_bf16(v0.x, v0.y); w.y = pg8::cvt_pk_bf16(v0.z, v0.w); w.z = pg8::cvt_pk_bf16(v1.x, v1.y); w.w = pg8::cvt_pk_bf16(v1.z, v1.w);
                    *(u32x4*)(rowp + 32 * bj) = w;
                }
            }
    }
};
struct EpiAO {
    static constexpr bool PERM = true, AFTER_DRAIN = false;
    bf16_t* O;
    __device__ __forceinline__ void operator()(const f32x4 (&acc)[2][2][4][2], const pg8::DenseSched::Unit& u, int wr, int wc, int fr, int fq) const {
        const int col0 = u.pn * 256 + wc * 32 + 8 * fq;
#pragma unroll
        for (int ai = 0; ai < 2; ++ai)
#pragma unroll
            for (int m = 0; m < 4; ++m) {
                bf16_t* rowp = O + (size_t)(u.pm * 256 + ai * 128 + wr * 64 + m * 16 + fr) * D + col0;
#pragma unroll
                for (int bj = 0; bj < 2; ++bj) {
                    const f32x4 v0 = acc[ai][bj][m][0], v1 = acc[ai][bj][m][1];
                    u32x4 w; w.x = pg8::cvt_pk_bf16(v0.x, v0.y); w.y = pg8::cvt_pk_bf16(v0.z, v0.w); w.z = pg8::cvt_pk_bf16(v1.x, v1.y); w.w = pg8::cvt_pk_bf16(v1.z, v1.w);
                    *(u32x4*)(rowp + bj * 128) = w;
                }
            }
    }
};
__device__ __forceinline__ void phase1_fast(const Params& p, const Ctx& c) {
    pg8::DenseSched S; S.init(p.ws + WS_XN, p.ws + WS_WIN, T, DIN, D, c.nb, c.bid);
    EpiProj E{(bf16_t*)(p.ws + WS_PROJ), p.q_norm_g, p.k_norm_g};
    pg8::gemm_phase<EpiProj, pg8::DenseSched, true, true, false>((PG8_LAS unsigned char*)c.lds, D, S, E, c.wave);
}
__device__ __forceinline__ void phase3_fast(const Params& p, const Ctx& c) {
    pg8::DenseSched S; S.init(p.ws + WS_XN, p.ws + WS_WOUT, T, D, D, c.nb, c.bid);
    EpiAO E{(bf16_t*)(p.ws + WS_AO)};
    pg8::gemm_phase<EpiAO, pg8::DenseSched, true, true, false>((PG8_LAS unsigned char*)c.lds, D, S, E, c.wave);
}

#include <hip/hip_bf16.h>
#include <cmath>
namespace attn128 {
using bf16=__hip_bfloat16;
using bf16x8=__attribute__((ext_vector_type(8)))short;
using s16x4=__attribute__((ext_vector_type(4)))short;
using f32x16=__attribute__((ext_vector_type(16)))float;
using u32x4=__attribute__((ext_vector_type(4)))unsigned;
constexpr int BATCH=4,NHEAD=16,SEQ=4096,D=64,DM=3072;
constexpr int NW=8,QBLK=32,QB=QBLK*NW,KVBLK=64,NQB=SEQ/QB;
constexpr int ATTN_PITCH=DM, ATTN_UNIT_ROWS=QB;
__device__ __forceinline__ int crow(int r,int hi){return (r&3)+8*(r>>2)+4*hi;}
#define SBAR() __builtin_amdgcn_sched_barrier(0)
__device__ __forceinline__ void cmask(f32x16&p0,f32x16&p1,int jb,int qrel,int hi){
  const float NEG=-INFINITY; int kb=64*jb+4*hi;
  #pragma unroll
  for(int r=0;r<16;++r){int kv=kb+(r&3)+8*(r>>2); if(kv>qrel)p0[r]=NEG; if(kv+32>qrel)p1[r]=NEG;}
}

constexpr int NSLOT=3, SLOTB=8192, VSLOTB=16384;
constexpr int LDS_K=0, LDS_V=NSLOT*SLOTB, LDS_WS=LDS_V+NSLOT*VSLOTB, LDS_OST=LDS_WS+NW*64*4, LDS_BYTES=LDS_OST+NW*8192;
constexpr float C2=0.125f*1.4426950408889634f;
__device__ __forceinline__ void glds16(const void*gbase,unsigned voff,unsigned lds_dst){unsigned keep;
  asm volatile("s_mov_b32 %0, m0\n\ts_mov_b32 m0, %3\n\ts_nop 0\n\tglobal_load_lds_dwordx4 %1, %2\n\ts_mov_b32 m0, %0":"=&s"(keep):"v"(voff),"s"(gbase),"s"(lds_dst):"memory");}
__device__ __forceinline__ float max3f(float a,float b,float c){float r;asm("v_max3_f32 %0, %1, %2, %3":"=v"(r):"v"(a),"v"(b),"v"(c));return r;}
__device__ __forceinline__ float max2f(float a,float b){float r;asm("v_max_f32_e32 %0, %1, %2":"=v"(r):"v"(a),"v"(b));return r;}
__device__ __forceinline__ float fadd_s(float a,float b){float r;asm("v_add_f32_e32 %0, %1, %2":"=v"(r):"v"(a),"v"(b));return r;}
__device__ __forceinline__ float fsub_s(float a,float b){float r;asm("v_sub_f32_e32 %0, %1, %2":"=v"(r):"v"(a),"v"(b));return r;}
typedef float f32x2_t __attribute__((ext_vector_type(2))); typedef __bf16 bf16x2_t __attribute__((ext_vector_type(2)));
__device__ __forceinline__ unsigned cvtpk_s(float lo,float hi){f32x2_t v={lo,hi};bf16x2_t b=__builtin_convertvector(v,bf16x2_t);return __builtin_bit_cast(unsigned,b);}
#define WAIT_BAR(N) asm volatile("s_waitcnt vmcnt(" #N ") lgkmcnt(0)\n\ts_barrier":::"memory")

__device__ __forceinline__ void qkt(f32x16&p0,f32x16&p1,const char*Kslot,const bf16x8*qr,int r32,int hi){ const f32x16 negm=f32x16{};
  const char*kb=Kslot+hi*1024+r32*16;
  #pragma unroll
  for(int d0=0;d0<4;++d0){
    const bf16x8 b0=*reinterpret_cast<const bf16x8*>(kb+d0*2048);
    const bf16x8 b1=*reinterpret_cast<const bf16x8*>(kb+d0*2048+512);
    if(d0==0){p0=__builtin_amdgcn_mfma_f32_32x32x16_bf16(b0,qr[0],negm,0,0,0);p1=__builtin_amdgcn_mfma_f32_32x32x16_bf16(b1,qr[0],negm,0,0,0);}
    else{p0=__builtin_amdgcn_mfma_f32_32x32x16_bf16(b0,qr[d0],p0,0,0,0);p1=__builtin_amdgcn_mfma_f32_32x32x16_bf16(b1,qr[d0],p1,0,0,0);}}
}
typedef __attribute__((address_space(3))) const char* lds_cptr;
typedef short v4i16_t __attribute__((ext_vector_type(4)));
__device__ __forceinline__ void kload8(bf16x8*kf,lds_cptr kp){
  kf[0]=*(const __attribute__((address_space(3))) bf16x8*)(kp);      kf[1]=*(const __attribute__((address_space(3))) bf16x8*)(kp+512);
  kf[2]=*(const __attribute__((address_space(3))) bf16x8*)(kp+2048); kf[3]=*(const __attribute__((address_space(3))) bf16x8*)(kp+2560);
  kf[4]=*(const __attribute__((address_space(3))) bf16x8*)(kp+4096); kf[5]=*(const __attribute__((address_space(3))) bf16x8*)(kp+4608);
  kf[6]=*(const __attribute__((address_space(3))) bf16x8*)(kp+6144); kf[7]=*(const __attribute__((address_space(3))) bf16x8*)(kp+6656);
}
__device__ __forceinline__ void kload2(bf16x8*kf,lds_cptr kp,int j){ kf[2*j]=*(const __attribute__((address_space(3))) bf16x8*)(kp+j*2048); kf[2*j+1]=*(const __attribute__((address_space(3))) bf16x8*)(kp+j*2048+512); }
__device__ __forceinline__ s16x4 vtr(lds_cptr p){ return __builtin_bit_cast(s16x4,__builtin_amdgcn_ds_read_tr16_b64_v4i16((__attribute__((address_space(3))) v4i16_t*)p)); }
__device__ __forceinline__ float rowmax(const f32x16&p0,const f32x16&p1){
  float a=max3f(p0[0],p0[1],p1[0]),b=max3f(p0[2],p0[3],p1[1]);a=max3f(a,p1[2],p1[3]);
  #pragma unroll
  for(int r=4;r<16;r+=4){a=max3f(a,p0[r],p0[r+1]);b=max3f(b,p0[r+2],p0[r+3]);a=max3f(a,p1[r],p1[r+1]);b=max3f(b,p1[r+2],p1[r+3]);}
  const float m=max2f(a,b);
  auto rr=__builtin_amdgcn_permlane32_swap(__float_as_uint(m),__float_as_uint(m),false,false);
  return max2f(__uint_as_float(rr[0]),__uint_as_float(rr[1]));
}
__device__ __forceinline__ void pv(f32x16*o,int vb,bf16x8 pa0,bf16x8 pa1,bf16x8 pa2,bf16x8 pa3){
  #pragma unroll
  for(int d0=0;d0<4;++d0){s16x4 lo[4],hi[4];
    #pragma unroll
    for(int ks=0;ks<4;++ks){
      asm volatile("ds_read_b64_tr_b16 %0,%1 offset:%c2":"=&v"(lo[ks]):"v"(vb),"i"(d0*4096+ks*1024):"memory");
      asm volatile("ds_read_b64_tr_b16 %0,%1 offset:%c2":"=&v"(hi[ks]):"v"(vb),"i"(d0*4096+ks*1024+512):"memory");}
    asm volatile("s_waitcnt lgkmcnt(0)":::"memory");SBAR();
    #define PK(k) (bf16x8){lo[k][0],lo[k][1],lo[k][2],lo[k][3],hi[k][0],hi[k][1],hi[k][2],hi[k][3]}
    o[d0]=__builtin_amdgcn_mfma_f32_32x32x16_bf16(pa0,PK(0),o[d0],0,0,0);
    o[d0]=__builtin_amdgcn_mfma_f32_32x32x16_bf16(pa1,PK(1),o[d0],0,0,0);
    o[d0]=__builtin_amdgcn_mfma_f32_32x32x16_bf16(pa2,PK(2),o[d0],0,0,0);
    o[d0]=__builtin_amdgcn_mfma_f32_32x32x16_bf16(pa3,PK(3),o[d0],0,0,0);
    #undef PK
  }
}

#ifndef ATTN_STORE16
#define ATTN_STORE16(p,v) (*(u32x4*)(p)=(v))
#endif
template<int THRL> __device__ __forceinline__ void attn_unit(int b,int h,int hv,int qb,const bf16*Q,const bf16*__restrict__ K,const bf16*__restrict__ V,bf16*O,char*shm){
  const int tid=threadIdx.x,lane=tid&63,r32=lane&31,hi=lane>>5; const int wid=__builtin_amdgcn_readfirstlane(tid>>6);
  const long rowbase=(long)b*SEQ; const int q0=qb*QB;
  const bf16*Qw=Q+(rowbase+q0+wid*QBLK)*DM+h*D;
  const bf16*Kh=K+rowbase*DM+h*D,*Vh=V+rowbase*DM+hv*128;
  const unsigned lds0=(unsigned)(uintptr_t)shm;
  float*wsf=(float*)(shm+LDS_WS)+wid*64;
  const unsigned koff=(unsigned)(lane*DM+wid*8)*2u;
  const unsigned voff=(unsigned)((16*(wid&3)+(lane>>2))*DM+(wid>>2)*32+(lane&3)*8)*2u;
  const unsigned kdst=lds0+LDS_K+wid*1024, vdst=lds0+LDS_V+wid*1024;
  #define DMA_K(t,slot) glds16(Kh+(long)(t)*KVBLK*DM,koff,(unsigned)__builtin_amdgcn_readfirstlane(kdst+(slot)))
  #define DMA_V(t,slot) do{ glds16(Vh+(long)(t)*KVBLK*DM,voff,(unsigned)__builtin_amdgcn_readfirstlane(vdst+(slot))); glds16(Vh+(long)(t)*KVBLK*DM+64,voff,(unsigned)__builtin_amdgcn_readfirstlane(vdst+(slot)+8192)); }while(0)
  const char*Kbase=shm+LDS_K; bf16x8 kf[8];
  const lds_cptr shm3=(lds_cptr)shm; const lds_cptr kp0=shm3+LDS_K+hi*1024+r32*16; const lds_cptr vp0=shm3+LDS_V+((lane>>4)&1)*32+(lane&3)*8+(4*hi+((lane&15)>>2))*64;
  const int NT=(q0+QB)/KVBLK;
  DMA_K(0,0);DMA_V(0,0);DMA_K(1,SLOTB);
  bf16x8 qr[4];
  #pragma unroll
  for(int d0=0;d0<4;++d0)qr[d0]=*reinterpret_cast<const bf16x8*>(&Qw[(long)r32*DM+d0*16+hi*8]);
  float mhat=0.f,l_reg=0.f;
  const int qrel=wid*QBLK+r32;
  #define CMASK(P0,P1,t) do{int jb_=(t)-(NT-4); if(jb_>=0)cmask(P0,P1,jb_,qrel,hi);}while(0)
  bool resc=false;
  #define START(P0,P1) do{ const float rm=rowmax(P0,P1); resc=false; \
    { const float dl=rm; mhat=fadd_s(mhat,dl); \
      _Pragma("unroll") for(int r=0;r<16;++r){P0[r]=fsub_s(P0[r],dl);P1[r]=fsub_s(P1[r],dl);} } \
    _Pragma("unroll") for(int r=0;r<16;++r)P0[r]=__builtin_amdgcn_exp2f(P0[r]); }while(0)
  #define RESC() do{ if(resc){ asm volatile("s_waitcnt lgkmcnt(0)":::"memory"); \
      _Pragma("unroll") for(int d_=0;d_<4;++d_) _Pragma("unroll") for(int r=0;r<16;++r)o[d_][r]*=wsf[crow(r,hi)]; } }while(0)
  f32x16 pA0,pA1,pB0,pB1;
  int sl_prev=0,sl_cur=0,sl_next=SLOTB;
  #define ROT() do{sl_prev=sl_cur;sl_cur=sl_next;sl_next=(sl_next==(NSLOT-1)*SLOTB)?0:sl_next+SLOTB;}while(0)
  DMA_K(2,2*SLOTB);
  WAIT_BAR(4);
  qkt(pA0,pA1,Kbase,qr,r32,hi);asm volatile("s_nop 15\n\ts_nop 7":"+v"(pA0),"+v"(pA1));CMASK(pA0,pA1,0);
  START(pA0,pA1);
  _Pragma("unroll") for(int r=0;r<16;++r)pA1[r]=__builtin_amdgcn_exp2f(pA1[r]);
  WAIT_BAR(0);
  DMA_K(3,0);DMA_V(1,VSLOTB);
  ROT();
  kload8(kf,kp0+sl_cur);
  WAIT_BAR(3);
  s16x4 vlo[8],vhi[8],wlo[8],whi[8]; u32x4 pw0,pw1,pw2,pw3;
  #define PKW(P,B) cvtpk_s(P[B],P[B+1])
  #define PAF(k) __builtin_bit_cast(bf16x8,pw##k)
  #define VFR(i) (bf16x8){vlo[i][0],vlo[i][1],vlo[i][2],vlo[i][3],vhi[i][0],vhi[i][1],vhi[i][2],vhi[i][3]}
  #define WFR(i) (bf16x8){wlo[i][0],wlo[i][1],wlo[i][2],wlo[i][3],whi[i][0],whi[i][1],whi[i][2],whi[i][3]}
  #define PIN(x) asm volatile("":"+v"(x))
  #define MX3(a,b,c) __builtin_fmaxf(__builtin_fmaxf((a),(b)),(c))
  #define GAPA(MF,A0,A1,A2,A3,W0,W1,PW) do{ MF; sacc+=A0; sacc+=A1; sacc+=A2; sacc+=A3; PIN(sacc); W0; W1; PIN(PW); SBAR(); }while(0)
  #define EX(v) __builtin_amdgcn_exp2f(v)
  #define GAPB(MF,X,B) do{ MF; X[B]=EX(X[B]-mhat); X[B+1]=EX(X[B+1]-mhat); PIN(X); SBAR(); }while(0)
  #define VOFF(s_) ((((s_)&3)*4096)+(((s_)>>2)*1024))
  #define VRD(i) do{ vlo[i]=vtr(vp_+VOFF(i)); vhi[i]=vtr(vp_+VOFF(i)+512); }while(0)
  #define WRD(i) do{ wlo[i]=vtr(vp_+VOFF(8+(i))); whi[i]=vtr(vp_+VOFF(8+(i))+512); SBAR(); }while(0)
  #define KRD(G,j) do{ if(G){ kload2(kf,kp0+sl_next,j); SBAR(); } }while(0)
  #define ZC f32x16{}
  #define STEP(C0,C1,P0,P1,t,GK,GV,GL) do{ SBAR(); \
    const lds_cptr vp_=vp0+2*sl_prev; \
    VRD(0); SBAR(); float sacc=(P0[0]+P0[1]); \
    GAPA(C0=__builtin_amdgcn_mfma_f32_32x32x16_bf16(kf[0],qr[0],ZC,0,0,0), P0[2],P0[3],P0[4],P0[5],     pw0[0]=PKW(P0,0), pw0[1]=PKW(P0,2), pw0); \
    VRD(1); SBAR(); GAPA(C1=__builtin_amdgcn_mfma_f32_32x32x16_bf16(kf[1],qr[0],ZC,0,0,0), P0[6],P0[7],P0[8],P0[9],     pw0[2]=PKW(P0,4), pw0[3]=PKW(P0,6), pw0); \
    VRD(2); SBAR(); GAPA(C0=__builtin_amdgcn_mfma_f32_32x32x16_bf16(kf[2],qr[1],C0,0,0,0),   P0[10],P0[11],P0[12],P0[13], pw1[0]=PKW(P0,8), pw1[1]=PKW(P0,10), pw1); \
    VRD(3); SBAR(); GAPA(C1=__builtin_amdgcn_mfma_f32_32x32x16_bf16(kf[3],qr[1],C1,0,0,0),   P0[14],P0[15],P1[0],P1[1],   pw1[2]=PKW(P0,12),pw1[3]=PKW(P0,14), pw1); \
    VRD(4); SBAR(); GAPA(C0=__builtin_amdgcn_mfma_f32_32x32x16_bf16(kf[4],qr[2],C0,0,0,0),   P1[2],P1[3],P1[4],P1[5],     pw2[0]=PKW(P1,0), pw2[1]=PKW(P1,2), pw2); \
    VRD(5); SBAR(); GAPA(C1=__builtin_amdgcn_mfma_f32_32x32x16_bf16(kf[5],qr[2],C1,0,0,0),   P1[6],P1[7],P1[8],P1[9],     pw2[2]=PKW(P1,4), pw2[3]=PKW(P1,6), pw2); \
    VRD(6); SBAR(); GAPA(C0=__builtin_amdgcn_mfma_f32_32x32x16_bf16(kf[6],qr[3],C0,0,0,0),   P1[10],P1[11],P1[12],P1[13], pw3[0]=PKW(P1,8), pw3[1]=PKW(P1,10), pw3); \
    VRD(7); SBAR(); GAPA(C1=__builtin_amdgcn_mfma_f32_32x32x16_bf16(kf[7],qr[3],C1,0,0,0),   P1[14],P1[15],0.f,0.f,       pw3[2]=PKW(P1,12),pw3[3]=PKW(P1,14), pw3); \
    l_reg+=sacc; \
    if(GK){DMA_K((t)+3,sl_cur);} if(GV){DMA_V((t)+1,2*sl_next);} \
    CMASK(C0,C1,t); \
    { float a=MX3(C0[0],C0[1],C1[0]),b=MX3(C0[2],C0[3],C1[1]); a=MX3(a,C1[2],C1[3]); \
      _Pragma("unroll") for(int r=4;r<16;r+=4){a=MX3(a,C0[r],C0[r+1]);b=MX3(b,C0[r+2],C0[r+3]);a=MX3(a,C1[r],C1[r+1]);b=MX3(b,C1[r+2],C1[r+3]);} \
      float rm=__builtin_fmaxf(a,b); { auto rr=__builtin_amdgcn_permlane32_swap(__float_as_uint(rm),__float_as_uint(rm),false,false); rm=__builtin_fmaxf(__uint_as_float(rr[0]),__uint_as_float(rr[1])); } \
      rm-=mhat;                                      \
      resc=false; \
      if(__builtin_expect(__any(rm>(float)THRL),0)){ const float dl=__builtin_fmaxf(rm,0.f); mhat+=dl; \
        const float f=__builtin_amdgcn_exp2f(-dl); l_reg*=f; if(hi==0)wsf[r32]=f; resc=true; } } \
    SBAR(); \
    WRD(0); GAPB(o[0]=__builtin_amdgcn_mfma_f32_32x32x16_bf16(PAF(0),VFR(0),o[0],0,0,0), C0,0); \
    WRD(1); GAPB(o[1]=__builtin_amdgcn_mfma_f32_32x32x16_bf16(PAF(0),VFR(1),o[1],0,0,0), C0,2); \
    WRD(2); KRD(GL,0); GAPB(o[2]=__builtin_amdgcn_mfma_f32_32x32x16_bf16(PAF(0),VFR(2),o[2],0,0,0), C0,4); \
    WRD(3); KRD(GL,1); GAPB(o[3]=__builtin_amdgcn_mfma_f32_32x32x16_bf16(PAF(0),VFR(3),o[3],0,0,0), C0,6); \
    WRD(4); KRD(GL,2); GAPB(o[0]=__builtin_amdgcn_mfma_f32_32x32x16_bf16(PAF(1),VFR(4),o[0],0,0,0), C0,8); \
    WRD(5); KRD(GL,3); GAPB(o[1]=__builtin_amdgcn_mfma_f32_32x32x16_bf16(PAF(1),VFR(5),o[1],0,0,0), C0,10); \
    WRD(6); GAPB(o[2]=__builtin_amdgcn_mfma_f32_32x32x16_bf16(PAF(1),VFR(6),o[2],0,0,0), C0,12); \
    WRD(7); GAPB(o[3]=__builtin_amdgcn_mfma_f32_32x32x16_bf16(PAF(1),VFR(7),o[3],0,0,0), C0,14); \
    GAPB(o[0]=__builtin_amdgcn_mfma_f32_32x32x16_bf16(PAF(2),WFR(0),o[0],0,0,0), C1,0); \
    GAPB(o[1]=__builtin_amdgcn_mfma_f32_32x32x16_bf16(PAF(2),WFR(1),o[1],0,0,0), C1,2); \
    GAPB(o[2]=__builtin_amdgcn_mfma_f32_32x32x16_bf16(PAF(2),WFR(2),o[2],0,0,0), C1,4); \
    GAPB(o[3]=__builtin_amdgcn_mfma_f32_32x32x16_bf16(PAF(2),WFR(3),o[3],0,0,0), C1,6); \
    GAPB(o[0]=__builtin_amdgcn_mfma_f32_32x32x16_bf16(PAF(3),WFR(4),o[0],0,0,0), C1,8); \
    GAPB(o[1]=__builtin_amdgcn_mfma_f32_32x32x16_bf16(PAF(3),WFR(5),o[1],0,0,0), C1,10); \
    GAPB(o[2]=__builtin_amdgcn_mfma_f32_32x32x16_bf16(PAF(3),WFR(6),o[2],0,0,0), C1,12); \
    GAPB(o[3]=__builtin_amdgcn_mfma_f32_32x32x16_bf16(PAF(3),WFR(7),o[3],0,0,0), C1,14); \
    }while(0)
  f32x16 o[4];o[0]=f32x16{};o[1]=f32x16{};o[2]=f32x16{};o[3]=f32x16{};
  int t=1;
  #undef CMASK
  #define CMASK(P0,P1,t) do{}while(0)
  for(;t+5<NT;t+=2){
    STEP(pB0,pB1,pA0,pA1,t,true,true,true);     WAIT_BAR(3); RESC(); ROT();
    STEP(pA0,pA1,pB0,pB1,t+1,true,true,true);   WAIT_BAR(3); RESC(); ROT();
  }
  #undef CMASK
  #define CMASK(P0,P1,t) do{int jb_=(t)-(NT-4); if(jb_>=0)cmask(P0,P1,jb_,qrel,hi);}while(0)
  #define ENDW(tt) do{ if((tt)+3<NT){WAIT_BAR(3);} else if((tt)+2<NT){WAIT_BAR(2);} else {WAIT_BAR(0);} }while(0)
  for(;t+1<NT;t+=2){
    STEP(pB0,pB1,pA0,pA1,t,(t+3<NT),(t+1<NT),(t+1<NT));       ENDW(t);   RESC(); ROT();
    STEP(pA0,pA1,pB0,pB1,t+1,(t+4<NT),(t+2<NT),(t+2<NT));     ENDW(t+1); RESC(); ROT();
  }
  STEP(pB0,pB1,pA0,pA1,NT-1,false,false,false); RESC();
  { float sacc=pB0[0]+pB0[1]; _Pragma("unroll") for(int r=2;r<16;++r)sacc+=pB0[r]; _Pragma("unroll") for(int r=0;r<16;++r)sacc+=pB1[r]; l_reg+=sacc;
    pw0=(u32x4){PKW(pB0,0),PKW(pB0,2),PKW(pB0,4),PKW(pB0,6)};pw1=(u32x4){PKW(pB0,8),PKW(pB0,10),PKW(pB0,12),PKW(pB0,14)};pw2=(u32x4){PKW(pB1,0),PKW(pB1,2),PKW(pB1,4),PKW(pB1,6)};pw3=(u32x4){PKW(pB1,8),PKW(pB1,10),PKW(pB1,12),PKW(pB1,14)};
    int ln_; asm volatile("v_mbcnt_lo_u32_b32 %0, -1, 0\n\tv_mbcnt_hi_u32_b32 %0, -1, %0":"=v"(ln_)); ln_&=63;
    const int vb0=(int)(lds0+LDS_V)+((ln_>>4)&1)*32+(ln_&3)*8+(4*((ln_>>5)&1)+((ln_&15)>>2))*64;
    SBAR(); pv(o,vb0+2*sl_cur,PAF(0),PAF(1),PAF(2),PAF(3)); }
  #undef PKW
  #undef PAF
  #undef VFR
  #undef WFR
  #undef VOFF
  #undef WRD
  #undef ZC
  #undef PIN
  #undef MX3
  #undef GAPA
  #undef GAPB
  #undef EX
  #undef VRD
  #undef KRD
  #undef STEP
  #undef ENDW
  {auto rr=__builtin_amdgcn_permlane32_swap(__float_as_uint(l_reg),__float_as_uint(l_reg),false,false);l_reg=__uint_as_float(rr[0])+__uint_as_float(rr[1]);}
  int le_; asm volatile("v_mbcnt_lo_u32_b32 %0, -1, 0\n\tv_mbcnt_hi_u32_b32 %0, -1, %0":"=v"(le_)); le_&=63; const int r32e=le_&31,hie=(le_>>5)&1;
  float*wsfe=(float*)(shm+LDS_WS)+wid*64;
  if(hie==0)wsfe[32+r32e]=l_reg;asm volatile("s_waitcnt lgkmcnt(0)":::"memory");
  float rli[16];
  #pragma unroll
  for(int r=0;r<16;++r)rli[r]=__builtin_amdgcn_rcpf(wsfe[32+crow(r,hie)]);
  bf16*Ow=O+(rowbase+q0+wid*QBLK)*512+hv*128;
  { bf16*stg=(bf16*)(shm+LDS_OST)+wid*4096;
    #pragma unroll
    for(int r=0;r<16;++r){const int orow=crow(r,hie);
      #pragma unroll
      for(int d0=0;d0<4;++d0)stg[orow*128+d0*32+r32e]=__float2bfloat16(o[d0][r]*rli[r]);}
    asm volatile("s_waitcnt lgkmcnt(0)":::"memory");
    #pragma unroll
    for(int i=0;i<8;++i){const int row=i*4+((le_>>4)&3),ch=le_&15; const u32x4 v=*(const u32x4*)(stg+row*128+ch*8); ATTN_STORE16(Ow+(long)row*512+ch*8,v);} }
  asm volatile("s_waitcnt lgkmcnt(0)\n\ts_barrier":::"memory");
  #undef DMA_K
  #undef DMA_V
  #undef CMASK
  #undef START
  #undef RESC
  #undef ROT
}
constexpr int ATTN_LDS_BYTES=LDS_BYTES;
struct AttnTensors { const bf16* Q; const bf16* K; const bf16* V; bf16* O; };
struct AttnUnit { int bhc; int qb; };
struct StaticOrder {
  int vcu;
  __device__ __forceinline__ explicit StaticOrder(int grid,int block):vcu((block%8)*(grid/8)+block/8){}
  __device__ __forceinline__ bool next(int i,AttnUnit&u)const{ if(i>=2)return false; const int s=vcu&7; u.bhc=vcu>>3; u.qb=(i==0)?s:15-s; return true; }
};
template<class Sched,class Mid,int THRL=8> __device__ __forceinline__ void attn_phase(char*lds,const AttnTensors&T,const Sched&S,const Mid&mid){
  AttnUnit u;
  for(int i=0;S.next(i,u);++i){ if(i==1)mid(); const int b=u.bhc>>3,hh=(u.bhc>>1)&3,c=u.bhc&1; attn_unit<THRL>(b,hh*2+c,hh,u.qb,T.Q,T.K,T.V,T.O+(long)c*16384*512,lds); }
}
#undef SBAR
#undef WAIT_BAR
}


template <int PART> __device__ __forceinline__ void phase2b(const Params& p, const Ctx& c) {
    const bf16_t* PROJ = (const bf16_t*)(p.ws + WS_PROJ); const bf16_t* ATT = (const bf16_t*)p.out; bf16_t* MIX = (bf16_t*)(p.ws + WS_XN);
    const int lane = c.lane;
    const float d1 = wave_sum(p.lq1[lane] * p.lk1[lane]), d2 = wave_sum(p.lq2[lane] * p.lk2[lane]);
    const float lam = expf(d1) - expf(d2) + LAM_INIT;
    float sg[8], w0[8], w1[8], w2[8], cgn[8];
#pragma unroll
    for (int i = 0; i < 8; ++i) { sg[i] = p.subln_g[(8 * lane + i) & 127] * (1.f - LAM_INIT); w0[i] = p.conv_w[8 * lane + i]; w1[i] = p.conv_w[512 + 8 * lane + i]; w2[i] = p.conv_w[1024 + 8 * lane + i]; cgn[i] = p.conv_out_g[8 * lane + i]; }
    if constexpr ((PART & 1) != 0) {
        for (int t0 = c.gw; t0 < T; t0 += 4 * c.ngw) {
            u32x4 A0[4], A1[4];
#pragma unroll
            for (int r = 0; r < 4; ++r) { const int t = (t0 + r * c.ngw < T) ? t0 + r * c.ngw : t0; A0[r] = *(const u32x4*)(ATT + (size_t)t * 512 + 8 * lane); A1[r] = *(const u32x4*)(ATT + ((size_t)T + t) * 512 + 8 * lane); }
#pragma unroll
            for (int r = 0; r < 4; ++r) { const int t = t0 + r * c.ngw; if (t < T) {
                float a0[8], a1[8], o[8]; unpack8(A0[r], a0); unpack8(A1[r], a1);
                float ss = 0.f;
#pragma unroll
                for (int i = 0; i < 8; ++i) { o[i] = a0[i] - lam * a1[i]; ss += o[i] * o[i]; }
                ss += lane_get(ss, lane ^ 1); ss += lane_get(ss, lane ^ 2); ss += lane_get(ss, lane ^ 4); ss += lane_get(ss, lane ^ 8);
                const float rinv = rsqrtf(ss * (1.f / 128.f) + EPS);
                u32x4 w; w.x = pk2(o[0] * rinv * sg[0], o[1] * rinv * sg[1]); w.y = pk2(o[2] * rinv * sg[2], o[3] * rinv * sg[3]);
                w.z = pk2(o[4] * rinv * sg[4], o[5] * rinv * sg[5]); w.w = pk2(o[6] * rinv * sg[6], o[7] * rinv * sg[7]);
                *(u32x4*)(MIX + (size_t)t * D + 512 + 8 * lane) = w; } }
        }
    }
    if constexpr ((PART & 2) != 0) {
        for (int t0 = c.gw; t0 < T; t0 += 2 * c.ngw) {
            u32x4 X0[2], B0[2], C0[2], X1[2], C1[2], X2[2], C2[2];
#pragma unroll
            for (int r = 0; r < 2; ++r) { const int t = (t0 + r * c.ngw < T) ? t0 + r * c.ngw : t0, s = t & (SEQ - 1);
                const bf16_t* r0 = PROJ + (size_t)t * DIN + 8 * lane; const bf16_t* r1 = r0 - (s >= 1 ? DIN : 0); const bf16_t* r2 = r0 - (s >= 2 ? 2 * DIN : 0);
                X0[r] = *(const u32x4*)(r0 + COL_XC); B0[r] = *(const u32x4*)(r0 + COL_BG); C0[r] = *(const u32x4*)(r0 + COL_CG);
                X1[r] = *(const u32x4*)(r1 + COL_XC); C1[r] = *(const u32x4*)(r1 + COL_CG); X2[r] = *(const u32x4*)(r2 + COL_XC); C2[r] = *(const u32x4*)(r2 + COL_CG); }
#pragma unroll
            for (int r = 0; r < 2; ++r) { const int t = t0 + r * c.ngw; if (t < T) {
                const int s = t & (SEQ - 1); const float m1 = s >= 1 ? 1.f : 0.f, m2 = s >= 2 ? 1.f : 0.f;
                float xc[8], bg[8], cgt[8], xa[8], ca[8], xb[8], cb[8], y[8];
                unpack8(X0[r], xc); unpack8(B0[r], bg); unpack8(C0[r], cgt); unpack8(X1[r], xa); unpack8(C1[r], ca); unpack8(X2[r], xb); unpack8(C2[r], cb);
                float ss = 0.f;
#pragma unroll
                for (int i = 0; i < 8; ++i) { const float u0 = cgt[i] * xc[i], u1 = ca[i] * xa[i] * m1, u2 = cb[i] * xb[i] * m2; y[i] = bg[i] * (w0[i] * u2 + w1[i] * u1 + w2[i] * u0); ss += y[i] * y[i]; }
                ss += lane_get(ss, lane ^ 1); ss += lane_get(ss, lane ^ 2); ss += lane_get(ss, lane ^ 4);
                const float rinv = rsqrtf(ss * (1.f / 64.f) + EPS);
                u32x4 w; w.x = pk2(y[0] * rinv * cgn[0], y[1] * rinv * cgn[1]); w.y = pk2(y[2] * rinv * cgn[2], y[3] * rinv * cgn[3]);
                w.z = pk2(y[4] * rinv * cgn[4], y[5] * rinv * cgn[5]); w.w = pk2(y[6] * rinv * cgn[6], y[7] * rinv * cgn[7]);
                *(u32x4*)(MIX + (size_t)t * D + 8 * lane) = w; } }
        }
    }
}

constexpr int WR_PITCH = 2048 + 64;
constexpr int P3B_X_OFF = 48 * WR_PITCH;
constexpr int P3B_H_OFF = P3B_X_OFF + 16384 + 4096;
constexpr int P3B_G_OFF = P3B_X_OFF + 16384;
template <int VAR = 0> __device__ __forceinline__ void phase3b(const Params& p, const Ctx& c) {
    unsigned char* HN2 = p.ws + WS_XN;
    const bf16_t* Wr = (const bf16_t*)(p.ws + WS_WR); float* RSTD = (float*)(p.ws + WS_RSTD);
    const int fr = c.lane & 15, fq = c.lane >> 4, tg = c.wave & 3, kh = c.wave >> 2;
    unsigned char* wlds = c.lds; float* xch = (float*)(c.lds + P3B_X_OFF); float* glds = (float*)(c.lds + P3B_G_OFF);
    unsigned* hist = (unsigned*)(c.lds + P3B_H_OFF); u32x4* ENT = (u32x4*)(p.ws + WS_ENT); unsigned* HIST = (unsigned*)(p.ws + WS_HIST);
    if (c.tid < 64) hist[c.tid] = 0u;
    __syncthreads();
    { u32x4 tw[12]; f32x4 tg = (f32x4){0.f, 0.f, 0.f, 0.f};
#pragma unroll
      for (int q = 0; q < 12; ++q) { const int i = c.tid + q * NTHREADS, row = i >> 7, ch = i & 127; tw[q] = *(const u32x4*)(Wr + (size_t)row * D + ch * 8); }
      if (c.tid < D / 4) tg = *(const f32x4*)(p.ffn_norm_g + 4 * c.tid);
#pragma unroll
      for (int q = 0; q < 12; ++q) { const int i = c.tid + q * NTHREADS, row = i >> 7, ch = i & 127; *(u32x4*)(wlds + row * WR_PITCH + ch * 16) = tw[q]; }
      if (c.tid < D / 4) *(f32x4*)(glds + 4 * c.tid) = tg; }
    __syncthreads();
    for (int blk = c.bid; blk < T / 64; blk += c.nb) {
        const int t = blk * 64 + tg * 16 + fr, kbase = kh * 512;
        const float* hrow = p.x + (size_t)t * D + kbase + 8 * fq; const float* grow = glds + kbase + 8 * fq;
        const bf16_t* arow = (const bf16_t*)(p.ws + WS_AO) + (size_t)t * D + kbase + 8 * fq;
        unsigned char* orow = HN2 + (size_t)t * D + kbase + 8 * fq;
        f32x4 hb[16][2]; u32x4 ab[16];
#pragma unroll
        for (int st = 0; st < 16; ++st) { hb[st][0] = __builtin_nontemporal_load((const f32x4*)(hrow + st * 32)); hb[st][1] = __builtin_nontemporal_load((const f32x4*)(hrow + st * 32 + 4)); ab[st] = *(const u32x4*)(arow + st * 32); }
        f32x4 acc[3]; acc[0] = (f32x4){0.f, 0.f, 0.f, 0.f}; acc[1] = acc[0]; acc[2] = acc[0];
        float ss = 0.f;
        const unsigned char* wb = wlds + fr * WR_PITCH + (kbase + 8 * fq) * 2;
#pragma unroll
        for (int st = 0; st < 16; ++st) {
            const u32x4 aw = ab[st];
            const f32x4 h0 = hb[st][0] + (f32x4){bflo(aw.x), bfhi(aw.x), bflo(aw.y), bfhi(aw.y)}, h1 = hb[st][1] + (f32x4){bflo(aw.z), bfhi(aw.z), bflo(aw.w), bfhi(aw.w)};
            const f32x4 g0 = *(const f32x4*)(grow + st * 32), g1 = *(const f32x4*)(grow + st * 32 + 4);
            ss += (h0.x * h0.x + h0.y * h0.y) + (h0.z * h0.z + h0.w * h0.w) + (h1.x * h1.x + h1.y * h1.y) + (h1.z * h1.z + h1.w * h1.w);
            float a[8] = {h0.x * g0.x, h0.y * g0.y, h0.z * g0.z, h0.w * g0.w, h1.x * g1.x, h1.y * g1.y, h1.z * g1.z, h1.w * g1.w};
            u32x4 hw, lw;
#pragma unroll
            for (int i = 0; i < 4; ++i) { const unsigned ha = f2bf(a[2 * i]), hb2 = f2bf(a[2 * i + 1]); hw[i] = ha | (hb2 << 16); lw[i] = pk2(a[2 * i] - bf2f((unsigned short)ha), a[2 * i + 1] - bf2f((unsigned short)hb2)); }
            if (!(VAR & 2)) { u32x2 o8; o8.x = pk4_fp8(a[0], a[1], a[2], a[3]); o8.y = pk4_fp8(a[4], a[5], a[6], a[7]); *(u32x2*)(orow + st * 32) = o8; }
            const bf16x8 Ahi = __builtin_bit_cast(bf16x8, hw), Alo = __builtin_bit_cast(bf16x8, lw);
#pragma unroll
            for (int nf = 0; nf < 3; ++nf) {
                const bf16x8 w1 = *(const bf16x8*)(wb + nf * 16 * WR_PITCH + st * 64);
                acc[nf] = __builtin_amdgcn_mfma_f32_16x16x32_bf16(w1, Ahi, acc[nf], 0, 0, 0);
                acc[nf] = __builtin_amdgcn_mfma_f32_16x16x32_bf16(w1, Alo, acc[nf], 0, 0, 0);
            }
        }
        float* xs = xch + (tg * 64 + c.lane) * 16;
        if (kh == 1) { *(f32x4*)(xs) = acc[0]; *(f32x4*)(xs + 4) = acc[1]; *(f32x4*)(xs + 8) = acc[2]; xs[12] = ss; }
        __syncthreads();
        if (kh == 0) {
            acc[0] += *(const f32x4*)(xs); acc[1] += *(const f32x4*)(xs + 4); acc[2] += *(const f32x4*)(xs + 8); ss += xs[12];
            { const int ln = fr + 16 * fq; ss += lane_get(ss, ln ^ 16); ss += lane_get(ss, ln ^ 32); }
            const float rstd = rsqrtf(ss * (1.f / D) + EPS);
            float le[8];
#pragma unroll
            for (int j = 0; j < 4; ++j) { le[j] = acc[0][j] * rstd; le[4 + j] = acc[1][j] * rstd; }
            const float lg = acc[2][0] * rstd;
            float gl[4];
#pragma unroll
            for (int g = 0; g < 4; ++g) gl[g] = lane_get(lg, fr + 16 * g);
            int gi = 0; float gm = gl[0];
#pragma unroll
            for (int g = 1; g < 4; ++g) if (gl[g] > gm) { gm = gl[g]; gi = g; }
            float gs = 0.f;
#pragma unroll
            for (int g = 0; g < 4; ++g) gs += expf(gl[g] - gm);
            const float ggate = 1.f / gs;
            int i1 = 0; float v1 = le[0];
#pragma unroll
            for (int e = 1; e < 8; ++e) if (le[e] > v1) { v1 = le[e]; i1 = e; }
            int i2 = 0; float v2 = -INFINITY;
#pragma unroll
            for (int e = 0; e < 8; ++e) if (e != i1 && le[e] > v2) { v2 = le[e]; i2 = e; }
            const float ex = expf(v2 - v1), wa = 1.f / (1.f + ex), wb2 = ex * wa;
            if (fq == 0) RSTD[t] = rstd;
            if (!(VAR & 1) && fq == gi) {
                const int l1 = ((gi * 8 + i1) << 1), l2 = ((gi * 8 + i2) << 1) + 1;
                const unsigned r1 = __hip_atomic_fetch_add(hist + l1, 1u, __ATOMIC_RELAXED, __HIP_MEMORY_SCOPE_WORKGROUP), r2 = __hip_atomic_fetch_add(hist + l2, 1u, __ATOMIC_RELAXED, __HIP_MEMORY_SCOPE_WORKGROUP);
                u32x4* e = ENT + (size_t)blk * 128 + (tg * 16 + fr) * 2;
                e[0] = (u32x4){(unsigned)l1, r1, (unsigned)t, __builtin_bit_cast(unsigned, wa * ggate)};
                e[1] = (u32x4){(unsigned)l2, r2, (unsigned)t, __builtin_bit_cast(unsigned, wb2 * ggate)};
            }
        }
        __syncthreads();
        if (!(VAR & 1) && c.tid < 64) { HIST[blk * 64 + c.tid] = hist[c.tid]; hist[c.tid] = 0u; }
        __syncthreads();
    }
}

__device__ __forceinline__ void phase3c(const Params& p, const Ctx& c) {
    const unsigned* HIST = (const unsigned*)(p.ws + WS_HIST); const u32x4* ENT = (const u32x4*)(p.ws + WS_ENT);
    unsigned* cnt = (unsigned*)(p.ws + WS_CTL); int* list = (int*)(p.ws + WS_LIST); float* wl = (float*)(p.ws + WS_WL);
    unsigned* part = (unsigned*)c.lds;
    const int l = c.tid & 63, pt = c.tid >> 6;
    for (int blk = c.bid; blk < T / 64; blk += c.nb) {
        unsigned pre = 0u, tot = 0u;
#pragma unroll 8
        for (int b = pt * 32; b < pt * 32 + 32; ++b) { const unsigned v = HIST[b * 64 + l]; tot += v; pre += (b < blk) ? v : 0u; }
        __syncthreads();
        part[pt * 64 + l] = pre; part[512 + pt * 64 + l] = tot;
        __syncthreads();
        if (c.tid < 128) {
            const u32x4 e = ENT[(size_t)blk * 128 + c.tid];
            unsigned base = 0u;
#pragma unroll
            for (int q = 0; q < 8; ++q) base += part[q * 64 + e.x];
            const size_t pos = (size_t)e.x * T + base + e.y;
            const unsigned ez = e.z, ew = e.w;
            list[pos] = (int)ez; wl[pos] = __uint_as_float(ew);
        }
        if (blk == 0 && c.tid < 64) { unsigned t2 = 0u;
#pragma unroll
            for (int q = 0; q < 8; ++q) t2 += part[512 + q * 64 + c.tid];
            cnt[c.tid] = t2; }
    }
}

constexpr int TAB_OFF = 131072, UT_OFF = TAB_OFF + 2048, BARST_OFF = LDS_BYTES - 64;
template <bool GATHERA> struct GroupSched {
    struct Unit { int l, mt, pn, ui; bool hf; };
    const int* tab; const unsigned* ut; const char* Abase; const char* Bbase; int K, G, vcu, l0, lstep, nl; int lane_;
    __device__ __forceinline__ bool next(int i, Unit& u) const {
        const int L = i * G + vcu, totF = tab[129 + nl], totH = tab[194 + nl];
        if (L >= (totF + totH) * 4) return false;
        const int tile = L >> 2, lane = lane_, ln = lane < nl ? lane : 0;
        int j, mt; bool hf;
        if (tile < totF) { const int pv = tab[130 + ln]; j = __builtin_popcountll(__ballot(lane < nl && pv <= tile)); mt = tile - tab[129 + j]; hf = false; }
        else { const int t2 = tile - totF, pv = tab[195 + ln]; j = __builtin_popcountll(__ballot(lane < nl && pv <= t2)); mt = tab[130 + j] - tab[129 + j]; hf = true; }
        u.l = l0 + j * lstep; u.mt = __builtin_amdgcn_readfirstlane(mt); u.pn = L & 3; u.ui = i; u.hf = hf; return true;
    }
    __device__ __forceinline__ bool half(const Unit& u) const { return u.hf; }
    __device__ __forceinline__ const char* a_base(const Unit& u) const { return GATHERA ? Abase : Abase + (size_t)(__builtin_amdgcn_readfirstlane(tab[64 + u.l]) + u.mt * 256) * K * 2; }
    __device__ __forceinline__ const char* b_base(const Unit& u) const { return Bbase + (size_t)((u.l >> 1) * 1024 + u.pn * 256) * K * 2; }
    __device__ __forceinline__ unsigned rowoff(const Unit& u, int r) const { return ut[u.ui * 768 + r]; }
    __device__ __forceinline__ void a_ready(const Unit&) const {}
    __device__ __forceinline__ void done(const Unit&) const {}
};
template <bool GATHERA> __device__ __forceinline__ void group_tables(const Params& p, const Ctx& c, GroupSched<GATHERA>& S, int l0, int lstep, int nl, int K, const void* Abase, const void* Bbase) {
    int* tab = (int*)(c.lds + TAB_OFF); unsigned* ut = (unsigned*)(c.lds + UT_OFF);
    const unsigned* cnt = (const unsigned*)(p.ws + WS_CTL); const int* list = (const int*)(p.ws + WS_LIST); const float* wl = (const float*)(p.ws + WS_WL); const float* RSTD = (const float*)(p.ws + WS_RSTD);
    __syncthreads();
    if (c.wave == 0) {
        const int l = c.lane, n = (int)cnt[l], rem = n & 255, hfl = (rem >= 1 && rem <= 128) ? 1 : 0, tiles = (n + 255) >> 8;
        int rb = tiles << 8, mf = tiles - hfl, mh = hfl;
#pragma unroll
        for (int o = 1; o < 64; o <<= 1) { const int sl = (l - o) & 63, a = lane_geti(rb, sl), b2 = lane_geti(mf, sl), c2 = lane_geti(mh, sl); if (l >= o) { rb += a; mf += b2; mh += c2; } }
        tab[l] = n; tab[64 + l] = rb - (tiles << 8); tab[129 + l] = mf - (tiles - hfl); tab[194 + l] = mh - hfl;
        if (l == 63) { tab[64 + 64] = rb; tab[129 + 64] = mf; tab[194 + 64] = mh; }
    }
    __syncthreads();
    S.tab = tab; S.ut = ut; S.Abase = (const char*)Abase; S.Bbase = (const char*)Bbase; S.K = K; S.G = c.nb; S.vcu = (c.nb % 8 == 0) ? (c.bid % 8) * (c.nb / 8) + c.bid / 8 : c.bid; S.l0 = l0; S.lstep = lstep; S.nl = nl; S.lane_ = c.lane;
    typename GroupSched<GATHERA>::Unit u0, u1, u2, u3;
    const bool h0 = S.next(0, u0), h1 = S.next(1, u1), h2 = S.next(2, u2), h3 = S.next(3, u3);
    if (c.tid < 256) {
        const int r = c.tid; int tok[4]; float wv[4], rs[4]; bool vd[4];
#define GT_LOAD(i, h, u) do { tok[i] = 0; wv[i] = 0.f; vd[i] = false; if (h) { const int n = tab[u.l], pos = u.mt * 256 + r; vd[i] = pos < n; const int idx = vd[i] ? pos : n - 1; \
            tok[i] = list[(size_t)u.l * T + idx]; const float w_ = wl[(size_t)u.l * T + idx]; wv[i] = vd[i] ? w_ : 0.f; } } while (0)
        GT_LOAD(0, h0, u0); GT_LOAD(1, h1, u1); GT_LOAD(2, h2, u2); GT_LOAD(3, h3, u3);
#undef GT_LOAD
        rs[0] = h0 ? RSTD[tok[0]] : 0.f; rs[1] = h1 ? RSTD[tok[1]] : 0.f; rs[2] = h2 ? RSTD[tok[2]] : 0.f; rs[3] = h3 ? RSTD[tok[3]] : 0.f;
        const bool hh[4] = {h0, h1, h2, h3};
#pragma unroll
        for (int i = 0; i < 4; ++i) if (hh[i]) {
            ut[i * 768 + r] = GATHERA ? (unsigned)tok[i] * (unsigned)(K * 2) : (vd[i] ? (unsigned)tok[i] : 0xffffffffu);
            ut[i * 768 + 256 + r] = __builtin_bit_cast(unsigned, wv[i]);
            ut[i * 768 + 512 + r] = __builtin_bit_cast(unsigned, rs[i]);
        }
    }
    __syncthreads();
}
__device__ __forceinline__ void group_tables_reuse(const Ctx& c, GroupSched<false>& S, int nl, int K, const void* Abase, const void* Bbase) {
    int* tab = (int*)(c.lds + TAB_OFF); unsigned* ut = (unsigned*)(c.lds + UT_OFF);
    S.tab = tab; S.ut = ut; S.Abase = (const char*)Abase; S.Bbase = (const char*)Bbase; S.K = K; S.G = c.nb; S.vcu = (c.nb % 8 == 0) ? (c.bid % 8) * (c.nb / 8) + c.bid / 8 : c.bid; S.l0 = 0; S.lstep = 1; S.nl = nl; S.lane_ = c.lane;
    GroupSched<false>::Unit u0, u1, u2, u3;
    const bool h0 = S.next(0, u0), h1 = S.next(1, u1), h2 = S.next(2, u2), h3 = S.next(3, u3);
    if (c.tid < 256) {
        const int r = c.tid;
#define GT_FIX(i, h, u) do { if (h) { const bool vd_ = u.mt * 256 + r < tab[u.l]; const unsigned w0_ = ut[i * 768 + r]; ut[i * 768 + r] = vd_ ? (w0_ >> 10) : 0xffffffffu; } } while (0)
        GT_FIX(0, h0, u0); GT_FIX(1, h1, u1); GT_FIX(2, h2, u2); GT_FIX(3, h3, u3);
#undef GT_FIX
    }
    __syncthreads();
}
struct EpiAct {
    static constexpr bool PERM = true, AFTER_DRAIN = false;
    unsigned char* ACT; const int* tab; const unsigned* ut;
    __device__ __forceinline__ void operator()(const f32x4 (&acc)[2][2][4][2], const GroupSched<true>::Unit& u, int wr, int wc, int fr, int fq) const {
        const int rb = tab[64 + u.l] + u.mt * 256;
#pragma unroll
        for (int ai = 0; ai < 2; ++ai)
#pragma unroll
            for (int m = 0; m < 4; ++m) {
                const int r = ai * 128 + wr * 64 + m * 16 + fr;
                const float w = __builtin_bit_cast(float, ut[u.ui * 768 + 256 + r]), rs = __builtin_bit_cast(float, ut[u.ui * 768 + 512 + r]);
                float a[8];
#pragma unroll
                for (int n = 0; n < 2; ++n)
#pragma unroll
                    for (int j = 0; j < 4; ++j) { const float g = acc[ai][0][m][n][j] * rs, up = acc[ai][1][m][n][j] * rs; a[4 * n + j] = g * __builtin_amdgcn_rcpf(1.f + __expf(-g)) * up * (w * ACT8_SCALE); }
                u32x2 o; o.x = pk4_fp8(a[0], a[1], a[2], a[3]); o.y = pk4_fp8(a[4], a[5], a[6], a[7]);
                *(u32x2*)(ACT + (size_t)(rb + r) * F + u.pn * 128 + wc * 32 + 8 * fq) = o;
            }
    }
};
struct EpiY {
    static constexpr bool PERM = true, AFTER_DRAIN = false;
    bf16_t* Y0; size_t ydelta; const unsigned* ut; const bf16_t* AO;
    __device__ __forceinline__ void operator()(const f32x4 (&acc)[2][2][4][2], const GroupSched<false>::Unit& u, int wr, int wc, int fr, int fq) const {
        bf16_t* Y = Y0 + (size_t)(u.l & 1) * ydelta;
        const int col0 = u.pn * 256 + wc * 32 + 8 * fq;
        const bool addao = !(u.l & 1);
        unsigned tok[2][4]; u32x4 aw[2][4][2];
#pragma unroll
        for (int ai = 0; ai < 2; ++ai)
#pragma unroll
            for (int m = 0; m < 4; ++m) tok[ai][m] = ut[u.ui * 768 + ai * 128 + wr * 64 + m * 16 + fr];
        if (addao) {
#pragma unroll
            for (int ai = 0; ai < 2; ++ai)
#pragma unroll
                for (int m = 0; m < 4; ++m) { const unsigned tk = tok[ai][m] != 0xffffffffu ? tok[ai][m] : 0u;
                    const bf16_t* arow = AO + (size_t)tk * D + col0; aw[ai][m][0] = *(const u32x4*)(arow); aw[ai][m][1] = *(const u32x4*)(arow + 128); }
            __builtin_amdgcn_s_waitcnt(0x0F70);
        }
#pragma unroll
        for (int ai = 0; ai < 2; ++ai)
#pragma unroll
            for (int m = 0; m < 4; ++m) {
                if (tok[ai][m] != 0xffffffffu) {
                    bf16_t* rowp = Y + (size_t)tok[ai][m] * D + col0;
#pragma unroll
                    for (int bj = 0; bj < 2; ++bj) {
                        f32x4 v0 = acc[ai][bj][m][0], v1 = acc[ai][bj][m][1];
                        if (addao) { const u32x4 a4 = aw[ai][m][bj];
                            v0 += (f32x4){bflo(a4.x), bfhi(a4.x), bflo(a4.y), bfhi(a4.y)}; v1 += (f32x4){bflo(a4.z), bfhi(a4.z), bflo(a4.w), bfhi(a4.w)}; }
                        u32x4 w; w.x = pg8::cvt_pk_bf16(v0.x, v0.y); w.y = pg8::cvt_pk_bf16(v0.z, v0.w); w.z = pg8::cvt_pk_bf16(v1.x, v1.y); w.w = pg8::cvt_pk_bf16(v1.z, v1.w);
                        *(u32x4*)(rowp + bj * 128) = w;
                    }
                }
            }
    }
};
__device__ __forceinline__ void phase4_fast(const Params& p, const Ctx& c) {
    GroupSched<true> S; group_tables<true>(p, c, S, 0, 1, NLIST, D / 2, p.ws + WS_XN, p.ws + WS_WGU);
    EpiAct E{(unsigned char*)p.out, S.tab, S.ut};
    pg8::gemm_phase<EpiAct, GroupSched<true>, true, true, true, 122, 127>((PG8_LAS unsigned char*)c.lds, D / 2, S, E, c.wave);
}
__device__ __forceinline__ void phase5_fast(const Params& p, const Ctx& c) {
    GroupSched<false> S; group_tables_reuse(c, S, NLIST, F / 2, p.out, p.ws + WS_WD);
    EpiY E{(bf16_t*)(p.ws + WS_XN), (WS_YB1 - WS_XN) / 2, S.ut, (const bf16_t*)(p.ws + WS_AO)};
    pg8::gemm_phase<EpiY, GroupSched<false>, true, true, false, 122, 123>((PG8_LAS unsigned char*)c.lds, F / 2, S, E, c.wave);
}
__device__ __forceinline__ void phase6(const Params& p, const Ctx& c) {
    const bf16_t* Y0 = (const bf16_t*)(p.ws + WS_XN); const bf16_t* Y1 = (const bf16_t*)(p.ws + WS_YB1);
    for (int t0 = c.gw; t0 < T; t0 += 2 * c.ngw) {
        f32x4 xv[2][2][2]; u32x4 ya[2][2], yb[2][2];
#pragma unroll
        for (int rr = 0; rr < 2; ++rr) { const int t = (t0 + rr * c.ngw < T) ? t0 + rr * c.ngw : t0;
#pragma unroll
            for (int hf = 0; hf < 2; ++hf) { const size_t o = (size_t)t * D + hf * 512 + 8 * c.lane;
                xv[rr][hf][0] = *(const f32x4*)(p.x + o); xv[rr][hf][1] = *(const f32x4*)(p.x + o + 4); ya[rr][hf] = *(const u32x4*)(Y0 + o); yb[rr][hf] = *(const u32x4*)(Y1 + o); } }
#pragma unroll
        for (int rr = 0; rr < 2; ++rr) { const int t = t0 + rr * c.ngw; if (t < T) {
#pragma unroll
            for (int hf = 0; hf < 2; ++hf) { const size_t o = (size_t)t * D + hf * 512 + 8 * c.lane;
                float y0[8], y1[8]; unpack8(ya[rr][hf], y0); unpack8(yb[rr][hf], y1);
                const f32x4 x0 = xv[rr][hf][0], x1 = xv[rr][hf][1]; f32x4 r0, r1;
                r0.x = x0.x + (y0[0] + y1[0]); r0.y = x0.y + (y0[1] + y1[1]); r0.z = x0.z + (y0[2] + y1[2]); r0.w = x0.w + (y0[3] + y1[3]);
                r1.x = x1.x + (y0[4] + y1[4]); r1.y = x1.y + (y0[5] + y1[5]); r1.z = x1.z + (y0[6] + y1[6]); r1.w = x1.w + (y0[7] + y1[7]);
                *(f32x4*)(p.out + o) = r0; *(f32x4*)(p.out + o + 4) = r1; } } }
    }
}

#define LAS __attribute__((address_space(3)))
#define XB_TMO      128
#define XB_XCNT(j)  (256  + 64 * (j))
#define XB_XSUB(j)  (1280 + 64 * (j))
#define XB_XGEN(j)  (2304 + 64 * (j))
#define XB_TOP      3328
#define XB_TOPGEN   3392
#define XCD_BAR_WORDS 3456
#define XB_SPIN_CAP (1u << 18)

__device__ __forceinline__ unsigned xb_ld(unsigned* p)              { return __hip_atomic_load(p, __ATOMIC_RELAXED, __HIP_MEMORY_SCOPE_AGENT); }
__device__ __forceinline__ unsigned xb_add(unsigned* p, unsigned v) { return __hip_atomic_fetch_add(p, v, __ATOMIC_RELAXED, __HIP_MEMORY_SCOPE_AGENT); }
__device__ __forceinline__ unsigned xb_xcc_id() { return (unsigned)__builtin_amdgcn_s_getreg((3 << 11) | 20) & 0xFu; }
#define XB_SPIN(cond, bar) do { unsigned _sp = 0; while (cond) { __builtin_amdgcn_s_sleep(1); \
    if ((++_sp & 255u) == 0u) { if (xb_ld(&(bar)[XB_TMO])) break; if (_sp > XB_SPIN_CAP) { atomicAdd(&(bar)[XB_TMO], 1u); break; } } } } while (0)

struct XcdBarrier {
    int w0;
    unsigned* bar; unsigned x;
    volatile LAS unsigned* st;
};

__device__ __forceinline__ XcdBarrier xcd_barrier_post(unsigned* bar, volatile LAS unsigned* st) {
    XcdBarrier b; b.bar = bar; b.x = xb_xcc_id(); b.st = st; b.w0 = __builtin_amdgcn_readfirstlane(threadIdx.x >> 6);
    if (threadIdx.x == 0) (void)xb_add(&bar[XB_XCNT(b.x)], 1u);
    return b;
}
__device__ __forceinline__ void xcd_barrier_complete(unsigned* bar, unsigned x, unsigned& nloc, unsigned& nx) {
    const unsigned G = gridDim.x * gridDim.y * gridDim.z;
    unsigned sum, cnt, mine, sp = 0u;
    for (;;) {
        sum = 0u; cnt = 0u; mine = 0u;
#pragma unroll
        for (unsigned j = 0; j < 16; ++j) { const unsigned c = xb_ld(&bar[XB_XCNT(j)]); sum += c; cnt += (c > 0u) ? 1u : 0u; mine = (j == x) ? c : mine; }
        if (sum == G) break;
        __builtin_amdgcn_s_sleep(1);
        if ((++sp & 255u) == 0u) { if (xb_ld(&bar[XB_TMO])) break; if (sp > XB_SPIN_CAP) { atomicAdd(&bar[XB_TMO], 1u); break; } }
    }
    nloc = mine > 0u ? mine : 1u; nx = cnt > 0u ? cnt : 1u;
}

__device__ __forceinline__ void xcd_barrier(const XcdBarrier& b) {
    asm volatile("s_waitcnt vmcnt(0)" ::: "memory");
    __syncthreads();
    if (b.w0 == 0 && my_lane() == 0) {
        unsigned* bar = b.bar;
        __builtin_amdgcn_s_waitcnt(0);
        unsigned nloc = b.st[0], nx = b.st[1];
        if (nloc == 0u) { xcd_barrier_complete(bar, b.x, nloc, nx); b.st[0] = nloc; b.st[1] = nx; }
        const unsigned old = xb_add(&bar[XB_XSUB(b.x)], 1u);
        const unsigned gen = old / nloc;
        if (old + 1u == (gen + 1u) * nloc) {
            __builtin_amdgcn_fence(__ATOMIC_RELEASE, "agent");
            asm volatile("s_waitcnt vmcnt(0)" ::: "memory");
            const unsigned og = xb_add(&bar[XB_TOP], 1u);
            const unsigned tg = og / nx;
            if (og + 1u != (tg + 1u) * nx) XB_SPIN((int)(xb_ld(&bar[XB_TOP]) - (tg + 1u) * nx) < 0, bar);
            __builtin_amdgcn_fence(__ATOMIC_ACQUIRE, "agent");
            xb_add(&bar[XB_XGEN(b.x)], 1u);
            asm volatile("s_waitcnt vmcnt(0)" ::: "memory");
        } else {
            XB_SPIN(xb_ld(&bar[XB_XGEN(b.x)]) == gen, bar);
            __builtin_amdgcn_fence(__ATOMIC_ACQUIRE, "agent");
            asm volatile("s_waitcnt vmcnt(0)" ::: "memory");
        }
    }
    __syncthreads();
}

__device__ __forceinline__ Ctx make_ctx(unsigned char* lds, int wave0) {
    const int tid = (wave0 & 7) * 64 + my_lane();
    Ctx c; c.tid = tid; c.lane = tid & 63; c.wave = wave0 & 7; c.bid = blockIdx.x; c.nb = gridDim.x;
    c.gw = c.bid * NWAVES + c.wave; c.ngw = c.nb * NWAVES; c.lds = lds; return c;
}
template <int PH> __device__ __forceinline__ void run_phase(const Params& p, unsigned char* lds, int wave0) {
    const Ctx c = make_ctx(lds, wave0);
    if constexpr (PH == 0) phase0(p, c);
    if constexpr (PH == 1) phase1_fast(p, c);
    if constexpr (PH == 2) {
        const attn128::bf16* PROJ = (const attn128::bf16*)(p.ws + WS_PROJ);
        const attn128::AttnTensors AT{PROJ + COL_Q, PROJ + COL_K, PROJ + COL_V, (attn128::bf16*)p.out};
        const attn128::StaticOrder S((int)gridDim.x, (int)blockIdx.x);
        struct SideJob { const Params& p; unsigned char* lds; int wave0; bool on;
            __device__ __forceinline__ void operator()() const { if (on) { __syncthreads(); const Ctx c2 = make_ctx(lds, wave0); convert_experts(p, c2); convert_late(p, c2); phase2b<2>(p, c2); __syncthreads(); } } };
        const int mode = EXPERTS_IN_ATTN ? S.vcu % 3 : 3;
        SideJob{p, lds, wave0, mode == 0}();
        attn128::attn_phase<attn128::StaticOrder, SideJob>((char*)c.lds, AT, S, SideJob{p, lds, wave0, mode == 1});
        SideJob{p, lds, wave0, mode == 2}();
    }
    if constexpr (PH == 3) phase2b<EXPERTS_IN_ATTN ? 1 : 3>(p, c);
    if constexpr (PH == 4) phase3_fast(p, c);
    if constexpr (PH == 5) phase3b<0>(p, c);
    if constexpr (PH == 6) phase4_fast(p, c);
    if constexpr (PH == 7) phase5_fast(p, c);
    if constexpr (PH == 8) phase6(p, c);
    if constexpr (PH == 9) phase3c(p, c);
}
__global__ void __launch_bounds__(NTHREADS, 2) mega_kernel(Params p) {
    extern __shared__ __attribute__((aligned(16))) unsigned char lds[];
    volatile LAS unsigned* bst = (volatile LAS unsigned*)((LAS unsigned char*)lds + BARST_OFF);
    if (threadIdx.x < 4) bst[threadIdx.x] = 0u;
    __syncthreads();
    const XcdBarrier bar = xcd_barrier_post((unsigned*)(p.ws + WS_BAR), bst);
    const int wave0 = bar.w0;
#define GSYNC() xcd_barrier(bar)
#define PH_(k) run_phase<k>(p, lds, wave0)
    PH_(0); GSYNC();
    PH_(1); GSYNC();
    PH_(2); GSYNC();
    PH_(3); GSYNC();
    PH_(4); GSYNC();
    PH_(5); GSYNC();
    PH_(9); GSYNC();
    PH_(6); GSYNC();
    PH_(7); GSYNC();
    PH_(8);
#undef PH_
#undef GSYNC
}

extern "C" void kernel_launch(void* const* d_in, const int* in_sizes, int n_in, void* d_out, int out_size, void* d_ws, size_t ws_size, hipStream_t stream) {
    static int grid = 0;
    if (grid == 0) {
        if (n_in != 19 || in_sizes[0] != T * D || out_size != T * D || ws_size < WS_END) { fprintf(stderr, "kernel_launch: unexpected shapes (n_in %d, in0 %d, out %d, ws %zu)\n", n_in, n_in > 0 ? in_sizes[0] : -1, out_size, ws_size); grid = -1; return; }
        int dev = 0, cus = 0;
        if (hipGetDevice(&dev) != hipSuccess || hipDeviceGetAttribute(&cus, hipDeviceAttributeMultiprocessorCount, dev) != hipSuccess) { grid = -1; return; }
        int per_cu = 0;
        (void)hipFuncSetAttribute((const void*)mega_kernel, hipFuncAttributeMaxDynamicSharedMemorySize, LDS_BYTES);
        if (hipOccupancyMaxActiveBlocksPerMultiprocessor(&per_cu, (const void*)mega_kernel, NTHREADS, LDS_BYTES) != hipSuccess || per_cu < 1) { fprintf(stderr, "kernel_launch: occupancy query failed (%d)\n", per_cu); (void)hipGetLastError(); per_cu = 1; }
        grid = cus;
        if (cus != 256) fprintf(stderr, "kernel_launch: built for 256 CUs (attention deal), device has %d\n", cus);
    }
    if (grid < 0) return;
    Params p{};
    const float** pf = (const float**)&p;
    for (int i = 0; i < 19; ++i) pf[i] = (const float*)d_in[i];
    p.out = (float*)d_out; p.ws = (unsigned char*)d_ws;
    if (hipMemsetAsync((char*)d_ws + WS_CTL, 0, CTL_ZERO_BYTES, stream) != hipSuccess) { fprintf(stderr, "kernel_launch: memset of the control words failed\n"); return; }
    void* args[] = {&p};
    hipError_t e = hipLaunchCooperativeKernel((const void*)mega_kernel, dim3(grid), dim3(NTHREADS), args, LDS_BYTES, stream);
    if (e != hipSuccess) fprintf(stderr, "cooperative launch failed: %s (grid %d)\n", hipGetErrorString(e), grid);
}
```

```cpp
#include <hip/hip_runtime.h>
#include <cstdio>
#include <cstdint>

#define EXPERTS_IN_ATTN 1

typedef unsigned short bf16_t;
typedef short bf16x8 __attribute__((ext_vector_type(8)));
typedef float f32x4 __attribute__((ext_vector_type(4)));
typedef unsigned u32x2 __attribute__((ext_vector_type(2)));
typedef unsigned u32x4 __attribute__((ext_vector_type(4)));
typedef int i32x4 __attribute__((ext_vector_type(4)));
typedef int i32x8 __attribute__((ext_vector_type(8)));

constexpr int BATCH = 4, SEQ = 4096, T = BATCH * SEQ, D = 1024, DIN = 3072, DCONV = 512;
constexpr int NH = 4, HD = 64, VD = 128;
constexpr int COL_XC = 0, COL_BG = 512, COL_CG = 1024, COL_Q = 1536, COL_K = 2048, COL_V = 2560;
constexpr int NG = 4, NE = 8, NEXP = NG * NE, F = 512, NLIST = NEXP * 2;
constexpr float EPS = 1e-6f;
constexpr float LOG2E = 1.4426950408889634f;
constexpr float QSCALE = 0.125f * LOG2E;
constexpr float LAM_INIT = 0.2f;
constexpr int NWAVES = 8, NTHREADS = NWAVES * 64;
constexpr int LDS_BYTES = 147456;

constexpr size_t MiB = 1u << 20;
constexpr size_t WS_CTL = 0;
constexpr size_t WS_BAR = 16384;
constexpr size_t CTL_ZERO_BYTES = 32768;
constexpr size_t WS_HIST = 384 * 1024;
constexpr size_t WS_WR = 65536;
constexpr size_t WS_RSTD = 512 * 1024;
constexpr size_t WS_LIST = 1 * MiB;
constexpr size_t WS_WL = 5 * MiB;
constexpr size_t WS_WIN = 9 * MiB;
constexpr size_t WS_WOUT = 15 * MiB;
constexpr size_t WS_WGU = 17 * MiB;
constexpr size_t WS_WD = 81 * MiB;
constexpr size_t WS_XN = 113 * MiB;
constexpr size_t WS_PROJ = 145 * MiB;
constexpr size_t WS_AO = 145 * MiB;
constexpr size_t WS_YB1 = 177 * MiB;
constexpr size_t WS_ENT = 241 * MiB;
constexpr size_t WS_END = 242 * MiB;
constexpr int ACT_ROWS_MAX = 2 * T + NLIST * 256;

struct Params {
    const float* x; const float* attn_norm_g; const float* w_in; const float* conv_w; const float* conv_out_g;
    const float* q_norm_g; const float* k_norm_g; const float* lq1; const float* lk1; const float* lq2; const float* lk2;
    const float* subln_g; const float* w_out; const float* ffn_norm_g; const float* w_rg; const float* w_re;
    const float* w_gate; const float* w_up; const float* w_down;
    float* out; unsigned char* ws;
};

__device__ __forceinline__ unsigned f2bf(float f) { unsigned u = __builtin_bit_cast(unsigned, f); return (u + 0x7fffu + ((u >> 16) & 1u)) >> 16; }
__device__ __forceinline__ unsigned pk2(float lo, float hi) { return f2bf(lo) | (f2bf(hi) << 16); }
__device__ __forceinline__ float bf2f(unsigned short b) { return __builtin_bit_cast(float, (unsigned)b << 16); }
__device__ __forceinline__ float bflo(unsigned w) { return __builtin_bit_cast(float, w << 16); }
__device__ __forceinline__ float bfhi(unsigned w) { return __builtin_bit_cast(float, w & 0xffff0000u); }
__device__ __forceinline__ int my_lane() { int l; asm volatile("v_mbcnt_lo_u32_b32 %0, -1, 0\n\tv_mbcnt_hi_u32_b32 %0, -1, %0" : "=v"(l)); return l & 63; }
__device__ __forceinline__ float lane_get(float v, int src) { return __builtin_bit_cast(float, __builtin_amdgcn_ds_bpermute(src << 2, __builtin_bit_cast(int, v))); }
__device__ __forceinline__ int lane_geti(int v, int src) { return __builtin_amdgcn_ds_bpermute(src << 2, v); }
__device__ __forceinline__ float wave_sum(float v) {
    const int ln = my_lane();
#pragma unroll
    for (int o = 1; o < 64; o <<= 1) v += lane_get(v, ln ^ o);
    return v;
}
__device__ __forceinline__ void unpack8(const u32x4 w, float (&o)[8]) {
    o[0] = bflo(w.x); o[1] = bfhi(w.x); o[2] = bflo(w.y); o[3] = bfhi(w.y); o[4] = bflo(w.z); o[5] = bfhi(w.z); o[6] = bflo(w.w); o[7] = bfhi(w.w);
}

constexpr float W8_SCALE = 32.f, ACT8_SCALE = 16.f;
__device__ __forceinline__ unsigned pk4_fp8(float a, float b, float c, float d) { int v = 0; v = __builtin_amdgcn_cvt_pk_fp8_f32(a, b, v, false); v = __builtin_amdgcn_cvt_pk_fp8_f32(c, d, v, true); return (unsigned)v; }
typedef __amdgpu_buffer_rsrc_t rsrc_t;
__device__ __forceinline__ rsrc_t wt_rsrc(const void* base, unsigned bytes) { return __builtin_amdgcn_make_buffer_rsrc((void*)base, 0, bytes, 0x00020000); }
__device__ __forceinline__ void st16_wt(rsrc_t r, unsigned off, u32x4 v) { __builtin_amdgcn_raw_buffer_store_b128(v, r, off, 0, 16); }
__device__ __forceinline__ void st4_wt(void* p, unsigned v) { __hip_atomic_store((unsigned*)p, v, __ATOMIC_RELAXED, __HIP_MEMORY_SCOPE_AGENT); }
struct Ctx { int gw, ngw, lane, wave, bid, nb, tid; unsigned char* lds; };

struct TrItem { const float* W; bf16_t* WT; int K, N, k0, n0; };
__device__ __forceinline__ TrItem tr_item(const float* W, int K, int N, bf16_t* WT, int item) { const int nblk = N / 32, kb = item / nblk, nb = item % nblk; return TrItem{W, WT, K, N, 64 * kb, 32 * nb}; }
__device__ __forceinline__ void tr_load(const TrItem& t, f32x4 (&v)[8], int lane) {
#pragma unroll
    for (int i = 0; i < 8; ++i) v[i] = __builtin_nontemporal_load((const f32x4*)(t.W + (size_t)(t.k0 + 8 * i + (lane >> 3)) * t.N + t.n0 + 4 * (lane & 7)));
}
template <class RowFn> __device__ __forceinline__ void tr_finish(const TrItem& t, const f32x4 (&v)[8], RowFn rowfn, float* scr, int lane) {
#pragma unroll
    for (int i = 0; i < 8; ++i) { float* d = scr + (8 * i + (lane >> 3)) * 33 + 4 * (lane & 7); d[0] = v[i].x; d[1] = v[i].y; d[2] = v[i].z; d[3] = v[i].w; }
    asm volatile("s_waitcnt lgkmcnt(0)" ::: "memory");
    const int c = lane & 7;
#pragma unroll
    for (int j = 0; j < 4; ++j) {
        const int n = (lane >> 3) + 8 * j; const float* sp = scr + (8 * c) * 33 + n;
        u32x4 o; o.x = pk2(sp[0 * 33], sp[1 * 33]); o.y = pk2(sp[2 * 33], sp[3 * 33]); o.z = pk2(sp[4 * 33], sp[5 * 33]); o.w = pk2(sp[6 * 33], sp[7 * 33]);
        st16_wt(wt_rsrc(t.WT, (unsigned)(t.N * t.K * 2)), (unsigned)((rowfn(t.n0 + n) * t.K + t.k0 + 8 * c) * 2), o);
    }
    asm volatile("s_waitcnt lgkmcnt(0)" ::: "memory");
}
template <class RowFn> __device__ __forceinline__ void tr_finish8(const TrItem& t, const f32x4 (&v)[8], RowFn rowfn, float* scr, int lane) {
#pragma unroll
    for (int i = 0; i < 8; ++i) { float* d = scr + (8 * i + (lane >> 3)) * 33 + 4 * (lane & 7); d[0] = v[i].x; d[1] = v[i].y; d[2] = v[i].z; d[3] = v[i].w; }
    asm volatile("s_waitcnt lgkmcnt(0)" ::: "memory");
    const int c = lane & 7; unsigned char* WT8 = (unsigned char*)t.WT;
#pragma unroll
    for (int j = 0; j < 4; ++j) {
        const int n = (lane >> 3) + 8 * j; const float* sp = scr + (8 * c) * 33 + n;
        u32x2 o; o.x = pk4_fp8(sp[0 * 33] * W8_SCALE, sp[1 * 33] * W8_SCALE, sp[2 * 33] * W8_SCALE, sp[3 * 33] * W8_SCALE); o.y = pk4_fp8(sp[4 * 33] * W8_SCALE, sp[5 * 33] * W8_SCALE, sp[6 * 33] * W8_SCALE, sp[7 * 33] * W8_SCALE);
        *(u32x2*)(WT8 + (size_t)rowfn(t.n0 + n) * t.K + t.k0 + 8 * c) = o;
    }
    asm volatile("s_waitcnt lgkmcnt(0)" ::: "memory");
}
template <class RowFn>
__device__ __forceinline__ void transpose_item(const float* __restrict__ W, int K, int N, bf16_t* __restrict__ WT, RowFn rowfn, float* scr, int item, int lane) {
    const TrItem t = tr_item(W, K, N, WT, item); f32x4 v[8]; tr_load(t, v, lane); tr_finish(t, v, rowfn, scr, lane);
}
struct RowId { __device__ __forceinline__ int operator()(int n) const { return n; } };
struct RowWin { __device__ __forceinline__ int operator()(int L) const { return (L & ~255) + ((L >> 5) & 1) * 128 + ((L >> 6) & 3) * 32 + (L & 31); } };
struct RowGU { int isup; __device__ __forceinline__ int operator()(int f) const { return (f >> 7) * 256 + isup * 128 + (f & 127); } };

struct RowGen { int kind; __device__ __forceinline__ int operator()(int f) const { return kind == 0 ? f : (f >> 7) * 256 + (kind - 1) * 128 + (f & 127); } };
__device__ __forceinline__ TrItem expert_item(const Params& p, int it, int& kind) {
    constexpr int I_G = (D / 64) * (F / 32), I_D = (F / 64) * (D / 32);
    unsigned char* Wgu8 = p.ws + WS_WGU; unsigned char* Wd8 = p.ws + WS_WD;
    const int e = it / (2 * I_G + I_D); int r = it - e * (2 * I_G + I_D);
    if (r < I_G) { kind = 1; return tr_item(p.w_gate + (size_t)e * D * F, D, F, (bf16_t*)(Wgu8 + (size_t)e * 1024 * D), r); } r -= I_G;
    if (r < I_G) { kind = 2; return tr_item(p.w_up + (size_t)e * D * F, D, F, (bf16_t*)(Wgu8 + (size_t)e * 1024 * D), r); } r -= I_G;
    kind = 0; return tr_item(p.w_down + (size_t)e * F * D, F, D, (bf16_t*)(Wd8 + (size_t)e * D * F), r);
}
__device__ __forceinline__ void convert_experts(const Params& p, const Ctx& c) {
    float* scr = (float*)(c.lds) + c.wave * (64 * 33);
    constexpr int I_G = (D / 64) * (F / 32), I_D = (F / 64) * (D / 32), NITEMS = NEXP * (2 * I_G + I_D);
    int it = c.gw;
    if (it >= NITEMS) return;
    int ka0, ka1; TrItem ta0 = expert_item(p, it, ka0); const bool ha1 = it + c.ngw < NITEMS; TrItem ta1 = expert_item(p, ha1 ? it + c.ngw : it, ka1);
    f32x4 va0[8], va1[8]; tr_load(ta0, va0, c.lane); tr_load(ta1, va1, c.lane);
    bool hcur1 = ha1;
    for (;;) {
        const int nx = it + 2 * c.ngw; const bool hn0 = nx < NITEMS, hn1 = nx + c.ngw < NITEMS;
        int kb0 = 0, kb1 = 0; TrItem tb0 = ta0, tb1 = ta1; f32x4 vb0[8], vb1[8];
        if (hn0) { tb0 = expert_item(p, nx, kb0); tb1 = expert_item(p, hn1 ? nx + c.ngw : nx, kb1); tr_load(tb0, vb0, c.lane); tr_load(tb1, vb1, c.lane); }
        tr_finish8(ta0, va0, RowGen{ka0}, scr, c.lane);
        if (hcur1) tr_finish8(ta1, va1, RowGen{ka1}, scr, c.lane);
        if (!hn0) break;
        ta0 = tb0; ta1 = tb1; ka0 = kb0; ka1 = kb1; hcur1 = hn1; it = nx;
#pragma unroll
        for (int q = 0; q < 8; ++q) { va0[q] = vb0[q]; va1[q] = vb1[q]; }
    }
}
__device__ __forceinline__ void convert_late(const Params& p, const Ctx& c) {
    float* scr = (float*)(c.lds) + c.wave * (64 * 33);
    bf16_t* Wout_t = (bf16_t*)(p.ws + WS_WOUT);
    constexpr int I_OUT = (D / 64) * (D / 32);
    for (int it = c.gw; it < I_OUT; it += c.ngw) transpose_item(p.w_out, D, D, Wout_t, RowId{}, scr, it, c.lane);
    bf16_t* Wr = (bf16_t*)(p.ws + WS_WR);
    for (int i2 = c.gw * 64 + c.lane; i2 < 48 * D / 2; i2 += c.ngw * 64) {
        const int i = 2 * i2, row = i >> 10, k = i & (D - 1), nf = row >> 4, q = (row >> 2) & 3, j = row & 3;
        float v0 = 0.f, v1 = 0.f;
        if (nf < 2) { v0 = p.w_re[(size_t)k * 32 + q * 8 + nf * 4 + j]; v1 = p.w_re[(size_t)(k + 1) * 32 + q * 8 + nf * 4 + j]; } else if (j == 0) { v0 = p.w_rg[(size_t)k * 4 + q]; v1 = p.w_rg[(size_t)(k + 1) * 4 + q]; }
        const unsigned h0 = f2bf(v0), h1 = f2bf(v1);
        st4_wt(Wr + i, h0 | (h1 << 16)); st4_wt(Wr + 48 * D + i, pk2(v0 - bf2f((unsigned short)h0), v1 - bf2f((unsigned short)h1)));
    }
}
__device__ __forceinline__ void phase0(const Params& p, const Ctx& c) {
    float* scr = (float*)(c.lds) + c.wave * (64 * 33);
    bf16_t* Win_t = (bf16_t*)(p.ws + WS_WIN);
    constexpr int I_IN = (D / 64) * (DIN / 32);
    for (int it = c.gw; it < I_IN; it += c.ngw) transpose_item(p.w_in, D, DIN, Win_t, RowWin{}, scr, it, c.lane);
#if !EXPERTS_IN_ATTN
    convert_experts(p, c); convert_late(p, c);
#endif
    const rsrc_t xnr = wt_rsrc(p.ws + WS_XN, (unsigned)(T * D * 2));
    const f32x4* gr = (const f32x4*)p.attn_norm_g + 2 * c.lane;
    for (int m = c.gw; m < T; m += 2 * c.ngw) {
        const int m2 = m + c.ngw;
        const f32x4* xa = (const f32x4*)(p.x + (size_t)m * D) + 2 * c.lane; const f32x4* xb = (const f32x4*)(p.x + (size_t)(m2 < T ? m2 : m) * D) + 2 * c.lane;
        f32x4 va[4], vb[4]; float sa = 0.f, sb = 0.f;
#pragma unroll
        for (int j = 0; j < 4; ++j) { va[j] = __builtin_nontemporal_load(xa + 128 * (j >> 1) + (j & 1)); vb[j] = __builtin_nontemporal_load(xb + 128 * (j >> 1) + (j & 1)); }
#pragma unroll
        for (int j = 0; j < 4; ++j) { sa += (va[j].x * va[j].x + va[j].y * va[j].y) + (va[j].z * va[j].z + va[j].w * va[j].w); sb += (vb[j].x * vb[j].x + vb[j].y * vb[j].y) + (vb[j].z * vb[j].z + vb[j].w * vb[j].w); }
        const float ra = rsqrtf(wave_sum(sa) * (1.f / D) + EPS), rb = rsqrtf(wave_sum(sb) * (1.f / D) + EPS);
#pragma unroll
        for (int hf = 0; hf < 2; ++hf) { const f32x4 g0 = gr[128 * hf], g1 = gr[128 * hf + 1];
            const f32x4 a0 = va[2 * hf], a1 = va[2 * hf + 1];
            u32x4 w; w.x = pk2(a0.x * ra * g0.x, a0.y * ra * g0.y); w.y = pk2(a0.z * ra * g0.z, a0.w * ra * g0.w); w.z = pk2(a1.x * ra * g1.x, a1.y * ra * g1.y); w.w = pk2(a1.z * ra * g1.z, a1.w * ra * g1.w);
            st16_wt(xnr, (unsigned)((m * D + 512 * hf + 8 * c.lane) * 2), w);
            if (m2 < T) { const f32x4 b0 = vb[2 * hf], b1 = vb[2 * hf + 1];
                u32x4 w2; w2.x = pk2(b0.x * rb * g0.x, b0.y * rb * g0.y); w2.y = pk2(b0.z * rb * g0.z, b0.w * rb * g0.w); w2.z = pk2(b1.x * rb * g1.x, b1.y * rb * g1.y); w2.w = pk2(b1.z * rb * g1.z, b1.w * rb * g1.w);
                st16_wt(xnr, (unsigned)((m2 * D + 512 * hf + 8 * c.lane) * 2), w2); } }
    }
}

namespace pg8 {
#define PG8_LAS __attribute__((address_space(3)))
typedef unsigned short bf16_t;
typedef short bf16x8 __attribute__((ext_vector_type(8)));
typedef float f32x4 __attribute__((ext_vector_type(4)));
typedef unsigned u32x4 __attribute__((ext_vector_type(4)));
constexpr int BM = 256, BK = 64, HALF = 128, HTB = HALF * BK * 2  , STAGE_BYTES = 8 * HTB, NXCD = 8, WGM = 8;

__host__ __device__ __forceinline__ int lds_byte(int r, int c) { const int st = (r >> 4) * 2 + (c >> 5), rr = r & 15, cc = c & 31, ob = rr * 64 + cc * 2; return st * 1024 + (ob ^ (((ob >> 9) & 1) << 5)); }
__host__ __device__ __forceinline__ void stage_rc(int b, int& R, int& C) { const int st = b / 1024, sb = b % 1024, swz = sb ^ (((sb >> 9) & 1) << 5); R = (st >> 1) * 16 + swz / 64; C = (st & 1) * 32 + (swz % 64) / 2; }
__host__ __device__ __forceinline__ int perm32(int rho) { const int n = rho >> 4, i = rho & 15; return 8 * (i >> 2) + 4 * n + (i & 3); }

__device__ __forceinline__ unsigned cvt_pk_bf16(float lo, float hi) { unsigned r; asm volatile("v_cvt_pk_bf16_f32 %0, %1, %2" : "=v"(r) : "v"(lo), "v"(hi)); return r; }
typedef float f32x2 __attribute__((ext_vector_type(2)));

struct DenseSched {
    struct Unit { int pm, pn; };
    const char* A; const char* Bt; int K, nM, nN, nwg, G, c;
    __device__ __forceinline__ void init(const void* A_, const void* Bt_, int M, int N, int K_, int G_, int c_) { A = (const char*)A_; Bt = (const char*)Bt_; K = K_; nM = M / BM; nN = N / BM; nwg = nM * nN; G = G_; c = c_; }
    __device__ __forceinline__ bool next(int i, Unit& u) const {
        const long L = (long)i * G + c; if (L >= nwg) return false;
        int wgid = (int)L; { const int q = nwg / NXCD, r = nwg % NXCD, xcd = wgid % NXCD, off = wgid / NXCD; wgid = (xcd < r ? xcd * (q + 1) : r * (q + 1) + (xcd - r) * q) + off; }
        const int nig = WGM * nN, gid = wgid / nig, fm = gid * WGM, gsz = (nM - fm) < WGM ? (nM - fm) : WGM;
        u.pm = fm + ((wgid % nig) % gsz); u.pn = (wgid % nig) / gsz; return true;
    }
    __device__ __forceinline__ const char* a_base(const Unit& u) const { return A + (size_t)u.pm * BM * K * 2; }
    __device__ __forceinline__ const char* b_base(const Unit& u) const { return Bt + (size_t)u.pn * BM * K * 2; }
    __device__ __forceinline__ unsigned rowoff(const Unit&, int) const { return 0u; }
    __device__ __forceinline__ bool half(const Unit&) const { return false; }
    __device__ __forceinline__ void a_ready(const Unit&) const {}
    __device__ __forceinline__ void done(const Unit&) const {}
};
template <class Epi, class Sched, bool ALIGN_EPI = false, bool SP2 = false, bool GATHER = false, int SC_W = 0, int SC_T = 0>
__device__ __forceinline__ void gemm_phase(PG8_LAS unsigned char* lds, const int K, const Sched& S, const Epi& E, const int wave_id) {
    typedef typename Sched::Unit Unit;
    const int tid_ = (wave_id & 7) * 64 + my_lane();
    const int tid = tid_, wid = __builtin_amdgcn_readfirstlane(tid >> 6), lane = tid & 63, wr = wid >> 2, wc = wid & 3, fr = lane & 15, fq = lane >> 4;
    int nt_ = K / BK; if constexpr (SC_W != 0) asm volatile("" : "+s"(nt_));
    const int nt = nt_;
    unsigned voffA[2], voffB[2]; int Rr[2]; unsigned Cc2[2];
#pragma unroll
    for (int i = 0; i < 2; ++i) { int R, C; stage_rc(tid * 16 + i * 8192, R, C); const int Rb = Epi::PERM ? ((R & ~31) + perm32(R & 31)) : R;
        voffA[i] = (unsigned)(R * K + C) * 2u; voffB[i] = (unsigned)(Rb * K + C) * 2u; Rr[i] = R; Cc2[i] = (unsigned)C * 2u; }
    unsigned cv[2][2], nv[2][2];
#define PG8_GATHER(dst, u) do { if constexpr (GATHER) { _Pragma("unroll") for (int h_ = 0; h_ < 2; ++h_) _Pragma("unroll") for (int i_ = 0; i_ < 2; ++i_) dst[h_][i_] = S.rowoff(u, Rr[i_] + HALF * h_) + Cc2[i_]; } } while (0)
    const size_t kstep = (size_t)(BK * 2);
    const size_t hstep = (size_t)HALF * K * 2;
    const unsigned ldsw = (unsigned)wid * 1024u;
    const int aoff = lds_byte(wr * 64 + fr, fq * 8), boff = lds_byte(wc * 32 + fr, fq * 8);
#define PG8_SA(b, h) (((b) * 2 + (h)) * HTB)
#define PG8_SB(b, h) ((4 + (b) * 2 + (h)) * HTB)
#define PG8_STAGE_V(bufoff, gbase, v0, v1) do { \
        __builtin_amdgcn_global_load_lds((const unsigned*)((const char*)(gbase) + (v0)), (PG8_LAS unsigned*)(lds + (bufoff) + ldsw), 16, 0, 0); \
        __builtin_amdgcn_global_load_lds((const unsigned*)((const char*)(gbase) + (v1)), (PG8_LAS unsigned*)(lds + (bufoff) + ldsw + 8192), 16, 0, 0); } while (0)
#define PG8_STAGE_B(bufoff, gbase) PG8_STAGE_V(bufoff, gbase, voffB[0], voffB[1])
#define PG8_STAGE_A(bufoff, gbase, h, nx) do { if constexpr (GATHER) { PG8_STAGE_V(bufoff, gbase, (nx) ? nv[h][0] : cv[h][0], (nx) ? nv[h][1] : cv[h][1]); } \
        else { PG8_STAGE_V(bufoff, (gbase) + (h) * hstep, voffA[0], voffA[1]); } } while (0)
#define PG8_LDA(dst, b, h) do { _Pragma("unroll") for (int m = 0; m < 4; ++m) _Pragma("unroll") for (int k = 0; k < 2; ++k) dst[m][k] = *(const PG8_LAS bf16x8*)(lds + PG8_SA(b, h) + aoff + m * 2048 + k * 1024); } while (0)
#define PG8_LDB(dst, b, h) do { _Pragma("unroll") for (int n = 0; n < 2; ++n) _Pragma("unroll") for (int k = 0; k < 2; ++k) dst[n][k] = *(const PG8_LAS bf16x8*)(lds + PG8_SB(b, h) + boff + n * 2048 + k * 1024); } while (0)
#define PG8_CAT8(x) __builtin_shufflevector(__builtin_bit_cast(i32x4, x[0]), __builtin_bit_cast(i32x4, x[1]), 0, 1, 2, 3, 4, 5, 6, 7)
#define PG8_MMA(ai, bj, At, Bt) do { __builtin_amdgcn_s_setprio(1); _Pragma("unroll") for (int m = 0; m < 4; ++m) _Pragma("unroll") for (int n = 0; n < 2; ++n) { \
        if constexpr (SC_W != 0) { const i32x8 b8_ = PG8_CAT8(Bt[n]), a8_ = PG8_CAT8(At[m]); \
            asm volatile("v_mfma_scale_f32_16x16x128_f8f6f4 %0, %1, %2, %0, %3, %4 op_sel_hi:[0,0,0]" : "+v"(acc[ai][bj][m][n]) : "v"(b8_), "v"(a8_), "v"(sc_w), "v"(sc_t)); } \
        else { _Pragma("unroll") for (int k = 0; k < 2; ++k) acc[ai][bj][m][n] = __builtin_amdgcn_mfma_f32_16x16x32_bf16(Bt[n][k], At[m][k], acc[ai][bj][m][n], 0, 0, 0); } } __builtin_amdgcn_s_setprio(0); } while (0)
#define PG8_WAIT_V(n) asm volatile("s_waitcnt vmcnt(" #n ")" ::: "memory")
#define PG8_WAIT_L(n) asm volatile("s_waitcnt lgkmcnt(" #n ")" ::: "memory")
#define PG8_BAR __builtin_amdgcn_s_barrier()
#define PG8_SCHED __builtin_amdgcn_sched_barrier(0)
    Unit cur, nxt; int ui = 0;
    if (!S.next(0, cur)) return;
    const int sc_w = SC_W * 0x01010101, sc_t = SC_T * 0x01010101;
    bool hf = S.half(cur);
    f32x4 acc[2][2][4][2];
#pragma unroll
    for (int a = 0; a < 2; ++a)
#pragma unroll
        for (int b = 0; b < 2; ++b)
#pragma unroll
            for (int m = 0; m < 4; ++m)
#pragma unroll
                for (int n = 0; n < 2; ++n) acc[a][b][m][n] = (f32x4){0.f, 0.f, 0.f, 0.f};
    bf16x8 At[4][2], B0[2][2], B1[2][2];
    const char* cA = S.a_base(cur); const char* cB = S.b_base(cur);
    S.a_ready(cur); PG8_GATHER(cv, cur);
    if constexpr (SP2) {
        PG8_STAGE_B(PG8_SB(0, 0), cB); PG8_STAGE_B(PG8_SB(0, 1), cB + hstep); PG8_STAGE_A(PG8_SA(0, 0), cA, 0, false); PG8_STAGE_A(PG8_SA(0, 1), cA, 1, false);
        if (wr == 1) PG8_BAR;
        PG8_WAIT_V(2); PG8_BAR;
        PG8_STAGE_B(PG8_SB(1, 0), cB + kstep); PG8_STAGE_A(PG8_SA(1, 0), cA + kstep, 0, false); PG8_STAGE_B(PG8_SB(1, 1), cB + hstep + kstep);
        PG8_WAIT_V(6); PG8_BAR;
    } else {
        PG8_STAGE_B(PG8_SB(0, 0), cB); PG8_STAGE_A(PG8_SA(0, 0), cA, 0, false); PG8_STAGE_B(PG8_SB(0, 1), cB + hstep); PG8_STAGE_A(PG8_SA(0, 1), cA, 1, false);
        if (wr == 1) PG8_BAR;
        PG8_WAIT_V(4); PG8_BAR;
        PG8_STAGE_B(PG8_SB(1, 0), cB + kstep); PG8_STAGE_A(PG8_SA(1, 0), cA + kstep, 0, false); PG8_STAGE_B(PG8_SB(1, 1), cB + hstep + kstep);
        PG8_WAIT_V(6); PG8_BAR;
    }
    for (;;) {
        const bool has_next = S.next(ui + 1, nxt);
        const char* nA = has_next ? S.a_base(nxt) : cA; const char* nB = has_next ? S.b_base(nxt) : cB;
        if constexpr (GATHER) { if (has_next) { PG8_GATHER(nv, nxt); } else { _Pragma("unroll") for (int h_ = 0; h_ < 2; ++h_) { nv[h_][0] = cv[h_][0]; nv[h_][1] = cv[h_][1]; } } }
        for (int t = 0; t < nt; t += 2) {
            const bool last = (t == nt - 2);
            const char* a1 = cA + (size_t)(t + 1) * kstep;
            const char* a2 = last ? nA : cA + (size_t)(t + 2) * kstep; const char* b2 = last ? nB : cB + (size_t)(t + 2) * kstep;
            const char* a3 = a2 + kstep; const char* b3 = b2 + kstep;
            if (last && has_next) S.a_ready(nxt);
            if constexpr (SP2) {
            PG8_LDB(B0, 0, 0); PG8_LDB(B1, 0, 1); PG8_SCHED; PG8_LDA(At, 0, 0); PG8_STAGE_A(PG8_SA(1, 1), a1, 1, false);
            PG8_WAIT_V(8); PG8_WAIT_L(0); PG8_BAR; PG8_MMA(0, 0, At, B0); PG8_MMA(0, 1, At, B1); PG8_BAR; PG8_SCHED;
            PG8_LDA(At, 0, 1); PG8_STAGE_B(PG8_SB(0, 0), b2); PG8_STAGE_B(PG8_SB(0, 1), b2 + hstep); PG8_STAGE_A(PG8_SA(0, 0), a2, 0, last);
            PG8_WAIT_V(8); PG8_WAIT_L(0); PG8_BAR; if (!hf) { PG8_MMA(1, 0, At, B0); PG8_MMA(1, 1, At, B1); } PG8_BAR; PG8_SCHED;
            PG8_LDB(B0, 1, 0); PG8_LDB(B1, 1, 1); PG8_SCHED; PG8_LDA(At, 1, 0); PG8_STAGE_A(PG8_SA(0, 1), a2, 1, last);
            PG8_WAIT_V(8); PG8_WAIT_L(0); PG8_BAR; PG8_MMA(0, 0, At, B0); PG8_MMA(0, 1, At, B1); PG8_BAR; PG8_SCHED;
            PG8_LDA(At, 1, 1); PG8_STAGE_B(PG8_SB(1, 0), b3); PG8_STAGE_B(PG8_SB(1, 1), b3 + hstep); PG8_STAGE_A(PG8_SA(1, 0), a3, 0, last);
            PG8_WAIT_V(8); PG8_WAIT_L(0); PG8_BAR; if (!hf) { PG8_MMA(1, 0, At, B0); PG8_MMA(1, 1, At, B1); } PG8_BAR; PG8_SCHED;
            } else {
            PG8_LDB(B0, 0, 0); PG8_SCHED; PG8_LDA(At, 0, 0); PG8_STAGE_A(PG8_SA(1, 1), a1, 1, false);
            PG8_WAIT_L(8); PG8_BAR; PG8_WAIT_L(0); PG8_MMA(0, 0, At, B0); PG8_BAR; PG8_SCHED;
            PG8_LDB(B1, 0, 1); PG8_STAGE_B(PG8_SB(0, 0), b2);
            PG8_BAR; PG8_WAIT_L(0); PG8_MMA(0, 1, At, B1); PG8_BAR;
            PG8_LDA(At, 0, 1); PG8_STAGE_A(PG8_SA(0, 0), a2, 0, last);
            PG8_BAR; PG8_WAIT_L(0); PG8_MMA(1, 0, At, B0); PG8_BAR; PG8_SCHED;
            PG8_STAGE_B(PG8_SB(0, 1), b2 + hstep);
            PG8_WAIT_V(6); PG8_BAR; PG8_MMA(1, 1, At, B1); PG8_BAR;
            PG8_LDB(B0, 1, 0); PG8_SCHED; PG8_LDA(At, 1, 0); PG8_STAGE_A(PG8_SA(0, 1), a2, 1, last);
            PG8_WAIT_L(8); PG8_BAR; PG8_WAIT_L(0); PG8_MMA(0, 0, At, B0); PG8_BAR; PG8_SCHED;
            PG8_LDB(B1, 1, 1); PG8_STAGE_B(PG8_SB(1, 0), b3);
            PG8_BAR; PG8_WAIT_L(0); PG8_MMA(0, 1, At, B1); PG8_BAR;
            PG8_LDA(At, 1, 1); PG8_STAGE_A(PG8_SA(1, 0), a3, 0, last);
            PG8_BAR; PG8_WAIT_L(0); PG8_MMA(1, 0, At, B0); PG8_BAR; PG8_SCHED;
            PG8_STAGE_B(PG8_SB(1, 1), b3 + hstep);
            PG8_WAIT_V(6); PG8_BAR; PG8_MMA(1, 1, At, B1); PG8_BAR;
            }
        }
        if constexpr (SC_W != 0) asm volatile("s_nop 15\n\ts_nop 15" ::: "memory");
        if constexpr (ALIGN_EPI) { if (wr == 0) PG8_BAR; }
        if constexpr (!Epi::AFTER_DRAIN) { E(acc, cur, wr, wc, fr, fq); S.done(cur); }
        if (!has_next) break;
#pragma unroll
        for (int a = 0; a < 2; ++a)
#pragma unroll
            for (int b = 0; b < 2; ++b)
#pragma unroll
                for (int m = 0; m < 4; ++m)
#pragma unroll
                    for (int n = 0; n < 2; ++n) acc[a][b][m][n] = (f32x4){0.f, 0.f, 0.f, 0.f};
        cur = nxt; cA = nA; cB = nB; ++ui; hf = S.half(cur);
        if constexpr (GATHER) { _Pragma("unroll") for (int h_ = 0; h_ < 2; ++h_) { cv[h_][0] = nv[h_][0]; cv[h_][1] = nv[h_][1]; } }
        if constexpr (ALIGN_EPI) { if (wr == 1) PG8_BAR; }
    }
    PG8_WAIT_V(0);
    if constexpr (!ALIGN_EPI) { if (wr == 0) PG8_BAR; }
    PG8_BAR;
    if constexpr (Epi::AFTER_DRAIN) { E.fused(acc, cur, wr, wc, fr, fq, lds, wid, lane); S.done(cur); }
#undef PG8_SA
#undef PG8_SB
#undef PG8_STAGE_V
#undef PG8_STAGE_A
#undef PG8_STAGE_B
#undef PG8_GATHER
#undef PG8_LDA
#undef PG8_LDB
#undef PG8_MMA
#undef PG8_CAT8
#undef PG8_WAIT_V
#undef PG8_WAIT_L
#undef PG8_BAR
#undef PG8_SCHED
}
}

struct EpiProj {
    static constexpr bool PERM = true, AFTER_DRAIN = false;
    bf16_t* O; const float* qg; const float* kg;
    __device__ __forceinline__ void operator()(const f32x4 (&acc)[2][2][4][2], const pg8::DenseSched::Unit& u, int wr, int wc, int fr, int fq) const {
        const int cb = u.pn * 256 + wc * 64;
        const bool isq = (cb >= COL_Q) && (cb < COL_K), isk = (cb >= COL_K) && (cb < COL_V);
        f32x4 sc[2][2];
#pragma unroll
        for (int bj = 0; bj < 2; ++bj)
#pragma unroll
            for (int n = 0; n < 2; ++n) sc[bj][n] = (f32x4){1.f, 1.f, 1.f, 1.f};
        if (isq || isk) {
            const float* gn = isq ? qg : kg; const float mlt = isq ? QSCALE : 1.f;
#pragma unroll
            for (int bj = 0; bj < 2; ++bj)
#pragma unroll
                for (int n = 0; n < 2; ++n) sc[bj][n] = *(const f32x4*)(gn + 32 * bj + 8 * fq + 4 * n) * mlt;
        }
#pragma unroll
        for (int ai = 0; ai < 2; ++ai)
#pragma unroll
            for (int m = 0; m < 4; ++m) {
                const int row = u.pm * 256 + ai * 128 + wr * 64 + m * 16 + fr;
                float mul = 1.f;
                if (isq || isk) {
                    float ss = 0.f;
#pragma unroll
                    for (int bj = 0; bj < 2; ++bj)
#pragma unroll
                        for (int n = 0; n < 2; ++n) { const f32x4 x = acc[ai][bj][m][n]; ss += (x.x * x.x + x.y * x.y) + (x.z * x.z + x.w * x.w); }
                    { const int ln = fr + 16 * fq; ss += lane_get(ss, ln ^ 16); ss += lane_get(ss, ln ^ 32); }
                    mul = rsqrtf(ss * (1.f / 64.f) + EPS);
                }
                const rsrc_t orr = wt_rsrc(O, (unsigned)(T * DIN * 2)); const unsigned roff = (unsigned)((row * DIN + cb + 8 * fq) * 2);
#pragma unroll
                for (int bj = 0; bj < 2; ++bj) {
                    const f32x4 v0 = acc[ai][bj][m][0] * sc[bj][0] * mul, v1 = acc[ai][bj][m][1] * sc[bj][1] * mul;
                    u32x4 w; w.x = pg8::cvt_pk_bf16(v0.x, v0.y); w.y = pg8::cvt_pk_bf16(v0.z, v0.w); w.z = pg8::cvt_pk_bf16(v1.x, v1.y); w.w = pg8::cvt_pk_bf16(v1.z, v1.w);
                    st16_wt(orr, roff + 64u * bj, w);
                }
            }
    }
};
struct EpiAO {
    static constexpr bool PERM = true, AFTER_DRAIN = false;
    bf16_t* O;
    __device__ __forceinline__ void operator()(const f32x4 (&acc)[2][2][4][2], const pg8::DenseSched::Unit& u, int wr, int wc, int fr, int fq) const {
        const int col0 = u.pn * 256 + wc * 32 + 8 * fq;
#pragma unroll
        for (int ai = 0; ai < 2; ++ai)
#pragma unroll
            for (int m = 0; m < 4; ++m) {
                const rsrc_t orr = wt_rsrc(O, (unsigned)(T * D * 2)); const unsigned roff = (unsigned)(((u.pm * 256 + ai * 128 + wr * 64 + m * 16 + fr) * D + col0) * 2);
#pragma unroll
                for (int bj = 0; bj < 2; ++bj) {
                    const f32x4 v0 = acc[ai][bj][m][0], v1 = acc[ai][bj][m][1];
                    u32x4 w; w.x = pg8::cvt_pk_bf16(v0.x, v0.y); w.y = pg8::cvt_pk_bf16(v0.z, v0.w); w.z = pg8::cvt_pk_bf16(v1.x, v1.y); w.w = pg8::cvt_pk_bf16(v1.z, v1.w);
                    st16_wt(orr, roff + 256u * bj, w);
                }
            }
    }
};
__device__ __forceinline__ void phase1_fast(const Params& p, const Ctx& c) {
    pg8::DenseSched S; S.init(p.ws + WS_XN, p.ws + WS_WIN, T, DIN, D, c.nb, c.bid);
    EpiProj E{(bf16_t*)(p.ws + WS_PROJ), p.q_norm_g, p.k_norm_g};
    pg8::gemm_phase<EpiProj, pg8::DenseSched, true, true, false>((PG8_LAS unsigned char*)c.lds, D, S, E, c.wave);
}
__device__ __forceinline__ void phase3_fast(const Params& p, const Ctx& c) {
    pg8::DenseSched S; S.init(p.ws + WS_XN, p.ws + WS_WOUT, T, D, D, c.nb, c.bid);
    EpiAO E{(bf16_t*)(p.ws + WS_AO)};
    pg8::gemm_phase<EpiAO, pg8::DenseSched, true, true, false>((PG8_LAS unsigned char*)c.lds, D, S, E, c.wave);
}

#include <hip/hip_bf16.h>
#include <cmath>
namespace attn128 {
using bf16=__hip_bfloat16;
using bf16x8=__attribute__((ext_vector_type(8)))short;
using s16x4=__attribute__((ext_vector_type(4)))short;
using f32x16=__attribute__((ext_vector_type(16)))float;
using u32x4=__attribute__((ext_vector_type(4)))unsigned;
constexpr int BATCH=4,NHEAD=16,SEQ=4096,D=64,DM=3072;
constexpr int NW=8,QBLK=32,QB=QBLK*NW,KVBLK=64,NQB=SEQ/QB;
constexpr int ATTN_PITCH=DM, ATTN_UNIT_ROWS=QB;
__device__ __forceinline__ int crow(int r,int hi){return (r&3)+8*(r>>2)+4*hi;}
#define SBAR() __builtin_amdgcn_sched_barrier(0)
__device__ __forceinline__ void cmask(f32x16&p0,f32x16&p1,int jb,int qrel,int hi){
  const float NEG=-INFINITY; int kb=64*jb+4*hi;
  #pragma unroll
  for(int r=0;r<16;++r){int kv=kb+(r&3)+8*(r>>2); if(kv>qrel)p0[r]=NEG; if(kv+32>qrel)p1[r]=NEG;}
}

constexpr int NSLOT=3, SLOTB=8192, VSLOTB=16384;
constexpr int LDS_K=0, LDS_V=NSLOT*SLOTB, LDS_WS=LDS_V+NSLOT*VSLOTB, LDS_OST=LDS_WS+NW*64*4, LDS_BYTES=LDS_OST+NW*8192;
constexpr float C2=0.125f*1.4426950408889634f;
__device__ __forceinline__ void glds16(const void*gbase,unsigned voff,unsigned lds_dst){unsigned keep;
  asm volatile("s_mov_b32 %0, m0\n\ts_mov_b32 m0, %3\n\ts_nop 0\n\tglobal_load_lds_dwordx4 %1, %2\n\ts_mov_b32 m0, %0":"=&s"(keep):"v"(voff),"s"(gbase),"s"(lds_dst):"memory");}
__device__ __forceinline__ float max3f(float a,float b,float c){float r;asm("v_max3_f32 %0, %1, %2, %3":"=v"(r):"v"(a),"v"(b),"v"(c));return r;}
__device__ __forceinline__ float max2f(float a,float b){float r;asm("v_max_f32_e32 %0, %1, %2":"=v"(r):"v"(a),"v"(b));return r;}
__device__ __forceinline__ float fadd_s(float a,float b){float r;asm("v_add_f32_e32 %0, %1, %2":"=v"(r):"v"(a),"v"(b));return r;}
__device__ __forceinline__ float fsub_s(float a,float b){float r;asm("v_sub_f32_e32 %0, %1, %2":"=v"(r):"v"(a),"v"(b));return r;}
typedef float f32x2_t __attribute__((ext_vector_type(2))); typedef __bf16 bf16x2_t __attribute__((ext_vector_type(2)));
__device__ __forceinline__ unsigned cvtpk_s(float lo,float hi){f32x2_t v={lo,hi};bf16x2_t b=__builtin_convertvector(v,bf16x2_t);return __builtin_bit_cast(unsigned,b);}
#define WAIT_BAR(N) asm volatile("s_waitcnt vmcnt(" #N ") lgkmcnt(0)\n\ts_barrier":::"memory")

__device__ __forceinline__ void qkt(f32x16&p0,f32x16&p1,const char*Kslot,const bf16x8*qr,int r32,int hi){ const f32x16 negm=f32x16{};
  const char*kb=Kslot+hi*1024+r32*16;
  #pragma unroll
  for(int d0=0;d0<4;++d0){
    const bf16x8 b0=*reinterpret_cast<const bf16x8*>(kb+d0*2048);
    const bf16x8 b1=*reinterpret_cast<const bf16x8*>(kb+d0*2048+512);
    if(d0==0){p0=__builtin_amdgcn_mfma_f32_32x32x16_bf16(b0,qr[0],negm,0,0,0);p1=__builtin_amdgcn_mfma_f32_32x32x16_bf16(b1,qr[0],negm,0,0,0);}
    else{p0=__builtin_amdgcn_mfma_f32_32x32x16_bf16(b0,qr[d0],p0,0,0,0);p1=__builtin_amdgcn_mfma_f32_32x32x16_bf16(b1,qr[d0],p1,0,0,0);}}
}
typedef __attribute__((address_space(3))) const char* lds_cptr;
typedef short v4i16_t __attribute__((ext_vector_type(4)));
__device__ __forceinline__ void kload8(bf16x8*kf,lds_cptr kp){
  kf[0]=*(const __attribute__((address_space(3))) bf16x8*)(kp);      kf[1]=*(const __attribute__((address_space(3))) bf16x8*)(kp+512);
  kf[2]=*(const __attribute__((address_space(3))) bf16x8*)(kp+2048); kf[3]=*(const __attribute__((address_space(3))) bf16x8*)(kp+2560);
  kf[4]=*(const __attribute__((address_space(3))) bf16x8*)(kp+4096); kf[5]=*(const __attribute__((address_space(3))) bf16x8*)(kp+4608);
  kf[6]=*(const __attribute__((address_space(3))) bf16x8*)(kp+6144); kf[7]=*(const __attribute__((address_space(3))) bf16x8*)(kp+6656);
}
__device__ __forceinline__ void kload2(bf16x8*kf,lds_cptr kp,int j){ kf[2*j]=*(const __attribute__((address_space(3))) bf16x8*)(kp+j*2048); kf[2*j+1]=*(const __attribute__((address_space(3))) bf16x8*)(kp+j*2048+512); }
__device__ __forceinline__ s16x4 vtr(lds_cptr p){ return __builtin_bit_cast(s16x4,__builtin_amdgcn_ds_read_tr16_b64_v4i16((__attribute__((address_space(3))) v4i16_t*)p)); }
__device__ __forceinline__ float rowmax(const f32x16&p0,const f32x16&p1){
  float a=max3f(p0[0],p0[1],p1[0]),b=max3f(p0[2],p0[3],p1[1]);a=max3f(a,p1[2],p1[3]);
  #pragma unroll
  for(int r=4;r<16;r+=4){a=max3f(a,p0[r],p0[r+1]);b=max3f(b,p0[r+2],p0[r+3]);a=max3f(a,p1[r],p1[r+1]);b=max3f(b,p1[r+2],p1[r+3]);}
  const float m=max2f(a,b);
  auto rr=__builtin_amdgcn_permlane32_swap(__float_as_uint(m),__float_as_uint(m),false,false);
  return max2f(__uint_as_float(rr[0]),__uint_as_float(rr[1]));
}
__device__ __forceinline__ void pv(f32x16*o,int vb,bf16x8 pa0,bf16x8 pa1,bf16x8 pa2,bf16x8 pa3){
  #pragma unroll
  for(int d0=0;d0<4;++d0){s16x4 lo[4],hi[4];
    #pragma unroll
    for(int ks=0;ks<4;++ks){
      asm volatile("ds_read_b64_tr_b16 %0,%1 offset:%c2":"=&v"(lo[ks]):"v"(vb),"i"(d0*4096+ks*1024):"memory");
      asm volatile("ds_read_b64_tr_b16 %0,%1 offset:%c2":"=&v"(hi[ks]):"v"(vb),"i"(d0*4096+ks*1024+512):"memory");}
    asm volatile("s_waitcnt lgkmcnt(0)":::"memory");SBAR();
    #define PK(k) (bf16x8){lo[k][0],lo[k][1],lo[k][2],lo[k][3],hi[k][0],hi[k][1],hi[k][2],hi[k][3]}
    o[d0]=__builtin_amdgcn_mfma_f32_32x32x16_bf16(pa0,PK(0),o[d0],0,0,0);
    o[d0]=__builtin_amdgcn_mfma_f32_32x32x16_bf16(pa1,PK(1),o[d0],0,0,0);
    o[d0]=__builtin_amdgcn_mfma_f32_32x32x16_bf16(pa2,PK(2),o[d0],0,0,0);
    o[d0]=__builtin_amdgcn_mfma_f32_32x32x16_bf16(pa3,PK(3),o[d0],0,0,0);
    #undef PK
  }
}

#ifndef ATTN_STORE16
#define ATTN_STORE16(p,v) (*(u32x4*)(p)=(v))
#endif
template<int THRL> __device__ __forceinline__ void attn_unit(int b,int h,int hv,int qb,const bf16*Q,const bf16*__restrict__ K,const bf16*__restrict__ V,bf16*O,char*shm){
  const int tid=threadIdx.x,lane=tid&63,r32=lane&31,hi=lane>>5; const int wid=__builtin_amdgcn_readfirstlane(tid>>6);
  const long rowbase=(long)b*SEQ; const int q0=qb*QB;
  const bf16*Qw=Q+(rowbase+q0+wid*QBLK)*DM+h*D;
  const bf16*Kh=K+rowbase*DM+h*D,*Vh=V+rowbase*DM+hv*128;
  const unsigned lds0=(unsigned)(uintptr_t)shm;
  float*wsf=(float*)(shm+LDS_WS)+wid*64;
  const unsigned koff=(unsigned)(lane*DM+wid*8)*2u;
  const unsigned voff=(unsigned)((16*(wid&3)+(lane>>2))*DM+(wid>>2)*32+(lane&3)*8)*2u;
  const unsigned kdst=lds0+LDS_K+wid*1024, vdst=lds0+LDS_V+wid*1024;
  #define DMA_K(t,slot) glds16(Kh+(long)(t)*KVBLK*DM,koff,(unsigned)__builtin_amdgcn_readfirstlane(kdst+(slot)))
  #define DMA_V(t,slot) do{ glds16(Vh+(long)(t)*KVBLK*DM,voff,(unsigned)__builtin_amdgcn_readfirstlane(vdst+(slot))); glds16(Vh+(long)(t)*KVBLK*DM+64,voff,(unsigned)__builtin_amdgcn_readfirstlane(vdst+(slot)+8192)); }while(0)
  const char*Kbase=shm+LDS_K; bf16x8 kf[8];
  const lds_cptr shm3=(lds_cptr)shm; const lds_cptr kp0=shm3+LDS_K+hi*1024+r32*16; const lds_cptr vp0=shm3+LDS_V+((lane>>4)&1)*32+(lane&3)*8+(4*hi+((lane&15)>>2))*64;
  const int NT=(q0+QB)/KVBLK;
  DMA_K(0,0);DMA_V(0,0);DMA_K(1,SLOTB);
  bf16x8 qr[4];
  #pragma unroll
  for(int d0=0;d0<4;++d0)qr[d0]=*reinterpret_cast<const bf16x8*>(&Qw[(long)r32*DM+d0*16+hi*8]);
  float mhat=0.f,l_reg=0.f;
  const int qrel=wid*QBLK+r32;
  #define CMASK(P0,P1,t) do{int jb_=(t)-(NT-4); if(jb_>=0)cmask(P0,P1,jb_,qrel,hi);}while(0)
  bool resc=false;
  #define START(P0,P1) do{ const float rm=rowmax(P0,P1); resc=false; \
    { const float dl=rm; mhat=fadd_s(mhat,dl); \
      _Pragma("unroll") for(int r=0;r<16;++r){P0[r]=fsub_s(P0[r],dl);P1[r]=fsub_s(P1[r],dl);} } \
    _Pragma("unroll") for(int r=0;r<16;++r)P0[r]=__builtin_amdgcn_exp2f(P0[r]); }while(0)
  #define RESC() do{ if(resc){ asm volatile("s_waitcnt lgkmcnt(0)":::"memory"); \
      _Pragma("unroll") for(int d_=0;d_<4;++d_) _Pragma("unroll") for(int r=0;r<16;++r)o[d_][r]*=wsf[crow(r,hi)]; } }while(0)
  f32x16 pA0,pA1,pB0,pB1;
  int sl_prev=0,sl_cur=0,sl_next=SLOTB;
  #define ROT() do{sl_prev=sl_cur;sl_cur=sl_next;sl_next=(sl_next==(NSLOT-1)*SLOTB)?0:sl_next+SLOTB;}while(0)
  DMA_K(2,2*SLOTB);
  WAIT_BAR(4);
  qkt(pA0,pA1,Kbase,qr,r32,hi);asm volatile("s_nop 15\n\ts_nop 7":"+v"(pA0),"+v"(pA1));CMASK(pA0,pA1,0);
  START(pA0,pA1);
  _Pragma("unroll") for(int r=0;r<16;++r)pA1[r]=__builtin_amdgcn_exp2f(pA1[r]);
  WAIT_BAR(0);
  DMA_K(3,0);DMA_V(1,VSLOTB);
  ROT();
  kload8(kf,kp0+sl_cur);
  WAIT_BAR(3);
  s16x4 vlo[8],vhi[8],wlo[8],whi[8]; u32x4 pw0,pw1,pw2,pw3;
  #define PKW(P,B) cvtpk_s(P[B],P[B+1])
  #define PAF(k) __builtin_bit_cast(bf16x8,pw##k)
  #define VFR(i) (bf16x8){vlo[i][0],vlo[i][1],vlo[i][2],vlo[i][3],vhi[i][0],vhi[i][1],vhi[i][2],vhi[i][3]}
  #define WFR(i) (bf16x8){wlo[i][0],wlo[i][1],wlo[i][2],wlo[i][3],whi[i][0],whi[i][1],whi[i][2],whi[i][3]}
  #define PIN(x) asm volatile("":"+v"(x))
  #define MX3(a,b,c) __builtin_fmaxf(__builtin_fmaxf((a),(b)),(c))
  #define GAPA(MF,A0,A1,A2,A3,W0,W1,PW) do{ MF; sacc+=A0; sacc+=A1; sacc+=A2; sacc+=A3; PIN(sacc); W0; W1; PIN(PW); SBAR(); }while(0)
  #define EX(v) __builtin_amdgcn_exp2f(v)
  #define GAPB(MF,X,B) do{ MF; X[B]=EX(X[B]-mhat); X[B+1]=EX(X[B+1]-mhat); PIN(X); SBAR(); }while(0)
  #define VOFF(s_) ((((s_)&3)*4096)+(((s_)>>2)*1024))
  #define VRD(i) do{ vlo[i]=vtr(vp_+VOFF(i)); vhi[i]=vtr(vp_+VOFF(i)+512); }while(0)
  #define WRD(i) do{ wlo[i]=vtr(vp_+VOFF(8+(i))); whi[i]=vtr(vp_+VOFF(8+(i))+512); SBAR(); }while(0)
  #define KRD(G,j) do{ if(G){ kload2(kf,kp0+sl_next,j); SBAR(); } }while(0)
  #define ZC f32x16{}
  #define STEP(C0,C1,P0,P1,t,GK,GV,GL) do{ SBAR(); \
    const lds_cptr vp_=vp0+2*sl_prev; \
    VRD(0); SBAR(); float sacc=(P0[0]+P0[1]); \
    GAPA(C0=__builtin_amdgcn_mfma_f32_32x32x16_bf16(kf[0],qr[0],ZC,0,0,0), P0[2],P0[3],P0[4],P0[5],     pw0[0]=PKW(P0,0), pw0[1]=PKW(P0,2), pw0); \
    VRD(1); SBAR(); GAPA(C1=__builtin_amdgcn_mfma_f32_32x32x16_bf16(kf[1],qr[0],ZC,0,0,0), P0[6],P0[7],P0[8],P0[9],     pw0[2]=PKW(P0,4), pw0[3]=PKW(P0,6), pw0); \
    VRD(2); SBAR(); GAPA(C0=__builtin_amdgcn_mfma_f32_32x32x16_bf16(kf[2],qr[1],C0,0,0,0),   P0[10],P0[11],P0[12],P0[13], pw1[0]=PKW(P0,8), pw1[1]=PKW(P0,10), pw1); \
    VRD(3); SBAR(); GAPA(C1=__builtin_amdgcn_mfma_f32_32x32x16_bf16(kf[3],qr[1],C1,0,0,0),   P0[14],P0[15],P1[0],P1[1],   pw1[2]=PKW(P0,12),pw1[3]=PKW(P0,14), pw1); \
    VRD(4); SBAR(); GAPA(C0=__builtin_amdgcn_mfma_f32_32x32x16_bf16(kf[4],qr[2],C0,0,0,0),   P1[2],P1[3],P1[4],P1[5],     pw2[0]=PKW(P1,0), pw2[1]=PKW(P1,2), pw2); \
    VRD(5); SBAR(); GAPA(C1=__builtin_amdgcn_mfma_f32_32x32x16_bf16(kf[5],qr[2],C1,0,0,0),   P1[6],P1[7],P1[8],P1[9],     pw2[2]=PKW(P1,4), pw2[3]=PKW(P1,6), pw2); \
    VRD(6); SBAR(); GAPA(C0=__builtin_amdgcn_mfma_f32_32x32x16_bf16(kf[6],qr[3],C0,0,0,0),   P1[10],P1[11],P1[12],P1[13], pw3[0]=PKW(P1,8), pw3[1]=PKW(P1,10), pw3); \
    VRD(7); SBAR(); GAPA(C1=__builtin_amdgcn_mfma_f32_32x32x16_bf16(kf[7],qr[3],C1,0,0,0),   P1[14],P1[15],0.f,0.f,       pw3[2]=PKW(P1,12),pw3[3]=PKW(P1,14), pw3); \
    l_reg+=sacc; \
    if(GK){DMA_K((t)+3,sl_cur);} if(GV){DMA_V((t)+1,2*sl_next);} \
    CMASK(C0,C1,t); \
    { float a=MX3(C0[0],C0[1],C1[0]),b=MX3(C0[2],C0[3],C1[1]); a=MX3(a,C1[2],C1[3]); \
      _Pragma("unroll") for(int r=4;r<16;r+=4){a=MX3(a,C0[r],C0[r+1]);b=MX3(b,C0[r+2],C0[r+3]);a=MX3(a,C1[r],C1[r+1]);b=MX3(b,C1[r+2],C1[r+3]);} \
      float rm=__builtin_fmaxf(a,b); { auto rr=__builtin_amdgcn_permlane32_swap(__float_as_uint(rm),__float_as_uint(rm),false,false); rm=__builtin_fmaxf(__uint_as_float(rr[0]),__uint_as_float(rr[1])); } \
      rm-=mhat;                                      \
      resc=false; \
      if(__builtin_expect(__any(rm>(float)THRL),0)){ const float dl=__builtin_fmaxf(rm,0.f); mhat+=dl; \
        const float f=__builtin_amdgcn_exp2f(-dl); l_reg*=f; if(hi==0)wsf[r32]=f; resc=true; } } \
    SBAR(); \
    WRD(0); GAPB(o[0]=__builtin_amdgcn_mfma_f32_32x32x16_bf16(PAF(0),VFR(0),o[0],0,0,0), C0,0); \
    WRD(1); GAPB(o[1]=__builtin_amdgcn_mfma_f32_32x32x16_bf16(PAF(0),VFR(1),o[1],0,0,0), C0,2); \
    WRD(2); KRD(GL,0); GAPB(o[2]=__builtin_amdgcn_mfma_f32_32x32x16_bf16(PAF(0),VFR(2),o[2],0,0,0), C0,4); \
    WRD(3); KRD(GL,1); GAPB(o[3]=__builtin_amdgcn_mfma_f32_32x32x16_bf16(PAF(0),VFR(3),o[3],0,0,0), C0,6); \
    WRD(4); KRD(GL,2); GAPB(o[0]=__builtin_amdgcn_mfma_f32_32x32x16_bf16(PAF(1),VFR(4),o[0],0,0,0), C0,8); \
    WRD(5); KRD(GL,3); GAPB(o[1]=__builtin_amdgcn_mfma_f32_32x32x16_bf16(PAF(1),VFR(5),o[1],0,0,0), C0,10); \
    WRD(6); GAPB(o[2]=__builtin_amdgcn_mfma_f32_32x32x16_bf16(PAF(1),VFR(6),o[2],0,0,0), C0,12); \
    WRD(7); GAPB(o[3]=__builtin_amdgcn_mfma_f32_32x32x16_bf16(PAF(1),VFR(7),o[3],0,0,0), C0,14); \
    GAPB(o[0]=__builtin_amdgcn_mfma_f32_32x32x16_bf16(PAF(2),WFR(0),o[0],0,0,0), C1,0); \
    GAPB(o[1]=__builtin_amdgcn_mfma_f32_32x32x16_bf16(PAF(2),WFR(1),o[1],0,0,0), C1,2); \
    GAPB(o[2]=__builtin_amdgcn_mfma_f32_32x32x16_bf16(PAF(2),WFR(2),o[2],0,0,0), C1,4); \
    GAPB(o[3]=__builtin_amdgcn_mfma_f32_32x32x16_bf16(PAF(2),WFR(3),o[3],0,0,0), C1,6); \
    GAPB(o[0]=__builtin_amdgcn_mfma_f32_32x32x16_bf16(PAF(3),WFR(4),o[0],0,0,0), C1,8); \
    GAPB(o[1]=__builtin_amdgcn_mfma_f32_32x32x16_bf16(PAF(3),WFR(5),o[1],0,0,0), C1,10); \
    GAPB(o[2]=__builtin_amdgcn_mfma_f32_32x32x16_bf16(PAF(3),WFR(6),o[2],0,0,0), C1,12); \
    GAPB(o[3]=__builtin_amdgcn_mfma_f32_32x32x16_bf16(PAF(3),WFR(7),o[3],0,0,0), C1,14); \
    }while(0)
  f32x16 o[4];o[0]=f32x16{};o[1]=f32x16{};o[2]=f32x16{};o[3]=f32x16{};
  int t=1;
  #undef CMASK
  #define CMASK(P0,P1,t) do{}while(0)
  for(;t+5<NT;t+=2){
    STEP(pB0,pB1,pA0,pA1,t,true,true,true);     WAIT_BAR(3); RESC(); ROT();
    STEP(pA0,pA1,pB0,pB1,t+1,true,true,true);   WAIT_BAR(3); RESC(); ROT();
  }
  #undef CMASK
  #define CMASK(P0,P1,t) do{int jb_=(t)-(NT-4); if(jb_>=0)cmask(P0,P1,jb_,qrel,hi);}while(0)
  #define ENDW(tt) do{ if((tt)+3<NT){WAIT_BAR(3);} else if((tt)+2<NT){WAIT_BAR(2);} else {WAIT_BAR(0);} }while(0)
  for(;t+1<NT;t+=2){
    STEP(pB0,pB1,pA0,pA1,t,(t+3<NT),(t+1<NT),(t+1<NT));       ENDW(t);   RESC(); ROT();
    STEP(pA0,pA1,pB0,pB1,t+1,(t+4<NT),(t+2<NT),(t+2<NT));     ENDW(t+1); RESC(); ROT();
  }
  STEP(pB0,pB1,pA0,pA1,NT-1,false,false,false); RESC();
  { float sacc=pB0[0]+pB0[1]; _Pragma("unroll") for(int r=2;r<16;++r)sacc+=pB0[r]; _Pragma("unroll") for(int r=0;r<16;++r)sacc+=pB1[r]; l_reg+=sacc;
    pw0=(u32x4){PKW(pB0,0),PKW(pB0,2),PKW(pB0,4),PKW(pB0,6)};pw1=(u32x4){PKW(pB0,8),PKW(pB0,10),PKW(pB0,12),PKW(pB0,14)};pw2=(u32x4){PKW(pB1,0),PKW(pB1,2),PKW(pB1,4),PKW(pB1,6)};pw3=(u32x4){PKW(pB1,8),PKW(pB1,10),PKW(pB1,12),PKW(pB1,14)};
    int ln_; asm volatile("v_mbcnt_lo_u32_b32 %0, -1, 0\n\tv_mbcnt_hi_u32_b32 %0, -1, %0":"=v"(ln_)); ln_&=63;
    const int vb0=(int)(lds0+LDS_V)+((ln_>>4)&1)*32+(ln_&3)*8+(4*((ln_>>5)&1)+((ln_&15)>>2))*64;
    SBAR(); pv(o,vb0+2*sl_cur,PAF(0),PAF(1),PAF(2),PAF(3)); }
  #undef PKW
  #undef PAF
  #undef VFR
  #undef WFR
  #undef VOFF
  #undef WRD
  #undef ZC
  #undef PIN
  #undef MX3
  #undef GAPA
  #undef GAPB
  #undef EX
  #undef VRD
  #undef KRD
  #undef STEP
  #undef ENDW
  {auto rr=__builtin_amdgcn_permlane32_swap(__float_as_uint(l_reg),__float_as_uint(l_reg),false,false);l_reg=__uint_as_float(rr[0])+__uint_as_float(rr[1]);}
  int le_; asm volatile("v_mbcnt_lo_u32_b32 %0, -1, 0\n\tv_mbcnt_hi_u32_b32 %0, -1, %0":"=v"(le_)); le_&=63; const int r32e=le_&31,hie=(le_>>5)&1;
  float*wsfe=(float*)(shm+LDS_WS)+wid*64;
  if(hie==0)wsfe[32+r32e]=l_reg;asm volatile("s_waitcnt lgkmcnt(0)":::"memory");
  float rli[16];
  #pragma unroll
  for(int r=0;r<16;++r)rli[r]=__builtin_amdgcn_rcpf(wsfe[32+crow(r,hie)]);
  bf16*Ow=O+(rowbase+q0+wid*QBLK)*512+hv*128;
  { bf16*stg=(bf16*)(shm+LDS_OST)+wid*4096;
    #pragma unroll
    for(int r=0;r<16;++r){const int orow=crow(r,hie);
      #pragma unroll
      for(int d0=0;d0<4;++d0)stg[orow*128+d0*32+r32e]=__float2bfloat16(o[d0][r]*rli[r]);}
    asm volatile("s_waitcnt lgkmcnt(0)":::"memory");
    const rsrc_t orr_=wt_rsrc(O,(unsigned)(16384*512*2)); const unsigned owoff_=(unsigned)(((rowbase+q0+wid*QBLK)*512+hv*128)*2);
    #pragma unroll
    for(int i=0;i<8;++i){const int row=i*4+((le_>>4)&3),ch=le_&15; const u32x4 v=*(const u32x4*)(stg+row*128+ch*8); st16_wt(orr_,owoff_+(unsigned)((row*512+ch*8)*2),v);} }
  asm volatile("s_waitcnt lgkmcnt(0)\n\ts_barrier":::"memory");
  #undef DMA_K
  #undef DMA_V
  #undef CMASK
  #undef START
  #undef RESC
  #undef ROT
}
constexpr int ATTN_LDS_BYTES=LDS_BYTES;
struct AttnTensors { const bf16* Q; const bf16* K; const bf16* V; bf16* O; };
struct AttnUnit { int bhc; int qb; };
struct StaticOrder {
  int vcu;
  __device__ __forceinline__ explicit StaticOrder(int grid,int block):vcu((block%8)*(grid/8)+block/8){}
  __device__ __forceinline__ bool next(int i,AttnUnit&u)const{ if(i>=2)return false; const int s=vcu&7; u.bhc=vcu>>3; u.qb=(i==0)?s:15-s; return true; }
};
template<class Sched,class Mid,int THRL=8> __device__ __forceinline__ void attn_phase(char*lds,const AttnTensors&T,const Sched&S,const Mid&mid){
  AttnUnit u;
  for(int i=0;S.next(i,u);++i){ if(i==1)mid(); const int b=u.bhc>>3,hh=(u.bhc>>1)&3,c=u.bhc&1; attn_unit<THRL>(b,hh*2+c,hh,u.qb,T.Q,T.K,T.V,T.O+(long)c*16384*512,lds); }
}
#undef SBAR
#undef WAIT_BAR
}


template <int PART> __device__ __forceinline__ void phase2b(const Params& p, const Ctx& c) {
    const bf16_t* PROJ = (const bf16_t*)(p.ws + WS_PROJ); const bf16_t* ATT = (const bf16_t*)p.out; const rsrc_t mixr = wt_rsrc(p.ws + WS_XN, (unsigned)(T * D * 2));
    const int lane = c.lane;
    const float d1 = wave_sum(p.lq1[lane] * p.lk1[lane]), d2 = wave_sum(p.lq2[lane] * p.lk2[lane]);
    const float lam = expf(d1) - expf(d2) + LAM_INIT;
    float sg[8], w0[8], w1[8], w2[8], cgn[8];
#pragma unroll
    for (int i = 0; i < 8; ++i) { sg[i] = p.subln_g[(8 * lane + i) & 127] * (1.f - LAM_INIT); w0[i] = p.conv_w[8 * lane + i]; w1[i] = p.conv_w[512 + 8 * lane + i]; w2[i] = p.conv_w[1024 + 8 * lane + i]; cgn[i] = p.conv_out_g[8 * lane + i]; }
    if constexpr ((PART & 1) != 0) {
        for (int t0 = c.gw; t0 < T; t0 += 4 * c.ngw) {
            u32x4 A0[4], A1[4];
#pragma unroll
            for (int r = 0; r < 4; ++r) { const int t = (t0 + r * c.ngw < T) ? t0 + r * c.ngw : t0; A0[r] = *(const u32x4*)(ATT + (size_t)t * 512 + 8 * lane); A1[r] = *(const u32x4*)(ATT + ((size_t)T + t) * 512 + 8 * lane); }
#pragma unroll
            for (int r = 0; r < 4; ++r) { const int t = t0 + r * c.ngw; if (t < T) {
                float a0[8], a1[8], o[8]; unpack8(A0[r], a0); unpack8(A1[r], a1);
                float ss = 0.f;
#pragma unroll
                for (int i = 0; i < 8; ++i) { o[i] = a0[i] - lam * a1[i]; ss += o[i] * o[i]; }
                ss += lane_get(ss, lane ^ 1); ss += lane_get(ss, lane ^ 2); ss += lane_get(ss, lane ^ 4); ss += lane_get(ss, lane ^ 8);
                const float rinv = rsqrtf(ss * (1.f / 128.f) + EPS);
                u32x4 w; w.x = pk2(o[0] * rinv * sg[0], o[1] * rinv * sg[1]); w.y = pk2(o[2] * rinv * sg[2], o[3] * rinv * sg[3]);
                w.z = pk2(o[4] * rinv * sg[4], o[5] * rinv * sg[5]); w.w = pk2(o[6] * rinv * sg[6], o[7] * rinv * sg[7]);
                st16_wt(mixr, (unsigned)((t * D + 512 + 8 * lane) * 2), w); } }
        }
    }
    if constexpr ((PART & 2) != 0) {
        for (int t0 = c.gw; t0 < T; t0 += 2 * c.ngw) {
            u32x4 X0[2], B0[2], C0[2], X1[2], C1[2], X2[2], C2[2];
#pragma unroll
            for (int r = 0; r < 2; ++r) { const int t = (t0 + r * c.ngw < T) ? t0 + r * c.ngw : t0, s = t & (SEQ - 1);
                const bf16_t* r0 = PROJ + (size_t)t * DIN + 8 * lane; const bf16_t* r1 = r0 - (s >= 1 ? DIN : 0); const bf16_t* r2 = r0 - (s >= 2 ? 2 * DIN : 0);
                X0[r] = *(const u32x4*)(r0 + COL_XC); B0[r] = *(const u32x4*)(r0 + COL_BG); C0[r] = *(const u32x4*)(r0 + COL_CG);
                X1[r] = *(const u32x4*)(r1 + COL_XC); C1[r] = *(const u32x4*)(r1 + COL_CG); X2[r] = *(const u32x4*)(r2 + COL_XC); C2[r] = *(const u32x4*)(r2 + COL_CG); }
#pragma unroll
            for (int r = 0; r < 2; ++r) { const int t = t0 + r * c.ngw; if (t < T) {
                const int s = t & (SEQ - 1); const float m1 = s >= 1 ? 1.f : 0.f, m2 = s >= 2 ? 1.f : 0.f;
                float xc[8], bg[8], cgt[8], xa[8], ca[8], xb[8], cb[8], y[8];
                unpack8(X0[r], xc); unpack8(B0[r], bg); unpack8(C0[r], cgt); unpack8(X1[r], xa); unpack8(C1[r], ca); unpack8(X2[r], xb); unpack8(C2[r], cb);
                float ss = 0.f;
#pragma unroll
                for (int i = 0; i < 8; ++i) { const float u0 = cgt[i] * xc[i], u1 = ca[i] * xa[i] * m1, u2 = cb[i] * xb[i] * m2; y[i] = bg[i] * (w0[i] * u2 + w1[i] * u1 + w2[i] * u0); ss += y[i] * y[i]; }
                ss += lane_get(ss, lane ^ 1); ss += lane_get(ss, lane ^ 2); ss += lane_get(ss, lane ^ 4);
                const float rinv = rsqrtf(ss * (1.f / 64.f) + EPS);
                u32x4 w; w.x = pk2(y[0] * rinv * cgn[0], y[1] * rinv * cgn[1]); w.y = pk2(y[2] * rinv * cgn[2], y[3] * rinv * cgn[3]);
                w.z = pk2(y[4] * rinv * cgn[4], y[5] * rinv * cgn[5]); w.w = pk2(y[6] * rinv * cgn[6], y[7] * rinv * cgn[7]);
                st16_wt(mixr, (unsigned)((t * D + 8 * lane) * 2), w); } }
        }
    }
}

constexpr int WR_PITCH = 2048 + 64;
constexpr int P3B_X_OFF = 48 * WR_PITCH;
constexpr int P3B_H_OFF = P3B_X_OFF + 16384 + 4096;
constexpr int P3B_G_OFF = P3B_X_OFF + 16384;
template <int VAR = 0> __device__ __forceinline__ void phase3b(const Params& p, const Ctx& c) {
    unsigned char* HN2 = p.ws + WS_XN;
    const bf16_t* Wr = (const bf16_t*)(p.ws + WS_WR); float* RSTD = (float*)(p.ws + WS_RSTD);
    const int fr = c.lane & 15, fq = c.lane >> 4, tg = c.wave & 3, kh = c.wave >> 2;
    unsigned char* wlds = c.lds; float* xch = (float*)(c.lds + P3B_X_OFF); float* glds = (float*)(c.lds + P3B_G_OFF);
    unsigned* hist = (unsigned*)(c.lds + P3B_H_OFF); u32x4* ENT = (u32x4*)(p.ws + WS_ENT); unsigned* HIST = (unsigned*)(p.ws + WS_HIST);
    if (c.tid < 64) hist[c.tid] = 0u;
    __syncthreads();
    { u32x4 tw[12]; f32x4 tg = (f32x4){0.f, 0.f, 0.f, 0.f};
#pragma unroll
      for (int q = 0; q < 12; ++q) { const int i = c.tid + q * NTHREADS, row = i >> 7, ch = i & 127; tw[q] = *(const u32x4*)(Wr + (size_t)row * D + ch * 8); }
      if (c.tid < D / 4) tg = *(const f32x4*)(p.ffn_norm_g + 4 * c.tid);
#pragma unroll
      for (int q = 0; q < 12; ++q) { const int i = c.tid + q * NTHREADS, row = i >> 7, ch = i & 127; *(u32x4*)(wlds + row * WR_PITCH + ch * 16) = tw[q]; }
      if (c.tid < D / 4) *(f32x4*)(glds + 4 * c.tid) = tg; }
    __syncthreads();
    for (int blk = c.bid; blk < T / 64; blk += c.nb) {
        const int t = blk * 64 + tg * 16 + fr, kbase = kh * 512;
        const float* hrow = p.x + (size_t)t * D + kbase + 8 * fq; const float* grow = glds + kbase + 8 * fq;
        const bf16_t* arow = (const bf16_t*)(p.ws + WS_AO) + (size_t)t * D + kbase + 8 * fq;
        unsigned char* orow = HN2 + (size_t)t * D + kbase + 8 * fq;
        f32x4 hb[16][2]; u32x4 ab[16];
#pragma unroll
        for (int st = 0; st < 16; ++st) { hb[st][0] = __builtin_nontemporal_load((const f32x4*)(hrow + st * 32)); hb[st][1] = __builtin_nontemporal_load((const f32x4*)(hrow + st * 32 + 4)); ab[st] = *(const u32x4*)(arow + st * 32); }
        f32x4 acc[3]; acc[0] = (f32x4){0.f, 0.f, 0.f, 0.f}; acc[1] = acc[0]; acc[2] = acc[0];
        float ss = 0.f;
        const unsigned char* wb = wlds + fr * WR_PITCH + (kbase + 8 * fq) * 2;
#pragma unroll
        for (int st = 0; st < 16; ++st) {
            const u32x4 aw = ab[st];
            const f32x4 h0 = hb[st][0] + (f32x4){bflo(aw.x), bfhi(aw.x), bflo(aw.y), bfhi(aw.y)}, h1 = hb[st][1] + (f32x4){bflo(aw.z), bfhi(aw.z), bflo(aw.w), bfhi(aw.w)};
            const f32x4 g0 = *(const f32x4*)(grow + st * 32), g1 = *(const f32x4*)(grow + st * 32 + 4);
            ss += (h0.x * h0.x + h0.y * h0.y) + (h0.z * h0.z + h0.w * h0.w) + (h1.x * h1.x + h1.y * h1.y) + (h1.z * h1.z + h1.w * h1.w);
            float a[8] = {h0.x * g0.x, h0.y * g0.y, h0.z * g0.z, h0.w * g0.w, h1.x * g1.x, h1.y * g1.y, h1.z * g1.z, h1.w * g1.w};
            u32x4 hw, lw;
#pragma unroll
            for (int i = 0; i < 4; ++i) { const unsigned ha = f2bf(a[2 * i]), hb2 = f2bf(a[2 * i + 1]); hw[i] = ha | (hb2 << 16); lw[i] = pk2(a[2 * i] - bf2f((unsigned short)ha), a[2 * i + 1] - bf2f((unsigned short)hb2)); }
            if (!(VAR & 2)) { u32x2 o8; o8.x = pk4_fp8(a[0], a[1], a[2], a[3]); o8.y = pk4_fp8(a[4], a[5], a[6], a[7]); *(u32x2*)(orow + st * 32) = o8; }
            const bf16x8 Ahi = __builtin_bit_cast(bf16x8, hw), Alo = __builtin_bit_cast(bf16x8, lw);
#pragma unroll
            for (int nf = 0; nf < 3; ++nf) {
                const bf16x8 w1 = *(const bf16x8*)(wb + nf * 16 * WR_PITCH + st * 64);
                acc[nf] = __builtin_amdgcn_mfma_f32_16x16x32_bf16(w1, Ahi, acc[nf], 0, 0, 0);
                acc[nf] = __builtin_amdgcn_mfma_f32_16x16x32_bf16(w1, Alo, acc[nf], 0, 0, 0);
            }
        }
        float* xs = xch + (tg * 64 + c.lane) * 16;
        if (kh == 1) { *(f32x4*)(xs) = acc[0]; *(f32x4*)(xs + 4) = acc[1]; *(f32x4*)(xs + 8) = acc[2]; xs[12] = ss; }
        __syncthreads();
        if (kh == 0) {
            acc[0] += *(const f32x4*)(xs); acc[1] += *(const f32x4*)(xs + 4); acc[2] += *(const f32x4*)(xs + 8); ss += xs[12];
            { const int ln = fr + 16 * fq; ss += lane_get(ss, ln ^ 16); ss += lane_get(ss, ln ^ 32); }
            const float rstd = rsqrtf(ss * (1.f / D) + EPS);
            float le[8];
#pragma unroll
            for (int j = 0; j < 4; ++j) { le[j] = acc[0][j] * rstd; le[4 + j] = acc[1][j] * rstd; }
            const float lg = acc[2][0] * rstd;
            float gl[4];
#pragma unroll
            for (int g = 0; g < 4; ++g) gl[g] = lane_get(lg, fr + 16 * g);
            int gi = 0; float gm = gl[0];
#pragma unroll
            for (int g = 1; g < 4; ++g) if (gl[g] > gm) { gm = gl[g]; gi = g; }
            float gs = 0.f;
#pragma unroll
            for (int g = 0; g < 4; ++g) gs += expf(gl[g] - gm);
            const float ggate = 1.f / gs;
            int i1 = 0; float v1 = le[0];
#pragma unroll
            for (int e = 1; e < 8; ++e) if (le[e] > v1) { v1 = le[e]; i1 = e; }
            int i2 = 0; float v2 = -INFINITY;
#pragma unroll
            for (int e = 0; e < 8; ++e) if (e != i1 && le[e] > v2) { v2 = le[e]; i2 = e; }
            const float ex = expf(v2 - v1), wa = 1.f / (1.f + ex), wb2 = ex * wa;
            if (fq == 0) RSTD[t] = rstd;
            if (!(VAR & 1) && fq == gi) {
                const int l1 = ((gi * 8 + i1) << 1), l2 = ((gi * 8 + i2) << 1) + 1;
                const unsigned r1 = __hip_atomic_fetch_add(hist + l1, 1u, __ATOMIC_RELAXED, __HIP_MEMORY_SCOPE_WORKGROUP), r2 = __hip_atomic_fetch_add(hist + l2, 1u, __ATOMIC_RELAXED, __HIP_MEMORY_SCOPE_WORKGROUP);
                u32x4* e = ENT + (size_t)blk * 128 + (tg * 16 + fr) * 2;
                e[0] = (u32x4){(unsigned)l1, r1, (unsigned)t, __builtin_bit_cast(unsigned, wa * ggate)};
                e[1] = (u32x4){(unsigned)l2, r2, (unsigned)t, __builtin_bit_cast(unsigned, wb2 * ggate)};
            }
        }
        __syncthreads();
        if (!(VAR & 1) && c.tid < 64) { HIST[blk * 64 + c.tid] = hist[c.tid]; hist[c.tid] = 0u; }
        __syncthreads();
    }
}

__device__ __forceinline__ void phase3c(const Params& p, const Ctx& c) {
    const unsigned* HIST = (const unsigned*)(p.ws + WS_HIST); const u32x4* ENT = (const u32x4*)(p.ws + WS_ENT);
    unsigned* cnt = (unsigned*)(p.ws + WS_CTL); int* list = (int*)(p.ws + WS_LIST); float* wl = (float*)(p.ws + WS_WL);
    unsigned* part = (unsigned*)c.lds;
    const int l = c.tid & 63, pt = c.tid >> 6;
    for (int blk = c.bid; blk < T / 64; blk += c.nb) {
        unsigned pre = 0u, tot = 0u;
#pragma unroll 8
        for (int b = pt * 32; b < pt * 32 + 32; ++b) { const unsigned v = HIST[b * 64 + l]; tot += v; pre += (b < blk) ? v : 0u; }
        __syncthreads();
        part[pt * 64 + l] = pre; part[512 + pt * 64 + l] = tot;
        __syncthreads();
        if (c.tid < 128) {
            const u32x4 e = ENT[(size_t)blk * 128 + c.tid];
            unsigned base = 0u;
#pragma unroll
            for (int q = 0; q < 8; ++q) base += part[q * 64 + e.x];
            const size_t pos = (size_t)e.x * T + base + e.y;
            const unsigned ez = e.z, ew = e.w;
            st4_wt(list + pos, ez); st4_wt(wl + pos, ew);
        }
        if (blk == 0 && c.tid < 64) { unsigned t2 = 0u;
#pragma unroll
            for (int q = 0; q < 8; ++q) t2 += part[512 + q * 64 + c.tid];
            st4_wt(cnt + c.tid, t2); }
    }
}

constexpr int TAB_OFF = 131072, UT_OFF = TAB_OFF + 2048, BARST_OFF = LDS_BYTES - 64;
template <bool GATHERA> struct GroupSched {
    struct Unit { int l, mt, pn, ui; bool hf; };
    const int* tab; const unsigned* ut; const char* Abase; const char* Bbase; int K, G, vcu, l0, lstep, nl; int lane_;
    __device__ __forceinline__ bool next(int i, Unit& u) const {
        const int L = i * G + vcu, totF = tab[129 + nl], totH = tab[194 + nl];
        if (L >= (totF + totH) * 4) return false;
        const int tile = L >> 2, lane = lane_, ln = lane < nl ? lane : 0;
        int j, mt; bool hf;
        if (tile < totF) { const int pv = tab[130 + ln]; j = __builtin_popcountll(__ballot(lane < nl && pv <= tile)); mt = tile - tab[129 + j]; hf = false; }
        else { const int t2 = tile - totF, pv = tab[195 + ln]; j = __builtin_popcountll(__ballot(lane < nl && pv <= t2)); mt = tab[130 + j] - tab[129 + j]; hf = true; }
        u.l = l0 + j * lstep; u.mt = __builtin_amdgcn_readfirstlane(mt); u.pn = L & 3; u.ui = i; u.hf = hf; return true;
    }
    __device__ __forceinline__ bool half(const Unit& u) const { return u.hf; }
    __device__ __forceinline__ const char* a_base(const Unit& u) const { return GATHERA ? Abase : Abase + (size_t)(__builtin_amdgcn_readfirstlane(tab[64 + u.l]) + u.mt * 256) * K * 2; }
    __device__ __forceinline__ const char* b_base(const Unit& u) const { return Bbase + (size_t)((u.l >> 1) * 1024 + u.pn * 256) * K * 2; }
    __device__ __forceinline__ unsigned rowoff(const Unit& u, int r) const { return ut[u.ui * 768 + r]; }
    __device__ __forceinline__ void a_ready(const Unit&) const {}
    __device__ __forceinline__ void done(const Unit&) const {}
};
template <bool GATHERA> __device__ __forceinline__ void group_tables(const Params& p, const Ctx& c, GroupSched<GATHERA>& S, int l0, int lstep, int nl, int K, const void* Abase, const void* Bbase) {
    int* tab = (int*)(c.lds + TAB_OFF); unsigned* ut = (unsigned*)(c.lds + UT_OFF);
    const unsigned* cnt = (const unsigned*)(p.ws + WS_CTL); const int* list = (const int*)(p.ws + WS_LIST); const float* wl = (const float*)(p.ws + WS_WL); const float* RSTD = (const float*)(p.ws + WS_RSTD);
    __syncthreads();
    if (c.wave == 0) {
        const int l = c.lane, n = (int)cnt[l], rem = n & 255, hfl = (rem >= 1 && rem <= 128) ? 1 : 0, tiles = (n + 255) >> 8;
        int rb = tiles << 8, mf = tiles - hfl, mh = hfl;
#pragma unroll
        for (int o = 1; o < 64; o <<= 1) { const int sl = (l - o) & 63, a = lane_geti(rb, sl), b2 = lane_geti(mf, sl), c2 = lane_geti(mh, sl); if (l >= o) { rb += a; mf += b2; mh += c2; } }
        tab[l] = n; tab[64 + l] = rb - (tiles << 8); tab[129 + l] = mf - (tiles - hfl); tab[194 + l] = mh - hfl;
        if (l == 63) { tab[64 + 64] = rb; tab[129 + 64] = mf; tab[194 + 64] = mh; }
    }
    __syncthreads();
    S.tab = tab; S.ut = ut; S.Abase = (const char*)Abase; S.Bbase = (const char*)Bbase; S.K = K; S.G = c.nb; S.vcu = (c.nb % 8 == 0) ? (c.bid % 8) * (c.nb / 8) + c.bid / 8 : c.bid; S.l0 = l0; S.lstep = lstep; S.nl = nl; S.lane_ = c.lane;
    typename GroupSched<GATHERA>::Unit u0, u1, u2, u3;
    const bool h0 = S.next(0, u0), h1 = S.next(1, u1), h2 = S.next(2, u2), h3 = S.next(3, u3);
    if (c.tid < 256) {
        const int r = c.tid; int tok[4]; float wv[4], rs[4]; bool vd[4];
#define GT_LOAD(i, h, u) do { tok[i] = 0; wv[i] = 0.f; vd[i] = false; if (h) { const int n = tab[u.l], pos = u.mt * 256 + r; vd[i] = pos < n; const int idx = vd[i] ? pos : n - 1; \
            tok[i] = list[(size_t)u.l * T + idx]; const float w_ = wl[(size_t)u.l * T + idx]; wv[i] = vd[i] ? w_ : 0.f; } } while (0)
        GT_LOAD(0, h0, u0); GT_LOAD(1, h1, u1); GT_LOAD(2, h2, u2); GT_LOAD(3, h3, u3);
#undef GT_LOAD
        rs[0] = h0 ? RSTD[tok[0]] : 0.f; rs[1] = h1 ? RSTD[tok[1]] : 0.f; rs[2] = h2 ? RSTD[tok[2]] : 0.f; rs[3] = h3 ? RSTD[tok[3]] : 0.f;
        const bool hh[4] = {h0, h1, h2, h3};
#pragma unroll
        for (int i = 0; i < 4; ++i) if (hh[i]) {
            ut[i * 768 + r] = GATHERA ? (unsigned)tok[i] * (unsigned)(K * 2) : (vd[i] ? (unsigned)tok[i] : 0xffffffffu);
            ut[i * 768 + 256 + r] = __builtin_bit_cast(unsigned, wv[i]);
            ut[i * 768 + 512 + r] = __builtin_bit_cast(unsigned, rs[i]);
        }
    }
    __syncthreads();
}
__device__ __forceinline__ void group_tables_reuse(const Ctx& c, GroupSched<false>& S, int nl, int K, const void* Abase, const void* Bbase) {
    int* tab = (int*)(c.lds + TAB_OFF); unsigned* ut = (unsigned*)(c.lds + UT_OFF);
    S.tab = tab; S.ut = ut; S.Abase = (const char*)Abase; S.Bbase = (const char*)Bbase; S.K = K; S.G = c.nb; S.vcu = (c.nb % 8 == 0) ? (c.bid % 8) * (c.nb / 8) + c.bid / 8 : c.bid; S.l0 = 0; S.lstep = 1; S.nl = nl; S.lane_ = c.lane;
    GroupSched<false>::Unit u0, u1, u2, u3;
    const bool h0 = S.next(0, u0), h1 = S.next(1, u1), h2 = S.next(2, u2), h3 = S.next(3, u3);
    if (c.tid < 256) {
        const int r = c.tid;
#define GT_FIX(i, h, u) do { if (h) { const bool vd_ = u.mt * 256 + r < tab[u.l]; const unsigned w0_ = ut[i * 768 + r]; ut[i * 768 + r] = vd_ ? (w0_ >> 10) : 0xffffffffu; } } while (0)
        GT_FIX(0, h0, u0); GT_FIX(1, h1, u1); GT_FIX(2, h2, u2); GT_FIX(3, h3, u3);
#undef GT_FIX
    }
    __syncthreads();
}
struct EpiAct {
    static constexpr bool PERM = true, AFTER_DRAIN = false;
    unsigned char* ACT; const int* tab; const unsigned* ut;
    __device__ __forceinline__ void operator()(const f32x4 (&acc)[2][2][4][2], const GroupSched<true>::Unit& u, int wr, int wc, int fr, int fq) const {
        const int rb = tab[64 + u.l] + u.mt * 256;
#pragma unroll
        for (int ai = 0; ai < 2; ++ai)
#pragma unroll
            for (int m = 0; m < 4; ++m) {
                const int r = ai * 128 + wr * 64 + m * 16 + fr;
                const float w = __builtin_bit_cast(float, ut[u.ui * 768 + 256 + r]), rs = __builtin_bit_cast(float, ut[u.ui * 768 + 512 + r]);
                float a[8];
#pragma unroll
                for (int n = 0; n < 2; ++n)
#pragma unroll
                    for (int j = 0; j < 4; ++j) { const float g = acc[ai][0][m][n][j] * rs, up = acc[ai][1][m][n][j] * rs; a[4 * n + j] = g * __builtin_amdgcn_rcpf(1.f + __expf(-g)) * up * (w * ACT8_SCALE); }
                u32x2 o; o.x = pk4_fp8(a[0], a[1], a[2], a[3]); o.y = pk4_fp8(a[4], a[5], a[6], a[7]);
                *(u32x2*)(ACT + (size_t)(rb + r) * F + u.pn * 128 + wc * 32 + 8 * fq) = o;
            }
    }
};
struct EpiY {
    static constexpr bool PERM = true, AFTER_DRAIN = false;
    bf16_t* Y0; size_t ydelta; const unsigned* ut; const bf16_t* AO;
    __device__ __forceinline__ void operator()(const f32x4 (&acc)[2][2][4][2], const GroupSched<false>::Unit& u, int wr, int wc, int fr, int fq) const {
        bf16_t* Y = Y0 + (size_t)(u.l & 1) * ydelta;
        const int col0 = u.pn * 256 + wc * 32 + 8 * fq;
        const bool addao = !(u.l & 1);
        unsigned tok[2][4]; u32x4 aw[2][4][2];
#pragma unroll
        for (int ai = 0; ai < 2; ++ai)
#pragma unroll
            for (int m = 0; m < 4; ++m) tok[ai][m] = ut[u.ui * 768 + ai * 128 + wr * 64 + m * 16 + fr];
        if (addao) {
#pragma unroll
            for (int ai = 0; ai < 2; ++ai)
#pragma unroll
                for (int m = 0; m < 4; ++m) { const unsigned tk = tok[ai][m] != 0xffffffffu ? tok[ai][m] : 0u;
                    const bf16_t* arow = AO + (size_t)tk * D + col0; aw[ai][m][0] = *(const u32x4*)(arow); aw[ai][m][1] = *(const u32x4*)(arow + 128); }
            __builtin_amdgcn_s_waitcnt(0x0F70);
        }
#pragma unroll
        for (int ai = 0; ai < 2; ++ai)
#pragma unroll
            for (int m = 0; m < 4; ++m) {
                if (tok[ai][m] != 0xffffffffu) {
                    const rsrc_t yr = wt_rsrc(Y, (unsigned)(T * D * 2)); const unsigned yoff = (unsigned)((tok[ai][m] * D + col0) * 2);
#pragma unroll
                    for (int bj = 0; bj < 2; ++bj) {
                        f32x4 v0 = acc[ai][bj][m][0], v1 = acc[ai][bj][m][1];
                        if (addao) { const u32x4 a4 = aw[ai][m][bj];
                            v0 += (f32x4){bflo(a4.x), bfhi(a4.x), bflo(a4.y), bfhi(a4.y)}; v1 += (f32x4){bflo(a4.z), bfhi(a4.z), bflo(a4.w), bfhi(a4.w)}; }
                        u32x4 w; w.x = pg8::cvt_pk_bf16(v0.x, v0.y); w.y = pg8::cvt_pk_bf16(v0.z, v0.w); w.z = pg8::cvt_pk_bf16(v1.x, v1.y); w.w = pg8::cvt_pk_bf16(v1.z, v1.w);
                        st16_wt(yr, yoff + 256u * bj, w);
                    }
                }
            }
    }
};
__device__ __forceinline__ void phase4_fast(const Params& p, const Ctx& c) {
    GroupSched<true> S; group_tables<true>(p, c, S, 0, 1, NLIST, D / 2, p.ws + WS_XN, p.ws + WS_WGU);
    EpiAct E{(unsigned char*)p.out, S.tab, S.ut};
    pg8::gemm_phase<EpiAct, GroupSched<true>, true, true, true, 122, 127>((PG8_LAS unsigned char*)c.lds, D / 2, S, E, c.wave);
}
__device__ __forceinline__ void phase5_fast(const Params& p, const Ctx& c) {
    GroupSched<false> S; group_tables_reuse(c, S, NLIST, F / 2, p.out, p.ws + WS_WD);
    EpiY E{(bf16_t*)(p.ws + WS_XN), (WS_YB1 - WS_XN) / 2, S.ut, (const bf16_t*)(p.ws + WS_AO)};
    pg8::gemm_phase<EpiY, GroupSched<false>, true, true, false, 122, 123>((PG8_LAS unsigned char*)c.lds, F / 2, S, E, c.wave);
}
__device__ __forceinline__ void phase6(const Params& p, const Ctx& c) {
    const bf16_t* Y0 = (const bf16_t*)(p.ws + WS_XN); const bf16_t* Y1 = (const bf16_t*)(p.ws + WS_YB1);
    for (int t0 = c.gw; t0 < T; t0 += 2 * c.ngw) {
        f32x4 xv[2][2][2]; u32x4 ya[2][2], yb[2][2];
#pragma unroll
        for (int rr = 0; rr < 2; ++rr) { const int t = (t0 + rr * c.ngw < T) ? t0 + rr * c.ngw : t0;
#pragma unroll
            for (int hf = 0; hf < 2; ++hf) { const size_t o = (size_t)t * D + hf * 512 + 8 * c.lane;
                xv[rr][hf][0] = *(const f32x4*)(p.x + o); xv[rr][hf][1] = *(const f32x4*)(p.x + o + 4); ya[rr][hf] = *(const u32x4*)(Y0 + o); yb[rr][hf] = *(const u32x4*)(Y1 + o); } }
#pragma unroll
        for (int rr = 0; rr < 2; ++rr) { const int t = t0 + rr * c.ngw; if (t < T) {
#pragma unroll
            for (int hf = 0; hf < 2; ++hf) { const size_t o = (size_t)t * D + hf * 512 + 8 * c.lane;
                float y0[8], y1[8]; unpack8(ya[rr][hf], y0); unpack8(yb[rr][hf], y1);
                const f32x4 x0 = xv[rr][hf][0], x1 = xv[rr][hf][1]; f32x4 r0, r1;
                r0.x = x0.x + (y0[0] + y1[0]); r0.y = x0.y + (y0[1] + y1[1]); r0.z = x0.z + (y0[2] + y1[2]); r0.w = x0.w + (y0[3] + y1[3]);
                r1.x = x1.x + (y0[4] + y1[4]); r1.y = x1.y + (y0[5] + y1[5]); r1.z = x1.z + (y0[6] + y1[6]); r1.w = x1.w + (y0[7] + y1[7]);
                *(f32x4*)(p.out + o) = r0; *(f32x4*)(p.out + o + 4) = r1; } } }
    }
}

#define LAS __attribute__((address_space(3)))
#define XB_TMO      128
#define XB_XCNT(j)  (256  + 64 * (j))
#define XB_XSUB(j)  (1280 + 64 * (j))
#define XB_XGEN(j)  (2304 + 64 * (j))
#define XB_TOP      3328
#define XB_TOPGEN   3392
#define XCD_BAR_WORDS 3456
#define XB_SPIN_CAP (1u << 18)

__device__ __forceinline__ unsigned xb_ld(unsigned* p)              { return __hip_atomic_load(p, __ATOMIC_RELAXED, __HIP_MEMORY_SCOPE_AGENT); }
__device__ __forceinline__ unsigned xb_add(unsigned* p, unsigned v) { return __hip_atomic_fetch_add(p, v, __ATOMIC_RELAXED, __HIP_MEMORY_SCOPE_AGENT); }
__device__ __forceinline__ unsigned xb_xcc_id() { return (unsigned)__builtin_amdgcn_s_getreg((3 << 11) | 20) & 0xFu; }
#define XB_SPIN(cond, bar) do { unsigned _sp = 0; while (cond) { __builtin_amdgcn_s_sleep(1); \
    if ((++_sp & 255u) == 0u) { if (xb_ld(&(bar)[XB_TMO])) break; if (_sp > XB_SPIN_CAP) { atomicAdd(&(bar)[XB_TMO], 1u); break; } } } } while (0)

struct XcdBarrier {
    int w0;
    unsigned* bar; unsigned x;
    volatile LAS unsigned* st;
};

__device__ __forceinline__ XcdBarrier xcd_barrier_post(unsigned* bar, volatile LAS unsigned* st) {
    XcdBarrier b; b.bar = bar; b.x = xb_xcc_id(); b.st = st; b.w0 = __builtin_amdgcn_readfirstlane(threadIdx.x >> 6);
    if (threadIdx.x == 0) (void)xb_add(&bar[XB_XCNT(b.x)], 1u);
    return b;
}
__device__ __forceinline__ void xcd_barrier_complete(unsigned* bar, unsigned x, unsigned& nloc, unsigned& nx) {
    const unsigned G = gridDim.x * gridDim.y * gridDim.z;
    unsigned sum, cnt, mine, sp = 0u;
    for (;;) {
        sum = 0u; cnt = 0u; mine = 0u;
#pragma unroll
        for (unsigned j = 0; j < 16; ++j) { const unsigned c = xb_ld(&bar[XB_XCNT(j)]); sum += c; cnt += (c > 0u) ? 1u : 0u; mine = (j == x) ? c : mine; }
        if (sum == G) break;
        __builtin_amdgcn_s_sleep(1);
        if ((++sp & 255u) == 0u) { if (xb_ld(&bar[XB_TMO])) break; if (sp > XB_SPIN_CAP) { atomicAdd(&bar[XB_TMO], 1u); break; } }
    }
    nloc = mine > 0u ? mine : 1u; nx = cnt > 0u ? cnt : 1u;
}

__device__ __forceinline__ void xcd_barrier(const XcdBarrier& b, const bool wb) {
    asm volatile("s_waitcnt vmcnt(0)" ::: "memory");
    __syncthreads();
    if (b.w0 == 0 && my_lane() == 0) {
        unsigned* bar = b.bar;
        __builtin_amdgcn_s_waitcnt(0);
        unsigned nloc = b.st[0], nx = b.st[1];
        if (nloc == 0u) { xcd_barrier_complete(bar, b.x, nloc, nx); b.st[0] = nloc; b.st[1] = nx; }
        const unsigned old = xb_add(&bar[XB_XSUB(b.x)], 1u);
        const unsigned gen = old / nloc;
        if (old + 1u == (gen + 1u) * nloc) {
            if (wb) __builtin_amdgcn_fence(__ATOMIC_RELEASE, "agent");
            asm volatile("s_waitcnt vmcnt(0)" ::: "memory");
            const unsigned og = xb_add(&bar[XB_TOP], 1u);
            const unsigned tg = og / nx;
            if (og + 1u != (tg + 1u) * nx) XB_SPIN((int)(xb_ld(&bar[XB_TOP]) - (tg + 1u) * nx) < 0, bar);
            __builtin_amdgcn_fence(__ATOMIC_ACQUIRE, "agent");
            xb_add(&bar[XB_XGEN(b.x)], 1u);
            asm volatile("s_waitcnt vmcnt(0)" ::: "memory");
        } else {
            XB_SPIN(xb_ld(&bar[XB_XGEN(b.x)]) == gen, bar);
            __builtin_amdgcn_fence(__ATOMIC_ACQUIRE, "agent");
            asm volatile("s_waitcnt vmcnt(0)" ::: "memory");
        }
    }
    __syncthreads();
}

__device__ __forceinline__ Ctx make_ctx(unsigned char* lds, int wave0) {
    const int tid = (wave0 & 7) * 64 + my_lane();
    Ctx c; c.tid = tid; c.lane = tid & 63; c.wave = wave0 & 7; c.bid = blockIdx.x; c.nb = gridDim.x;
    c.gw = c.bid * NWAVES + c.wave; c.ngw = c.nb * NWAVES; c.lds = lds; return c;
}
template <int PH> __device__ __forceinline__ void run_phase(const Params& p, unsigned char* lds, int wave0) {
    const Ctx c = make_ctx(lds, wave0);
    if constexpr (PH == 0) phase0(p, c);
    if constexpr (PH == 1) phase1_fast(p, c);
    if constexpr (PH == 2) {
        const attn128::bf16* PROJ = (const attn128::bf16*)(p.ws + WS_PROJ);
        const attn128::AttnTensors AT{PROJ + COL_Q, PROJ + COL_K, PROJ + COL_V, (attn128::bf16*)p.out};
        const attn128::StaticOrder S((int)gridDim.x, (int)blockIdx.x);
        struct SideJob { const Params& p; unsigned char* lds; int wave0; bool on;
            __device__ __forceinline__ void operator()() const { if (on) { __syncthreads(); const Ctx c2 = make_ctx(lds, wave0); convert_experts(p, c2); convert_late(p, c2); phase2b<2>(p, c2); __syncthreads(); } } };
        const int mode = EXPERTS_IN_ATTN ? S.vcu % 3 : 3;
        SideJob{p, lds, wave0, mode == 0}();
        attn128::attn_phase<attn128::StaticOrder, SideJob>((char*)c.lds, AT, S, SideJob{p, lds, wave0, mode == 1});
        SideJob{p, lds, wave0, mode == 2}();
    }
    if constexpr (PH == 3) phase2b<EXPERTS_IN_ATTN ? 1 : 3>(p, c);
    if constexpr (PH == 4) phase3_fast(p, c);
    if constexpr (PH == 5) phase3b<0>(p, c);
    if constexpr (PH == 6) phase4_fast(p, c);
    if constexpr (PH == 7) phase5_fast(p, c);
    if constexpr (PH == 8) phase6(p, c);
    if constexpr (PH == 9) phase3c(p, c);
}
__global__ void __launch_bounds__(NTHREADS, 2) mega_kernel(Params p) {
    extern __shared__ __attribute__((aligned(16))) unsigned char lds[];
    volatile LAS unsigned* bst = (volatile LAS unsigned*)((LAS unsigned char*)lds + BARST_OFF);
    if (threadIdx.x < 4) bst[threadIdx.x] = 0u;
    __syncthreads();
    const XcdBarrier bar = xcd_barrier_post((unsigned*)(p.ws + WS_BAR), bst);
    const int wave0 = bar.w0;
#define GSYNC() xcd_barrier(bar, true)
#define GSYNC_WB() xcd_barrier(bar, true)
#define PH_(k) run_phase<k>(p, lds, wave0)
    PH_(0); GSYNC();
    PH_(1); GSYNC();
    PH_(2); GSYNC();
    PH_(3); GSYNC();
    PH_(4); GSYNC();
    PH_(5); GSYNC_WB();
    PH_(9); GSYNC();
    PH_(6); GSYNC_WB();
    PH_(7); GSYNC();
    PH_(8);
#undef PH_
#undef GSYNC
#undef GSYNC_WB
}

extern "C" void kernel_launch(void* const* d_in, const int* in_sizes, int n_in, void* d_out, int out_size, void* d_ws, size_t ws_size, hipStream_t stream) {
    static int grid = 0;
    if (grid == 0) {
        if (n_in != 19 || in_sizes[0] != T * D || out_size != T * D || ws_size < WS_END) { fprintf(stderr, "kernel_launch: unexpected shapes (n_in %d, in0 %d, out %d, ws %zu)\n", n_in, n_in > 0 ? in_sizes[0] : -1, out_size, ws_size); grid = -1; return; }
        int dev = 0, cus = 0;
        if (hipGetDevice(&dev) != hipSuccess || hipDeviceGetAttribute(&cus, hipDeviceAttributeMultiprocessorCount, dev) != hipSuccess) { grid = -1; return; }
        int per_cu = 0;
        (void)hipFuncSetAttribute((const void*)mega_kernel, hipFuncAttributeMaxDynamicSharedMemorySize, LDS_BYTES);
        if (hipOccupancyMaxActiveBlocksPerMultiprocessor(&per_cu, (const void*)mega_kernel, NTHREADS, LDS_BYTES) != hipSuccess || per_cu < 1) { fprintf(stderr, "kernel_launch: occupancy query failed (%d)\n", per_cu); (void)hipGetLastError(); per_cu = 1; }
        grid = cus;
        if (cus != 256) fprintf(stderr, "kernel_launch: built for 256 CUs (attention deal), device has %d\n", cus);
    }
    if (grid < 0) return;
    Params p{};
    const float** pf = (const float**)&p;
    for (int i = 0; i < 19; ++i) pf[i] = (const float*)d_in[i];
    p.out = (float*)d_out; p.ws = (unsigned char*)d_ws;
    if (hipMemsetAsync((char*)d_ws + WS_CTL, 0, CTL_ZERO_BYTES, stream) != hipSuccess) { fprintf(stderr, "kernel_launch: memset of the control words failed\n"); return; }
    void* args[] = {&p};
    hipError_t e = hipLaunchCooperativeKernel((const void*)mega_kernel, dim3(grid), dim3(NTHREADS), args, LDS_BYTES, stream);
    if (e != hipSuccess) fprintf(stderr, "cooperative launch failed: %s (grid %d)\n", hipGetErrorString(e), grid);
}
```

```cpp
#include <hip/hip_runtime.h>
#include <cstdio>
#include <cstdint>

#define EXPERTS_IN_ATTN 1

typedef unsigned short bf16_t;
typedef short bf16x8 __attribute__((ext_vector_type(8)));
typedef float f32x4 __attribute__((ext_vector_type(4)));
typedef unsigned u32x2 __attribute__((ext_vector_type(2)));
typedef unsigned u32x4 __attribute__((ext_vector_type(4)));
typedef int i32x4 __attribute__((ext_vector_type(4)));
typedef int i32x8 __attribute__((ext_vector_type(8)));

constexpr int BATCH = 4, SEQ = 4096, T = BATCH * SEQ, D = 1024, DIN = 3072, DCONV = 512;
constexpr int NH = 4, HD = 64, VD = 128;
constexpr int COL_XC = 0, COL_BG = 512, COL_CG = 1024, COL_Q = 1536, COL_K = 2048, COL_V = 2560;
constexpr int NG = 4, NE = 8, NEXP = NG * NE, F = 512, NLIST = NEXP * 2;
constexpr float EPS = 1e-6f;
constexpr float LOG2E = 1.4426950408889634f;
constexpr float QSCALE = 0.125f * LOG2E;
constexpr float LAM_INIT = 0.2f;
constexpr int NWAVES = 8, NTHREADS = NWAVES * 64;
constexpr int LDS_BYTES = 147456;

constexpr size_t MiB = 1u << 20;
constexpr size_t WS_CTL = 0;
constexpr size_t WS_BAR = 16384;
constexpr size_t CTL_ZERO_BYTES = 32768;
constexpr size_t WS_HIST = 384 * 1024;
constexpr size_t WS_WR = 65536;
constexpr size_t WS_RSTD = 512 * 1024;
constexpr size_t WS_LIST = 1 * MiB;
constexpr size_t WS_WL = 5 * MiB;
constexpr size_t WS_WIN = 9 * MiB;
constexpr size_t WS_WOUT = 15 * MiB;
constexpr size_t WS_WGU = 17 * MiB;
constexpr size_t WS_WD = 81 * MiB;
constexpr size_t WS_XN = 113 * MiB;
constexpr size_t WS_PROJ = 145 * MiB;
constexpr size_t WS_AO = 145 * MiB;
constexpr size_t WS_YB1 = 177 * MiB;
constexpr size_t WS_ENT = 241 * MiB;
constexpr size_t WS_END = 242 * MiB;
constexpr int ACT_ROWS_MAX = 2 * T + NLIST * 256;

struct Params {
    const float* x; const float* attn_norm_g; const float* w_in; const float* conv_w; const float* conv_out_g;
    const float* q_norm_g; const float* k_norm_g; const float* lq1; const float* lk1; const float* lq2; const float* lk2;
    const float* subln_g; const float* w_out; const float* ffn_norm_g; const float* w_rg; const float* w_re;
    const float* w_gate; const float* w_up; const float* w_down;
    float* out; unsigned char* ws;
};

__device__ __forceinline__ unsigned f2bf(float f) { unsigned u = __builtin_bit_cast(unsigned, f); return (u + 0x7fffu + ((u >> 16) & 1u)) >> 16; }
__device__ __forceinline__ unsigned pk2(float lo, float hi) { return f2bf(lo) | (f2bf(hi) << 16); }
__device__ __forceinline__ float bf2f(unsigned short b) { return __builtin_bit_cast(float, (unsigned)b << 16); }
__device__ __forceinline__ float bflo(unsigned w) { return __builtin_bit_cast(float, w << 16); }
__device__ __forceinline__ float bfhi(unsigned w) { return __builtin_bit_cast(float, w & 0xffff0000u); }
__device__ __forceinline__ int my_lane() { int l; asm volatile("v_mbcnt_lo_u32_b32 %0, -1, 0\n\tv_mbcnt_hi_u32_b32 %0, -1, %0" : "=v"(l)); return l & 63; }
__device__ __forceinline__ float lane_get(float v, int src) { return __builtin_bit_cast(float, __builtin_amdgcn_ds_bpermute(src << 2, __builtin_bit_cast(int, v))); }
__device__ __forceinline__ int lane_geti(int v, int src) { return __builtin_amdgcn_ds_bpermute(src << 2, v); }
__device__ __forceinline__ float wave_sum(float v) {
    const int ln = my_lane();
#pragma unroll
    for (int o = 1; o < 64; o <<= 1) v += lane_get(v, ln ^ o);
    return v;
}
__device__ __forceinline__ void unpack8(const u32x4 w, float (&o)[8]) {
    o[0] = bflo(w.x); o[1] = bfhi(w.x); o[2] = bflo(w.y); o[3] = bfhi(w.y); o[4] = bflo(w.z); o[5] = bfhi(w.z); o[6] = bflo(w.w); o[7] = bfhi(w.w);
}

constexpr float W8_SCALE = 32.f, ACT8_SCALE = 16.f;
__device__ __forceinline__ unsigned pk4_fp8(float a, float b, float c, float d) { int v = 0; v = __builtin_amdgcn_cvt_pk_fp8_f32(a, b, v, false); v = __builtin_amdgcn_cvt_pk_fp8_f32(c, d, v, true); return (unsigned)v; }
typedef __amdgpu_buffer_rsrc_t rsrc_t;
__device__ __forceinline__ rsrc_t wt_rsrc(const void* base, unsigned bytes) { return __builtin_amdgcn_make_buffer_rsrc((void*)base, 0, bytes, 0x00020000); }
__device__ __forceinline__ void st16_wt(rsrc_t r, unsigned off, u32x4 v) { __builtin_amdgcn_raw_buffer_store_b128(v, r, off, 0, 16); }
__device__ __forceinline__ void st4_wt(void* p, unsigned v) { __hip_atomic_store((unsigned*)p, v, __ATOMIC_RELAXED, __HIP_MEMORY_SCOPE_AGENT); }
struct Ctx { int gw, ngw, lane, wave, bid, nb, tid; unsigned char* lds; };

struct TrItem { const float* W; bf16_t* WT; int K, N, k0, n0; };
__device__ __forceinline__ TrItem tr_item(const float* W, int K, int N, bf16_t* WT, int item) { const int nblk = N / 32, kb = item / nblk, nb = item % nblk; return TrItem{W, WT, K, N, 64 * kb, 32 * nb}; }
__device__ __forceinline__ void tr_load(const TrItem& t, f32x4 (&v)[8], int lane) {
#pragma unroll
    for (int i = 0; i < 8; ++i) v[i] = __builtin_nontemporal_load((const f32x4*)(t.W + (size_t)(t.k0 + 8 * i + (lane >> 3)) * t.N + t.n0 + 4 * (lane & 7)));
}
template <class RowFn> __device__ __forceinline__ void tr_finish(const TrItem& t, const f32x4 (&v)[8], RowFn rowfn, float* scr, int lane) {
#pragma unroll
    for (int i = 0; i < 8; ++i) { float* d = scr + (8 * i + (lane >> 3)) * 33 + 4 * (lane & 7); d[0] = v[i].x; d[1] = v[i].y; d[2] = v[i].z; d[3] = v[i].w; }
    asm volatile("s_waitcnt lgkmcnt(0)" ::: "memory");
    const int c = lane & 7;
#pragma unroll
    for (int j = 0; j < 4; ++j) {
        const int n = (lane >> 3) + 8 * j; const float* sp = scr + (8 * c) * 33 + n;
        u32x4 o; o.x = pk2(sp[0 * 33], sp[1 * 33]); o.y = pk2(sp[2 * 33], sp[3 * 33]); o.z = pk2(sp[4 * 33], sp[5 * 33]); o.w = pk2(sp[6 * 33], sp[7 * 33]);
        st16_wt(wt_rsrc(t.WT, (unsigned)(t.N * t.K * 2)), (unsigned)((rowfn(t.n0 + n) * t.K + t.k0 + 8 * c) * 2), o);
    }
    asm volatile("s_waitcnt lgkmcnt(0)" ::: "memory");
}
template <class RowFn> __device__ __forceinline__ void tr_finish8(const TrItem& t, const f32x4 (&v)[8], RowFn rowfn, float* scr, int lane) {
#pragma unroll
    for (int i = 0; i < 8; ++i) { float* d = scr + (8 * i + (lane >> 3)) * 33 + 4 * (lane & 7); d[0] = v[i].x; d[1] = v[i].y; d[2] = v[i].z; d[3] = v[i].w; }
    asm volatile("s_waitcnt lgkmcnt(0)" ::: "memory");
    const int c = lane & 7; unsigned char* WT8 = (unsigned char*)t.WT;
#pragma unroll
    for (int j = 0; j < 4; ++j) {
        const int n = (lane >> 3) + 8 * j; const float* sp = scr + (8 * c) * 33 + n;
        u32x2 o; o.x = pk4_fp8(sp[0 * 33] * W8_SCALE, sp[1 * 33] * W8_SCALE, sp[2 * 33] * W8_SCALE, sp[3 * 33] * W8_SCALE); o.y = pk4_fp8(sp[4 * 33] * W8_SCALE, sp[5 * 33] * W8_SCALE, sp[6 * 33] * W8_SCALE, sp[7 * 33] * W8_SCALE);
        *(u32x2*)(WT8 + (size_t)rowfn(t.n0 + n) * t.K + t.k0 + 8 * c) = o;
    }
    asm volatile("s_waitcnt lgkmcnt(0)" ::: "memory");
}
template <class RowFn>
__device__ __forceinline__ void transpose_item(const float* __restrict__ W, int K, int N, bf16_t* __restrict__ WT, RowFn rowfn, float* scr, int item, int lane) {
    const TrItem t = tr_item(W, K, N, WT, item); f32x4 v[8]; tr_load(t, v, lane); tr_finish(t, v, rowfn, scr, lane);
}
struct RowId { __device__ __forceinline__ int operator()(int n) const { return n; } };
struct RowWin { __device__ __forceinline__ int operator()(int L) const { return (L & ~255) + ((L >> 5) & 1) * 128 + ((L >> 6) & 3) * 32 + (L & 31); } };
struct RowGU { int isup; __device__ __forceinline__ int operator()(int f) const { return (f >> 7) * 256 + isup * 128 + (f & 127); } };

struct RowGen { int kind; __device__ __forceinline__ int operator()(int f) const { return kind == 0 ? f : (f >> 7) * 256 + (kind - 1) * 128 + (f & 127); } };
__device__ __forceinline__ TrItem expert_item(const Params& p, int it, int& kind) {
    constexpr int I_G = (D / 64) * (F / 32), I_D = (F / 64) * (D / 32);
    unsigned char* Wgu8 = p.ws + WS_WGU; unsigned char* Wd8 = p.ws + WS_WD;
    const int e = it / (2 * I_G + I_D); int r = it - e * (2 * I_G + I_D);
    if (r < I_G) { kind = 1; return tr_item(p.w_gate + (size_t)e * D * F, D, F, (bf16_t*)(Wgu8 + (size_t)e * 1024 * D), r); } r -= I_G;
    if (r < I_G) { kind = 2; return tr_item(p.w_up + (size_t)e * D * F, D, F, (bf16_t*)(Wgu8 + (size_t)e * 1024 * D), r); } r -= I_G;
    kind = 0; return tr_item(p.w_down + (size_t)e * F * D, F, D, (bf16_t*)(Wd8 + (size_t)e * D * F), r);
}
__device__ __forceinline__ void convert_experts(const Params& p, const Ctx& c) {
    float* scr = (float*)(c.lds) + c.wave * (64 * 33);
    constexpr int I_G = (D / 64) * (F / 32), I_D = (F / 64) * (D / 32), NITEMS = NEXP * (2 * I_G + I_D);
    int it = c.gw;
    if (it >= NITEMS) return;
    int ka0, ka1; TrItem ta0 = expert_item(p, it, ka0); const bool ha1 = it + c.ngw < NITEMS; TrItem ta1 = expert_item(p, ha1 ? it + c.ngw : it, ka1);
    f32x4 va0[8], va1[8]; tr_load(ta0, va0, c.lane); tr_load(ta1, va1, c.lane);
    bool hcur1 = ha1;
    for (;;) {
        const int nx = it + 2 * c.ngw; const bool hn0 = nx < NITEMS, hn1 = nx + c.ngw < NITEMS;
        int kb0 = 0, kb1 = 0; TrItem tb0 = ta0, tb1 = ta1; f32x4 vb0[8], vb1[8];
        if (hn0) { tb0 = expert_item(p, nx, kb0); tb1 = expert_item(p, hn1 ? nx + c.ngw : nx, kb1); tr_load(tb0, vb0, c.lane); tr_load(tb1, vb1, c.lane); }
        tr_finish8(ta0, va0, RowGen{ka0}, scr, c.lane);
        if (hcur1) tr_finish8(ta1, va1, RowGen{ka1}, scr, c.lane);
        if (!hn0) break;
        ta0 = tb0; ta1 = tb1; ka0 = kb0; ka1 = kb1; hcur1 = hn1; it = nx;
#pragma unroll
        for (int q = 0; q < 8; ++q) { va0[q] = vb0[q]; va1[q] = vb1[q]; }
    }
}
__device__ __forceinline__ void convert_late(const Params& p, const Ctx& c) {
    float* scr = (float*)(c.lds) + c.wave * (64 * 33);
    bf16_t* Wout_t = (bf16_t*)(p.ws + WS_WOUT);
    constexpr int I_OUT = (D / 64) * (D / 32);
    for (int it = c.gw; it < I_OUT; it += c.ngw) transpose_item(p.w_out, D, D, Wout_t, RowId{}, scr, it, c.lane);
    bf16_t* Wr = (bf16_t*)(p.ws + WS_WR);
    for (int i2 = c.gw * 64 + c.lane; i2 < 48 * D / 2; i2 += c.ngw * 64) {
        const int i = 2 * i2, row = i >> 10, k = i & (D - 1), nf = row >> 4, q = (row >> 2) & 3, j = row & 3;
        float v0 = 0.f, v1 = 0.f;
        if (nf < 2) { v0 = p.w_re[(size_t)k * 32 + q * 8 + nf * 4 + j]; v1 = p.w_re[(size_t)(k + 1) * 32 + q * 8 + nf * 4 + j]; } else if (j == 0) { v0 = p.w_rg[(size_t)k * 4 + q]; v1 = p.w_rg[(size_t)(k + 1) * 4 + q]; }
        const unsigned h0 = f2bf(v0), h1 = f2bf(v1);
        st4_wt(Wr + i, h0 | (h1 << 16)); st4_wt(Wr + 48 * D + i, pk2(v0 - bf2f((unsigned short)h0), v1 - bf2f((unsigned short)h1)));
    }
}
__device__ __forceinline__ void phase0(const Params& p, const Ctx& c) {
    float* scr = (float*)(c.lds) + c.wave * (64 * 33);
    bf16_t* Win_t = (bf16_t*)(p.ws + WS_WIN);
    constexpr int I_IN = (D / 64) * (DIN / 32);
    for (int it = c.gw; it < I_IN; it += c.ngw) transpose_item(p.w_in, D, DIN, Win_t, RowWin{}, scr, it, c.lane);
#if !EXPERTS_IN_ATTN
    convert_experts(p, c); convert_late(p, c);
#endif
    const rsrc_t xnr = wt_rsrc(p.ws + WS_XN, (unsigned)(T * D * 2));
    const f32x4* gr = (const f32x4*)p.attn_norm_g + 2 * c.lane;
    for (int m = c.gw; m < T; m += 2 * c.ngw) {
        const int m2 = m + c.ngw;
        const f32x4* xa = (const f32x4*)(p.x + (size_t)m * D) + 2 * c.lane; const f32x4* xb = (const f32x4*)(p.x + (size_t)(m2 < T ? m2 : m) * D) + 2 * c.lane;
        f32x4 va[4], vb[4]; float sa = 0.f, sb = 0.f;
#pragma unroll
        for (int j = 0; j < 4; ++j) { va[j] = __builtin_nontemporal_load(xa + 128 * (j >> 1) + (j & 1)); vb[j] = __builtin_nontemporal_load(xb + 128 * (j >> 1) + (j & 1)); }
#pragma unroll
        for (int j = 0; j < 4; ++j) { sa += (va[j].x * va[j].x + va[j].y * va[j].y) + (va[j].z * va[j].z + va[j].w * va[j].w); sb += (vb[j].x * vb[j].x + vb[j].y * vb[j].y) + (vb[j].z * vb[j].z + vb[j].w * vb[j].w); }
        const float ra = rsqrtf(wave_sum(sa) * (1.f / D) + EPS), rb = rsqrtf(wave_sum(sb) * (1.f / D) + EPS);
#pragma unroll
        for (int hf = 0; hf < 2; ++hf) { const f32x4 g0 = gr[128 * hf], g1 = gr[128 * hf + 1];
            const f32x4 a0 = va[2 * hf], a1 = va[2 * hf + 1];
            u32x4 w; w.x = pk2(a0.x * ra * g0.x, a0.y * ra * g0.y); w.y = pk2(a0.z * ra * g0.z, a0.w * ra * g0.w); w.z = pk2(a1.x * ra * g1.x, a1.y * ra * g1.y); w.w = pk2(a1.z * ra * g1.z, a1.w * ra * g1.w);
            st16_wt(xnr, (unsigned)((m * D + 512 * hf + 8 * c.lane) * 2), w);
            if (m2 < T) { const f32x4 b0 = vb[2 * hf], b1 = vb[2 * hf + 1];
                u32x4 w2; w2.x = pk2(b0.x * rb * g0.x, b0.y * rb * g0.y); w2.y = pk2(b0.z * rb * g0.z, b0.w * rb * g0.w); w2.z = pk2(b1.x * rb * g1.x, b1.y * rb * g1.y); w2.w = pk2(b1.z * rb * g1.z, b1.w * rb * g1.w);
                st16_wt(xnr, (unsigned)((m2 * D + 512 * hf + 8 * c.lane) * 2), w2); } }
    }
}

namespace pg8 {
#define PG8_LAS __attribute__((address_space(3)))
typedef unsigned short bf16_t;
typedef short bf16x8 __attribute__((ext_vector_type(8)));
typedef float f32x4 __attribute__((ext_vector_type(4)));
typedef unsigned u32x4 __attribute__((ext_vector_type(4)));
constexpr int BM = 256, BK = 64, HALF = 128, HTB = HALF * BK * 2  , STAGE_BYTES = 8 * HTB, NXCD = 8, WGM = 8;

__host__ __device__ __forceinline__ int lds_byte(int r, int c) { const int st = (r >> 4) * 2 + (c >> 5), rr = r & 15, cc = c & 31, ob = rr * 64 + cc * 2; return st * 1024 + (ob ^ (((ob >> 9) & 1) << 5)); }
__host__ __device__ __forceinline__ void stage_rc(int b, int& R, int& C) { const int st = b / 1024, sb = b % 1024, swz = sb ^ (((sb >> 9) & 1) << 5); R = (st >> 1) * 16 + swz / 64; C = (st & 1) * 32 + (swz % 64) / 2; }
__host__ __device__ __forceinline__ int perm32(int rho) { const int n = rho >> 4, i = rho & 15; return 8 * (i >> 2) + 4 * n + (i & 3); }

__device__ __forceinline__ unsigned cvt_pk_bf16(float lo, float hi) { unsigned r; asm volatile("v_cvt_pk_bf16_f32 %0, %1, %2" : "=v"(r) : "v"(lo), "v"(hi)); return r; }
typedef float f32x2 __attribute__((ext_vector_type(2)));

struct DenseSched {
    struct Unit { int pm, pn; };
    const char* A; const char* Bt; int K, nM, nN, nwg, G, c;
    __device__ __forceinline__ void init(const void* A_, const void* Bt_, int M, int N, int K_, int G_, int c_) { A = (const char*)A_; Bt = (const char*)Bt_; K = K_; nM = M / BM; nN = N / BM; nwg = nM * nN; G = G_; c = c_; }
    __device__ __forceinline__ bool next(int i, Unit& u) const {
        const long L = (long)i * G + c; if (L >= nwg) return false;
        int wgid = (int)L; { const int q = nwg / NXCD, r = nwg % NXCD, xcd = wgid % NXCD, off = wgid / NXCD; wgid = (xcd < r ? xcd * (q + 1) : r * (q + 1) + (xcd - r) * q) + off; }
        const int nig = WGM * nN, gid = wgid / nig, fm = gid * WGM, gsz = (nM - fm) < WGM ? (nM - fm) : WGM;
        u.pm = fm + ((wgid % nig) % gsz); u.pn = (wgid % nig) / gsz; return true;
    }
    __device__ __forceinline__ const char* a_base(const Unit& u) const { return A + (size_t)u.pm * BM * K * 2; }
    __device__ __forceinline__ const char* b_base(const Unit& u) const { return Bt + (size_t)u.pn * BM * K * 2; }
    __device__ __forceinline__ unsigned rowoff(const Unit&, int) const { return 0u; }
    __device__ __forceinline__ bool half(const Unit&) const { return false; }
    __device__ __forceinline__ void a_ready(const Unit&) const {}
    __device__ __forceinline__ void done(const Unit&) const {}
};
template <class Epi, class Sched, bool ALIGN_EPI = false, bool SP2 = false, bool GATHER = false, int SC_W = 0, int SC_T = 0>
__device__ __forceinline__ void gemm_phase(PG8_LAS unsigned char* lds, const int K, const Sched& S, const Epi& E, const int wave_id) {
    typedef typename Sched::Unit Unit;
    const int tid_ = (wave_id & 7) * 64 + my_lane();
    const int tid = tid_, wid = __builtin_amdgcn_readfirstlane(tid >> 6), lane = tid & 63, wr = wid >> 2, wc = wid & 3, fr = lane & 15, fq = lane >> 4;
    int nt_ = K / BK; if constexpr (SC_W != 0) asm volatile("" : "+s"(nt_));
    const int nt = nt_;
    unsigned voffA[2], voffB[2]; int Rr[2]; unsigned Cc2[2];
#pragma unroll
    for (int i = 0; i < 2; ++i) { int R, C; stage_rc(tid * 16 + i * 8192, R, C); const int Rb = Epi::PERM ? ((R & ~31) + perm32(R & 31)) : R;
        voffA[i] = (unsigned)(R * K + C) * 2u; voffB[i] = (unsigned)(Rb * K + C) * 2u; Rr[i] = R; Cc2[i] = (unsigned)C * 2u; }
    unsigned cv[2][2], nv[2][2];
#define PG8_GATHER(dst, u) do { if constexpr (GATHER) { _Pragma("unroll") for (int h_ = 0; h_ < 2; ++h_) _Pragma("unroll") for (int i_ = 0; i_ < 2; ++i_) dst[h_][i_] = S.rowoff(u, Rr[i_] + HALF * h_) + Cc2[i_]; } } while (0)
    const size_t kstep = (size_t)(BK * 2);
    const size_t hstep = (size_t)HALF * K * 2;
    const unsigned ldsw = (unsigned)wid * 1024u;
    const int aoff = lds_byte(wr * 64 + fr, fq * 8), boff = lds_byte(wc * 32 + fr, fq * 8);
#define PG8_SA(b, h) (((b) * 2 + (h)) * HTB)
#define PG8_SB(b, h) ((4 + (b) * 2 + (h)) * HTB)
#define PG8_STAGE_V(bufoff, gbase, v0, v1) do { \
        __builtin_amdgcn_global_load_lds((const unsigned*)((const char*)(gbase) + (v0)), (PG8_LAS unsigned*)(lds + (bufoff) + ldsw), 16, 0, 0); \
        __builtin_amdgcn_global_load_lds((const unsigned*)((const char*)(gbase) + (v1)), (PG8_LAS unsigned*)(lds + (bufoff) + ldsw + 8192), 16, 0, 0); } while (0)
#define PG8_STAGE_B(bufoff, gbase) PG8_STAGE_V(bufoff, gbase, voffB[0], voffB[1])
#define PG8_STAGE_A(bufoff, gbase, h, nx) do { if constexpr (GATHER) { PG8_STAGE_V(bufoff, gbase, (nx) ? nv[h][0] : cv[h][0], (nx) ? nv[h][1] : cv[h][1]); } \
        else { PG8_STAGE_V(bufoff, (gbase) + (h) * hstep, voffA[0], voffA[1]); } } while (0)
#define PG8_LDA(dst, b, h) do { _Pragma("unroll") for (int m = 0; m < 4; ++m) _Pragma("unroll") for (int k = 0; k < 2; ++k) dst[m][k] = *(const PG8_LAS bf16x8*)(lds + PG8_SA(b, h) + aoff + m * 2048 + k * 1024); } while (0)
#define PG8_LDB(dst, b, h) do { _Pragma("unroll") for (int n = 0; n < 2; ++n) _Pragma("unroll") for (int k = 0; k < 2; ++k) dst[n][k] = *(const PG8_LAS bf16x8*)(lds + PG8_SB(b, h) + boff + n * 2048 + k * 1024); } while (0)
#define PG8_CAT8(x) __builtin_shufflevector(__builtin_bit_cast(i32x4, x[0]), __builtin_bit_cast(i32x4, x[1]), 0, 1, 2, 3, 4, 5, 6, 7)
#define PG8_MMA(ai, bj, At, Bt) do { __builtin_amdgcn_s_setprio(1); _Pragma("unroll") for (int m = 0; m < 4; ++m) _Pragma("unroll") for (int n = 0; n < 2; ++n) { \
        if constexpr (SC_W != 0) { const i32x8 b8_ = PG8_CAT8(Bt[n]), a8_ = PG8_CAT8(At[m]); \
            asm volatile("v_mfma_scale_f32_16x16x128_f8f6f4 %0, %1, %2, %0, %3, %4 op_sel_hi:[0,0,0]" : "+v"(acc[ai][bj][m][n]) : "v"(b8_), "v"(a8_), "v"(sc_w), "v"(sc_t)); } \
        else { _Pragma("unroll") for (int k = 0; k < 2; ++k) acc[ai][bj][m][n] = __builtin_amdgcn_mfma_f32_16x16x32_bf16(Bt[n][k], At[m][k], acc[ai][bj][m][n], 0, 0, 0); } } __builtin_amdgcn_s_setprio(0); } while (0)
#define PG8_WAIT_V(n) asm volatile("s_waitcnt vmcnt(" #n ")" ::: "memory")
#define PG8_WAIT_L(n) asm volatile("s_waitcnt lgkmcnt(" #n ")" ::: "memory")
#define PG8_BAR __builtin_amdgcn_s_barrier()
#define PG8_SCHED __builtin_amdgcn_sched_barrier(0)
    Unit cur, nxt; int ui = 0;
    if (!S.next(0, cur)) return;
    const int sc_w = SC_W * 0x01010101, sc_t = SC_T * 0x01010101;
    bool hf = S.half(cur);
    f32x4 acc[2][2][4][2];
#pragma unroll
    for (int a = 0; a < 2; ++a)
#pragma unroll
        for (int b = 0; b < 2; ++b)
#pragma unroll
            for (int m = 0; m < 4; ++m)
#pragma unroll
                for (int n = 0; n < 2; ++n) acc[a][b][m][n] = (f32x4){0.f, 0.f, 0.f, 0.f};
    bf16x8 At[4][2], B0[2][2], B1[2][2];
    const char* cA = S.a_base(cur); const char* cB = S.b_base(cur);
    S.a_ready(cur); PG8_GATHER(cv, cur);
    if constexpr (SP2) {
        PG8_STAGE_B(PG8_SB(0, 0), cB); PG8_STAGE_B(PG8_SB(0, 1), cB + hstep); PG8_STAGE_A(PG8_SA(0, 0), cA, 0, false); PG8_STAGE_A(PG8_SA(0, 1), cA, 1, false);
        if (wr == 1) PG8_BAR;
        PG8_WAIT_V(2); PG8_BAR;
        PG8_STAGE_B(PG8_SB(1, 0), cB + kstep); PG8_STAGE_A(PG8_SA(1, 0), cA + kstep, 0, false); PG8_STAGE_B(PG8_SB(1, 1), cB + hstep + kstep);
        PG8_WAIT_V(6); PG8_BAR;
    } else {
        PG8_STAGE_B(PG8_SB(0, 0), cB); PG8_STAGE_A(PG8_SA(0, 0), cA, 0, false); PG8_STAGE_B(PG8_SB(0, 1), cB + hstep); PG8_STAGE_A(PG8_SA(0, 1), cA, 1, false);
        if (wr == 1) PG8_BAR;
        PG8_WAIT_V(4); PG8_BAR;
        PG8_STAGE_B(PG8_SB(1, 0), cB + kstep); PG8_STAGE_A(PG8_SA(1, 0), cA + kstep, 0, false); PG8_STAGE_B(PG8_SB(1, 1), cB + hstep + kstep);
        PG8_WAIT_V(6); PG8_BAR;
    }
    for (;;) {
        const bool has_next = S.next(ui + 1, nxt);
        const char* nA = has_next ? S.a_base(nxt) : cA; const char* nB = has_next ? S.b_base(nxt) : cB;
        if constexpr (GATHER) { if (has_next) { PG8_GATHER(nv, nxt); } else { _Pragma("unroll") for (int h_ = 0; h_ < 2; ++h_) { nv[h_][0] = cv[h_][0]; nv[h_][1] = cv[h_][1]; } } }
        for (int t = 0; t < nt; t += 2) {
            const bool last = (t == nt - 2);
            const char* a1 = cA + (size_t)(t + 1) * kstep;
            const char* a2 = last ? nA : cA + (size_t)(t + 2) * kstep; const char* b2 = last ? nB : cB + (size_t)(t + 2) * kstep;
            const char* a3 = a2 + kstep; const char* b3 = b2 + kstep;
            if (last && has_next) S.a_ready(nxt);
            if constexpr (SP2) {
            PG8_LDB(B0, 0, 0); PG8_LDB(B1, 0, 1); PG8_SCHED; PG8_LDA(At, 0, 0); PG8_STAGE_A(PG8_SA(1, 1), a1, 1, false);
            PG8_WAIT_V(8); PG8_WAIT_L(0); PG8_BAR; PG8_MMA(0, 0, At, B0); PG8_MMA(0, 1, At, B1); PG8_BAR; PG8_SCHED;
            PG8_LDA(At, 0, 1); PG8_STAGE_B(PG8_SB(0, 0), b2); PG8_STAGE_B(PG8_SB(0, 1), b2 + hstep); PG8_STAGE_A(PG8_SA(0, 0), a2, 0, last);
            PG8_WAIT_V(8); PG8_WAIT_L(0); PG8_BAR; if (!hf) { PG8_MMA(1, 0, At, B0); PG8_MMA(1, 1, At, B1); } PG8_BAR; PG8_SCHED;
            PG8_LDB(B0, 1, 0); PG8_LDB(B1, 1, 1); PG8_SCHED; PG8_LDA(At, 1, 0); PG8_STAGE_A(PG8_SA(0, 1), a2, 1, last);
            PG8_WAIT_V(8); PG8_WAIT_L(0); PG8_BAR; PG8_MMA(0, 0, At, B0); PG8_MMA(0, 1, At, B1); PG8_BAR; PG8_SCHED;
            PG8_LDA(At, 1, 1); PG8_STAGE_B(PG8_SB(1, 0), b3); PG8_STAGE_B(PG8_SB(1, 1), b3 + hstep); PG8_STAGE_A(PG8_SA(1, 0), a3, 0, last);
            PG8_WAIT_V(8); PG8_WAIT_L(0); PG8_BAR; if (!hf) { PG8_MMA(1, 0, At, B0); PG8_MMA(1, 1, At, B1); } PG8_BAR; PG8_SCHED;
            } else {
            PG8_LDB(B0, 0, 0); PG8_SCHED; PG8_LDA(At, 0, 0); PG8_STAGE_A(PG8_SA(1, 1), a1, 1, false);
            PG8_WAIT_L(8); PG8_BAR; PG8_WAIT_L(0); PG8_MMA(0, 0, At, B0); PG8_BAR; PG8_SCHED;
            PG8_LDB(B1, 0, 1); PG8_STAGE_B(PG8_SB(0, 0), b2);
            PG8_BAR; PG8_WAIT_L(0); PG8_MMA(0, 1, At, B1); PG8_BAR;
            PG8_LDA(At, 0, 1); PG8_STAGE_A(PG8_SA(0, 0), a2, 0, last);
            PG8_BAR; PG8_WAIT_L(0); PG8_MMA(1, 0, At, B0); PG8_BAR; PG8_SCHED;
            PG8_STAGE_B(PG8_SB(0, 1), b2 + hstep);
            PG8_WAIT_V(6); PG8_BAR; PG8_MMA(1, 1, At, B1); PG8_BAR;
            PG8_LDB(B0, 1, 0); PG8_SCHED; PG8_LDA(At, 1, 0); PG8_STAGE_A(PG8_SA(0, 1), a2, 1, last);
            PG8_WAIT_L(8); PG8_BAR; PG8_WAIT_L(0); PG8_MMA(0, 0, At, B0); PG8_BAR; PG8_SCHED;
            PG8_LDB(B1, 1, 1); PG8_STAGE_B(PG8_SB(1, 0), b3);
            PG8_BAR; PG8_WAIT_L(0); PG8_MMA(0, 1, At, B1); PG8_BAR;
            PG8_LDA(At, 1, 1); PG8_STAGE_A(PG8_SA(1, 0), a3, 0, last);
            PG8_BAR; PG8_WAIT_L(0); PG8_MMA(1, 0, At, B0); PG8_BAR; PG8_SCHED;
            PG8_STAGE_B(PG8_SB(1, 1), b3 + hstep);
            PG8_WAIT_V(6); PG8_BAR; PG8_MMA(1, 1, At, B1); PG8_BAR;
            }
        }
        if constexpr (SC_W != 0) asm volatile("s_nop 15\n\ts_nop 15" ::: "memory");
        if constexpr (ALIGN_EPI) { if (wr == 0) PG8_BAR; }
        if constexpr (!Epi::AFTER_DRAIN) { E(acc, cur, wr, wc, fr, fq); S.done(cur); }
        if (!has_next) break;
#pragma unroll
        for (int a = 0; a < 2; ++a)
#pragma unroll
            for (int b = 0; b < 2; ++b)
#pragma unroll
                for (int m = 0; m < 4; ++m)
#pragma unroll
                    for (int n = 0; n < 2; ++n) acc[a][b][m][n] = (f32x4){0.f, 0.f, 0.f, 0.f};
        cur = nxt; cA = nA; cB = nB; ++ui; hf = S.half(cur);
        if constexpr (GATHER) { _Pragma("unroll") for (int h_ = 0; h_ < 2; ++h_) { cv[h_][0] = nv[h_][0]; cv[h_][1] = nv[h_][1]; } }
        if constexpr (ALIGN_EPI) { if (wr == 1) PG8_BAR; }
    }
    PG8_WAIT_V(0);
    if constexpr (!ALIGN_EPI) { if (wr == 0) PG8_BAR; }
    PG8_BAR;
    if constexpr (Epi::AFTER_DRAIN) { E.fused(acc, cur, wr, wc, fr, fq, lds, wid, lane); S.done(cur); }
#undef PG8_SA
#undef PG8_SB
#undef PG8_STAGE_V
#undef PG8_STAGE_A
#undef PG8_STAGE_B
#undef PG8_GATHER
#undef PG8_LDA
#undef PG8_LDB
#undef PG8_MMA
#undef PG8_CAT8
#undef PG8_WAIT_V
#undef PG8_WAIT_L
#undef PG8_BAR
#undef PG8_SCHED
}
}

struct EpiProj {
    static constexpr bool PERM = true, AFTER_DRAIN = false;
    bf16_t* O; const float* qg; const float* kg;
    __device__ __forceinline__ void operator()(const f32x4 (&acc)[2][2][4][2], const pg8::DenseSched::Unit& u, int wr, int wc, int fr, int fq) const {
        const int cb = u.pn * 256 + wc * 64;
        const bool isq = (cb >= COL_Q) && (cb < COL_K), isk = (cb >= COL_K) && (cb < COL_V);
        f32x4 sc[2][2];
#pragma unroll
        for (int bj = 0; bj < 2; ++bj)
#pragma unroll
            for (int n = 0; n < 2; ++n) sc[bj][n] = (f32x4){1.f, 1.f, 1.f, 1.f};
        if (isq || isk) {
            const float* gn = isq ? qg : kg; const float mlt = isq ? QSCALE : 1.f;
#pragma unroll
            for (int bj = 0; bj < 2; ++bj)
#pragma unroll
                for (int n = 0; n < 2; ++n) sc[bj][n] = *(const f32x4*)(gn + 32 * bj + 8 * fq + 4 * n) * mlt;
        }
#pragma unroll
        for (int ai = 0; ai < 2; ++ai)
#pragma unroll
            for (int m = 0; m < 4; ++m) {
                const int row = u.pm * 256 + ai * 128 + wr * 64 + m * 16 + fr;
                float mul = 1.f;
                if (isq || isk) {
                    float ss = 0.f;
#pragma unroll
                    for (int bj = 0; bj < 2; ++bj)
#pragma unroll
                        for (int n = 0; n < 2; ++n) { const f32x4 x = acc[ai][bj][m][n]; ss += (x.x * x.x + x.y * x.y) + (x.z * x.z + x.w * x.w); }
                    { const int ln = fr + 16 * fq; ss += lane_get(ss, ln ^ 16); ss += lane_get(ss, ln ^ 32); }
                    mul = rsqrtf(ss * (1.f / 64.f) + EPS);
                }
                const rsrc_t orr = wt_rsrc(O, (unsigned)(T * DIN * 2)); const unsigned roff = (unsigned)((row * DIN + cb + 8 * fq) * 2);
#pragma unroll
                for (int bj = 0; bj < 2; ++bj) {
                    const f32x4 v0 = acc[ai][bj][m][0] * sc[bj][0] * mul, v1 = acc[ai][bj][m][1] * sc[bj][1] * mul;
                    u32x4 w; w.x = pg8::cvt_pk_bf16(v0.x, v0.y); w.y = pg8::cvt_pk_bf16(v0.z, v0.w); w.z = pg8::cvt_pk_bf16(v1.x, v1.y); w.w = pg8::cvt_pk_bf16(v1.z, v1.w);
                    st16_wt(orr, roff + 64u * bj, w);
                }
            }
    }
};
struct EpiAO {
    static constexpr bool PERM = true, AFTER_DRAIN = false;
    bf16_t* O;
    __device__ __forceinline__ void operator()(const f32x4 (&acc)[2][2][4][2], const pg8::DenseSched::Unit& u, int wr, int wc, int fr, int fq) const {
        const int col0 = u.pn * 256 + wc * 32 + 8 * fq;
#pragma unroll
        for (int ai = 0; ai < 2; ++ai)
#pragma unroll
            for (int m = 0; m < 4; ++m) {
                const rsrc_t orr = wt_rsrc(O, (unsigned)(T * D * 2)); const unsigned roff = (unsigned)(((u.pm * 256 + ai * 128 + wr * 64 + m * 16 + fr) * D + col0) * 2);
#pragma unroll
                for (int bj = 0; bj < 2; ++bj) {
                    const f32x4 v0 = acc[ai][bj][m][0], v1 = acc[ai][bj][m][1];
                    u32x4 w; w.x = pg8::cvt_pk_bf16(v0.x, v0.y); w.y = pg8::cvt_pk_bf16(v0.z, v0.w); w.z = pg8::cvt_pk_bf16(v1.x, v1.y); w.w = pg8::cvt_pk_bf16(v1.z, v1.w);
                    st16_wt(orr, roff + 256u * bj, w);
                }
            }
    }
};
__device__ __forceinline__ void phase1_fast(const Params& p, const Ctx& c) {
    pg8::DenseSched S; S.init(p.ws + WS_XN, p.ws + WS_WIN, T, DIN, D, c.nb, c.bid);
    EpiProj E{(bf16_t*)(p.ws + WS_PROJ), p.q_norm_g, p.k_norm_g};
    pg8::gemm_phase<EpiProj, pg8::DenseSched, true, true, false>((PG8_LAS unsigned char*)c.lds, D, S, E, c.wave);
}
__device__ __forceinline__ void phase3_fast(const Params& p, const Ctx& c) {
    pg8::DenseSched S; S.init(p.ws + WS_XN, p.ws + WS_WOUT, T, D, D, c.nb, c.bid);
    EpiAO E{(bf16_t*)(p.ws + WS_AO)};
    pg8::gemm_phase<EpiAO, pg8::DenseSched, true, true, false>((PG8_LAS unsigned char*)c.lds, D, S, E, c.wave);
}

#include <hip/hip_bf16.h>
#include <cmath>
namespace attn128 {
using bf16=__hip_bfloat16;
using bf16x8=__attribute__((ext_vector_type(8)))short;
using s16x4=__attribute__((ext_vector_type(4)))short;
using f32x16=__attribute__((ext_vector_type(16)))float;
using u32x4=__attribute__((ext_vector_type(4)))unsigned;
constexpr int BATCH=4,NHEAD=16,SEQ=4096,D=64,DM=3072;
constexpr int NW=8,QBLK=32,QB=QBLK*NW,KVBLK=64,NQB=SEQ/QB;
constexpr int ATTN_PITCH=DM, ATTN_UNIT_ROWS=QB;
__device__ __forceinline__ int crow(int r,int hi){return (r&3)+8*(r>>2)+4*hi;}
#define SBAR() __builtin_amdgcn_sched_barrier(0)
__device__ __forceinline__ void cmask(f32x16&p0,f32x16&p1,int jb,int qrel,int hi){
  const float NEG=-INFINITY; int kb=64*jb+4*hi;
  #pragma unroll
  for(int r=0;r<16;++r){int kv=kb+(r&3)+8*(r>>2); if(kv>qrel)p0[r]=NEG; if(kv+32>qrel)p1[r]=NEG;}
}

constexpr int NSLOT=3, SLOTB=8192, VSLOTB=16384;
constexpr int LDS_K=0, LDS_V=NSLOT*SLOTB, LDS_WS=LDS_V+NSLOT*VSLOTB, LDS_OST=LDS_WS+NW*64*4, LDS_BYTES=LDS_OST+NW*8192;
constexpr float C2=0.125f*1.4426950408889634f;
__device__ __forceinline__ void glds16(const void*gbase,unsigned voff,unsigned lds_dst){unsigned keep;
  asm volatile("s_mov_b32 %0, m0\n\ts_mov_b32 m0, %3\n\ts_nop 0\n\tglobal_load_lds_dwordx4 %1, %2\n\ts_mov_b32 m0, %0":"=&s"(keep):"v"(voff),"s"(gbase),"s"(lds_dst):"memory");}
__device__ __forceinline__ float max3f(float a,float b,float c){float r;asm("v_max3_f32 %0, %1, %2, %3":"=v"(r):"v"(a),"v"(b),"v"(c));return r;}
__device__ __forceinline__ float max2f(float a,float b){float r;asm("v_max_f32_e32 %0, %1, %2":"=v"(r):"v"(a),"v"(b));return r;}
__device__ __forceinline__ float fadd_s(float a,float b){float r;asm("v_add_f32_e32 %0, %1, %2":"=v"(r):"v"(a),"v"(b));return r;}
__device__ __forceinline__ float fsub_s(float a,float b){float r;asm("v_sub_f32_e32 %0, %1, %2":"=v"(r):"v"(a),"v"(b));return r;}
typedef float f32x2_t __attribute__((ext_vector_type(2))); typedef __bf16 bf16x2_t __attribute__((ext_vector_type(2)));
__device__ __forceinline__ unsigned cvtpk_s(float lo,float hi){f32x2_t v={lo,hi};bf16x2_t b=__builtin_convertvector(v,bf16x2_t);return __builtin_bit_cast(unsigned,b);}
#define WAIT_BAR(N) asm volatile("s_waitcnt vmcnt(" #N ") lgkmcnt(0)\n\ts_barrier":::"memory")

__device__ __forceinline__ void qkt(f32x16&p0,f32x16&p1,const char*Kslot,const bf16x8*qr,int r32,int hi){ const f32x16 negm=f32x16{};
  const char*kb=Kslot+hi*1024+r32*16;
  #pragma unroll
  for(int d0=0;d0<4;++d0){
    const bf16x8 b0=*reinterpret_cast<const bf16x8*>(kb+d0*2048);
    const bf16x8 b1=*reinterpret_cast<const bf16x8*>(kb+d0*2048+512);
    if(d0==0){p0=__builtin_amdgcn_mfma_f32_32x32x16_bf16(b0,qr[0],negm,0,0,0);p1=__builtin_amdgcn_mfma_f32_32x32x16_bf16(b1,qr[0],negm,0,0,0);}
    else{p0=__builtin_amdgcn_mfma_f32_32x32x16_bf16(b0,qr[d0],p0,0,0,0);p1=__builtin_amdgcn_mfma_f32_32x32x16_bf16(b1,qr[d0],p1,0,0,0);}}
}
typedef __attribute__((address_space(3))) const char* lds_cptr;
typedef short v4i16_t __attribute__((ext_vector_type(4)));
__device__ __forceinline__ void kload8(bf16x8*kf,lds_cptr kp){
  kf[0]=*(const __attribute__((address_space(3))) bf16x8*)(kp);      kf[1]=*(const __attribute__((address_space(3))) bf16x8*)(kp+512);
  kf[2]=*(const __attribute__((address_space(3))) bf16x8*)(kp+2048); kf[3]=*(const __attribute__((address_space(3))) bf16x8*)(kp+2560);
  kf[4]=*(const __attribute__((address_space(3))) bf16x8*)(kp+4096); kf[5]=*(const __attribute__((address_space(3))) bf16x8*)(kp+4608);
  kf[6]=*(const __attribute__((address_space(3))) bf16x8*)(kp+6144); kf[7]=*(const __attribute__((address_space(3))) bf16x8*)(kp+6656);
}
__device__ __forceinline__ void kload2(bf16x8*kf,lds_cptr kp,int j){ kf[2*j]=*(const __attribute__((address_space(3))) bf16x8*)(kp+j*2048); kf[2*j+1]=*(const __attribute__((address_space(3))) bf16x8*)(kp+j*2048+512); }
__device__ __forceinline__ s16x4 vtr(lds_cptr p){ return __builtin_bit_cast(s16x4,__builtin_amdgcn_ds_read_tr16_b64_v4i16((__attribute__((address_space(3))) v4i16_t*)p)); }
__device__ __forceinline__ float rowmax(const f32x16&p0,const f32x16&p1){
  float a=max3f(p0[0],p0[1],p1[0]),b=max3f(p0[2],p0[3],p1[1]);a=max3f(a,p1[2],p1[3]);
  #pragma unroll
  for(int r=4;r<16;r+=4){a=max3f(a,p0[r],p0[r+1]);b=max3f(b,p0[r+2],p0[r+3]);a=max3f(a,p1[r],p1[r+1]);b=max3f(b,p1[r+2],p1[r+3]);}
  const float m=max2f(a,b);
  auto rr=__builtin_amdgcn_permlane32_swap(__float_as_uint(m),__float_as_uint(m),false,false);
  return max2f(__uint_as_float(rr[0]),__uint_as_float(rr[1]));
}
__device__ __forceinline__ void pv(f32x16*o,int vb,bf16x8 pa0,bf16x8 pa1,bf16x8 pa2,bf16x8 pa3){
  #pragma unroll
  for(int d0=0;d0<4;++d0){s16x4 lo[4],hi[4];
    #pragma unroll
    for(int ks=0;ks<4;++ks){
      asm volatile("ds_read_b64_tr_b16 %0,%1 offset:%c2":"=&v"(lo[ks]):"v"(vb),"i"(d0*4096+ks*1024):"memory");
      asm volatile("ds_read_b64_tr_b16 %0,%1 offset:%c2":"=&v"(hi[ks]):"v"(vb),"i"(d0*4096+ks*1024+512):"memory");}
    asm volatile("s_waitcnt lgkmcnt(0)":::"memory");SBAR();
    #define PK(k) (bf16x8){lo[k][0],lo[k][1],lo[k][2],lo[k][3],hi[k][0],hi[k][1],hi[k][2],hi[k][3]}
    o[d0]=__builtin_amdgcn_mfma_f32_32x32x16_bf16(pa0,PK(0),o[d0],0,0,0);
    o[d0]=__builtin_amdgcn_mfma_f32_32x32x16_bf16(pa1,PK(1),o[d0],0,0,0);
    o[d0]=__builtin_amdgcn_mfma_f32_32x32x16_bf16(pa2,PK(2),o[d0],0,0,0);
    o[d0]=__builtin_amdgcn_mfma_f32_32x32x16_bf16(pa3,PK(3),o[d0],0,0,0);
    #undef PK
  }
}

#ifndef ATTN_STORE16
#define ATTN_STORE16(p,v) (*(u32x4*)(p)=(v))
#endif
template<int THRL> __device__ __forceinline__ void attn_unit(int b,int h,int hv,int qb,const bf16*Q,const bf16*__restrict__ K,const bf16*__restrict__ V,bf16*O,char*shm){
  const int tid=threadIdx.x,lane=tid&63,r32=lane&31,hi=lane>>5; const int wid=__builtin_amdgcn_readfirstlane(tid>>6);
  const long rowbase=(long)b*SEQ; const int q0=qb*QB;
  const bf16*Qw=Q+(rowbase+q0+wid*QBLK)*DM+h*D;
  const bf16*Kh=K+rowbase*DM+h*D,*Vh=V+rowbase*DM+hv*128;
  const unsigned lds0=(unsigned)(uintptr_t)shm;
  float*wsf=(float*)(shm+LDS_WS)+wid*64;
  const unsigned koff=(unsigned)(lane*DM+wid*8)*2u;
  const unsigned voff=(unsigned)((16*(wid&3)+(lane>>2))*DM+(wid>>2)*32+(lane&3)*8)*2u;
  const unsigned kdst=lds0+LDS_K+wid*1024, vdst=lds0+LDS_V+wid*1024;
  #define DMA_K(t,slot) glds16(Kh+(long)(t)*KVBLK*DM,koff,(unsigned)__builtin_amdgcn_readfirstlane(kdst+(slot)))
  #define DMA_V(t,slot) do{ glds16(Vh+(long)(t)*KVBLK*DM,voff,(unsigned)__builtin_amdgcn_readfirstlane(vdst+(slot))); glds16(Vh+(long)(t)*KVBLK*DM+64,voff,(unsigned)__builtin_amdgcn_readfirstlane(vdst+(slot)+8192)); }while(0)
  const char*Kbase=shm+LDS_K; bf16x8 kf[8];
  const lds_cptr shm3=(lds_cptr)shm; const lds_cptr kp0=shm3+LDS_K+hi*1024+r32*16; const lds_cptr vp0=shm3+LDS_V+((lane>>4)&1)*32+(lane&3)*8+(4*hi+((lane&15)>>2))*64;
  const int NT=(q0+QB)/KVBLK;
  DMA_K(0,0);DMA_V(0,0);DMA_K(1,SLOTB);
  bf16x8 qr[4];
  #pragma unroll
  for(int d0=0;d0<4;++d0)qr[d0]=*reinterpret_cast<const bf16x8*>(&Qw[(long)r32*DM+d0*16+hi*8]);
  float mhat=0.f,l_reg=0.f;
  const int qrel=wid*QBLK+r32;
  #define CMASK(P0,P1,t) do{int jb_=(t)-(NT-4); if(jb_>=0)cmask(P0,P1,jb_,qrel,hi);}while(0)
  bool resc=false;
  #define START(P0,P1) do{ const float rm=rowmax(P0,P1); resc=false; \
    { const float dl=rm; mhat=fadd_s(mhat,dl); \
      _Pragma("unroll") for(int r=0;r<16;++r){P0[r]=fsub_s(P0[r],dl);P1[r]=fsub_s(P1[r],dl);} } \
    _Pragma("unroll") for(int r=0;r<16;++r)P0[r]=__builtin_amdgcn_exp2f(P0[r]); }while(0)
  #define RESC() do{ if(resc){ asm volatile("s_waitcnt lgkmcnt(0)":::"memory"); \
      _Pragma("unroll") for(int d_=0;d_<4;++d_) _Pragma("unroll") for(int r=0;r<16;++r)o[d_][r]*=wsf[crow(r,hi)]; } }while(0)
  f32x16 pA0,pA1,pB0,pB1;
  int sl_prev=0,sl_cur=0,sl_next=SLOTB;
  #define ROT() do{sl_prev=sl_cur;sl_cur=sl_next;sl_next=(sl_next==(NSLOT-1)*SLOTB)?0:sl_next+SLOTB;}while(0)
  DMA_K(2,2*SLOTB);
  WAIT_BAR(4);
  qkt(pA0,pA1,Kbase,qr,r32,hi);asm volatile("s_nop 15\n\ts_nop 7":"+v"(pA0),"+v"(pA1));CMASK(pA0,pA1,0);
  START(pA0,pA1);
  _Pragma("unroll") for(int r=0;r<16;++r)pA1[r]=__builtin_amdgcn_exp2f(pA1[r]);
  WAIT_BAR(0);
  DMA_K(3,0);DMA_V(1,VSLOTB);
  ROT();
  kload8(kf,kp0+sl_cur);
  WAIT_BAR(3);
  s16x4 vlo[8],vhi[8],wlo[8],whi[8]; u32x4 pw0,pw1,pw2,pw3;
  #define PKW(P,B) cvtpk_s(P[B],P[B+1])
  #define PAF(k) __builtin_bit_cast(bf16x8,pw##k)
  #define VFR(i) (bf16x8){vlo[i][0],vlo[i][1],vlo[i][2],vlo[i][3],vhi[i][0],vhi[i][1],vhi[i][2],vhi[i][3]}
  #define WFR(i) (bf16x8){wlo[i][0],wlo[i][1],wlo[i][2],wlo[i][3],whi[i][0],whi[i][1],whi[i][2],whi[i][3]}
  #define PIN(x) asm volatile("":"+v"(x))
  #define MX3(a,b,c) __builtin_fmaxf(__builtin_fmaxf((a),(b)),(c))
  #define GAPA(MF,A0,A1,A2,A3,W0,W1,PW) do{ MF; sacc+=A0; sacc+=A1; sacc+=A2; sacc+=A3; PIN(sacc); W0; W1; PIN(PW); SBAR(); }while(0)
  #define EX(v) __builtin_amdgcn_exp2f(v)
  #define GAPB(MF,X,B) do{ MF; X[B]=EX(X[B]-mhat); X[B+1]=EX(X[B+1]-mhat); PIN(X); SBAR(); }while(0)
  #define VOFF(s_) ((((s_)&3)*4096)+(((s_)>>2)*1024))
  #define VRD(i) do{ vlo[i]=vtr(vp_+VOFF(i)); vhi[i]=vtr(vp_+VOFF(i)+512); }while(0)
  #define WRD(i) do{ wlo[i]=vtr(vp_+VOFF(8+(i))); whi[i]=vtr(vp_+VOFF(8+(i))+512); SBAR(); }while(0)
  #define KRD(G,j) do{ if(G){ kload2(kf,kp0+sl_next,j); SBAR(); } }while(0)
  #define ZC f32x16{}
  #define STEP(C0,C1,P0,P1,t,GK,GV,GL) do{ SBAR(); \
    const lds_cptr vp_=vp0+2*sl_prev; \
    VRD(0); SBAR(); float sacc=(P0[0]+P0[1]); \
    GAPA(C0=__builtin_amdgcn_mfma_f32_32x32x16_bf16(kf[0],qr[0],ZC,0,0,0), P0[2],P0[3],P0[4],P0[5],     pw0[0]=PKW(P0,0), pw0[1]=PKW(P0,2), pw0); \
    VRD(1); SBAR(); GAPA(C1=__builtin_amdgcn_mfma_f32_32x32x16_bf16(kf[1],qr[0],ZC,0,0,0), P0[6],P0[7],P0[8],P0[9],     pw0[2]=PKW(P0,4), pw0[3]=PKW(P0,6), pw0); \
    VRD(2); SBAR(); GAPA(C0=__builtin_amdgcn_mfma_f32_32x32x16_bf16(kf[2],qr[1],C0,0,0,0),   P0[10],P0[11],P0[12],P0[13], pw1[0]=PKW(P0,8), pw1[1]=PKW(P0,10), pw1); \
    VRD(3); SBAR(); GAPA(C1=__builtin_amdgcn_mfma_f32_32x32x16_bf16(kf[3],qr[1],C1,0,0,0),   P0[14],P0[15],P1[0],P1[1],   pw1[2]=PKW(P0,12),pw1[3]=PKW(P0,14), pw1); \
    VRD(4); SBAR(); GAPA(C0=__builtin_amdgcn_mfma_f32_32x32x16_bf16(kf[4],qr[2],C0,0,0,0),   P1[2],P1[3],P1[4],P1[5],     pw2[0]=PKW(P1,0), pw2[1]=PKW(P1,2), pw2); \
    VRD(5); SBAR(); GAPA(C1=__builtin_amdgcn_mfma_f32_32x32x16_bf16(kf[5],qr[2],C1,0,0,0),   P1[6],P1[7],P1[8],P1[9],     pw2[2]=PKW(P1,4), pw2[3]=PKW(P1,6), pw2); \
    VRD(6); SBAR(); GAPA(C0=__builtin_amdgcn_mfma_f32_32x32x16_bf16(kf[6],qr[3],C0,0,0,0),   P1[10],P1[11],P1[12],P1[13], pw3[0]=PKW(P1,8), pw3[1]=PKW(P1,10), pw3); \
    VRD(7); SBAR(); GAPA(C1=__builtin_amdgcn_mfma_f32_32x32x16_bf16(kf[7],qr[3],C1,0,0,0),   P1[14],P1[15],0.f,0.f,       pw3[2]=PKW(P1,12),pw3[3]=PKW(P1,14), pw3); \
    l_reg+=sacc; \
    if(GK){DMA_K((t)+3,sl_cur);} if(GV){DMA_V((t)+1,2*sl_next);} \
    CMASK(C0,C1,t); \
    { float a=MX3(C0[0],C0[1],C1[0]),b=MX3(C0[2],C0[3],C1[1]); a=MX3(a,C1[2],C1[3]); \
      _Pragma("unroll") for(int r=4;r<16;r+=4){a=MX3(a,C0[r],C0[r+1]);b=MX3(b,C0[r+2],C0[r+3]);a=MX3(a,C1[r],C1[r+1]);b=MX3(b,C1[r+2],C1[r+3]);} \
      float rm=__builtin_fmaxf(a,b); { auto rr=__builtin_amdgcn_permlane32_swap(__float_as_uint(rm),__float_as_uint(rm),false,false); rm=__builtin_fmaxf(__uint_as_float(rr[0]),__uint_as_float(rr[1])); } \
      rm-=mhat;                                      \
      resc=false; \
      if(__builtin_expect(__any(rm>(float)THRL),0)){ const float dl=__builtin_fmaxf(rm,0.f); mhat+=dl; \
        const float f=__builtin_amdgcn_exp2f(-dl); l_reg*=f; if(hi==0)wsf[r32]=f; resc=true; } } \
    SBAR(); \
    WRD(0); GAPB(o[0]=__builtin_amdgcn_mfma_f32_32x32x16_bf16(PAF(0),VFR(0),o[0],0,0,0), C0,0); \
    WRD(1); GAPB(o[1]=__builtin_amdgcn_mfma_f32_32x32x16_bf16(PAF(0),VFR(1),o[1],0,0,0), C0,2); \
    WRD(2); KRD(GL,0); GAPB(o[2]=__builtin_amdgcn_mfma_f32_32x32x16_bf16(PAF(0),VFR(2),o[2],0,0,0), C0,4); \
    WRD(3); KRD(GL,1); GAPB(o[3]=__builtin_amdgcn_mfma_f32_32x32x16_bf16(PAF(0),VFR(3),o[3],0,0,0), C0,6); \
    WRD(4); KRD(GL,2); GAPB(o[0]=__builtin_amdgcn_mfma_f32_32x32x16_bf16(PAF(1),VFR(4),o[0],0,0,0), C0,8); \
    WRD(5); KRD(GL,3); GAPB(o[1]=__builtin_amdgcn_mfma_f32_32x32x16_bf16(PAF(1),VFR(5),o[1],0,0,0), C0,10); \
    WRD(6); GAPB(o[2]=__builtin_amdgcn_mfma_f32_32x32x16_bf16(PAF(1),VFR(6),o[2],0,0,0), C0,12); \
    WRD(7); GAPB(o[3]=__builtin_amdgcn_mfma_f32_32x32x16_bf16(PAF(1),VFR(7),o[3],0,0,0), C0,14); \
    GAPB(o[0]=__builtin_amdgcn_mfma_f32_32x32x16_bf16(PAF(2),WFR(0),o[0],0,0,0), C1,0); \
    GAPB(o[1]=__builtin_amdgcn_mfma_f32_32x32x16_bf16(PAF(2),WFR(1),o[1],0,0,0), C1,2); \
    GAPB(o[2]=__builtin_amdgcn_mfma_f32_32x32x16_bf16(PAF(2),WFR(2),o[2],0,0,0), C1,4); \
    GAPB(o[3]=__builtin_amdgcn_mfma_f32_32x32x16_bf16(PAF(2),WFR(3),o[3],0,0,0), C1,6); \
    GAPB(o[0]=__builtin_amdgcn_mfma_f32_32x32x16_bf16(PAF(3),WFR(4),o[0],0,0,0), C1,8); \
    GAPB(o[1]=__builtin_amdgcn_mfma_f32_32x32x16_bf16(PAF(3),WFR(5),o[1],0,0,0), C1,10); \
    GAPB(o[2]=__builtin_amdgcn_mfma_f32_32x32x16_bf16(PAF(3),WFR(6),o[2],0,0,0), C1,12); \
    GAPB(o[3]=__builtin_amdgcn_mfma_f32_32x32x16_bf16(PAF(3),WFR(7),o[3],0,0,0), C1,14); \
    }while(0)
  f32x16 o[4];o[0]=f32x16{};o[1]=f32x16{};o[2]=f32x16{};o[3]=f32x16{};
  int t=1;
  #undef CMASK
  #define CMASK(P0,P1,t) do{}while(0)
  for(;t+5<NT;t+=2){
    STEP(pB0,pB1,pA0,pA1,t,true,true,true);     WAIT_BAR(3); RESC(); ROT();
    STEP(pA0,pA1,pB0,pB1,t+1,true,true,true);   WAIT_BAR(3); RESC(); ROT();
  }
  #undef CMASK
  #define CMASK(P0,P1,t) do{int jb_=(t)-(NT-4); if(jb_>=0)cmask(P0,P1,jb_,qrel,hi);}while(0)
  #define ENDW(tt) do{ if((tt)+3<NT){WAIT_BAR(3);} else if((tt)+2<NT){WAIT_BAR(2);} else {WAIT_BAR(0);} }while(0)
  for(;t+1<NT;t+=2){
    STEP(pB0,pB1,pA0,pA1,t,(t+3<NT),(t+1<NT),(t+1<NT));       ENDW(t);   RESC(); ROT();
    STEP(pA0,pA1,pB0,pB1,t+1,(t+4<NT),(t+2<NT),(t+2<NT));     ENDW(t+1); RESC(); ROT();
  }
  STEP(pB0,pB1,pA0,pA1,NT-1,false,false,false); RESC();
  { float sacc=pB0[0]+pB0[1]; _Pragma("unroll") for(int r=2;r<16;++r)sacc+=pB0[r]; _Pragma("unroll") for(int r=0;r<16;++r)sacc+=pB1[r]; l_reg+=sacc;
    pw0=(u32x4){PKW(pB0,0),PKW(pB0,2),PKW(pB0,4),PKW(pB0,6)};pw1=(u32x4){PKW(pB0,8),PKW(pB0,10),PKW(pB0,12),PKW(pB0,14)};pw2=(u32x4){PKW(pB1,0),PKW(pB1,2),PKW(pB1,4),PKW(pB1,6)};pw3=(u32x4){PKW(pB1,8),PKW(pB1,10),PKW(pB1,12),PKW(pB1,14)};
    int ln_; asm volatile("v_mbcnt_lo_u32_b32 %0, -1, 0\n\tv_mbcnt_hi_u32_b32 %0, -1, %0":"=v"(ln_)); ln_&=63;
    const int vb0=(int)(lds0+LDS_V)+((ln_>>4)&1)*32+(ln_&3)*8+(4*((ln_>>5)&1)+((ln_&15)>>2))*64;
    SBAR(); pv(o,vb0+2*sl_cur,PAF(0),PAF(1),PAF(2),PAF(3)); }
  #undef PKW
  #undef PAF
  #undef VFR
  #undef WFR
  #undef VOFF
  #undef WRD
  #undef ZC
  #undef PIN
  #undef MX3
  #undef GAPA
  #undef GAPB
  #undef EX
  #undef VRD
  #undef KRD
  #undef STEP
  #undef ENDW
  {auto rr=__builtin_amdgcn_permlane32_swap(__float_as_uint(l_reg),__float_as_uint(l_reg),false,false);l_reg=__uint_as_float(rr[0])+__uint_as_float(rr[1]);}
  int le_; asm volatile("v_mbcnt_lo_u32_b32 %0, -1, 0\n\tv_mbcnt_hi_u32_b32 %0, -1, %0":"=v"(le_)); le_&=63; const int r32e=le_&31,hie=(le_>>5)&1;
  float*wsfe=(float*)(shm+LDS_WS)+wid*64;
  if(hie==0)wsfe[32+r32e]=l_reg;asm volatile("s_waitcnt lgkmcnt(0)":::"memory");
  float rli[16];
  #pragma unroll
  for(int r=0;r<16;++r)rli[r]=__builtin_amdgcn_rcpf(wsfe[32+crow(r,hie)]);
  bf16*Ow=O+(rowbase+q0+wid*QBLK)*512+hv*128;
  { bf16*stg=(bf16*)(shm+LDS_OST)+wid*4096;
    #pragma unroll
    for(int r=0;r<16;++r){const int orow=crow(r,hie);
      #pragma unroll
      for(int d0=0;d0<4;++d0)stg[orow*128+d0*32+r32e]=__float2bfloat16(o[d0][r]*rli[r]);}
    asm volatile("s_waitcnt lgkmcnt(0)":::"memory");
    const rsrc_t orr_=wt_rsrc(O,(unsigned)(16384*512*2)); const unsigned owoff_=(unsigned)(((rowbase+q0+wid*QBLK)*512+hv*128)*2);
    #pragma unroll
    for(int i=0;i<8;++i){const int row=i*4+((le_>>4)&3),ch=le_&15; const u32x4 v=*(const u32x4*)(stg+row*128+ch*8); st16_wt(orr_,owoff_+(unsigned)((row*512+ch*8)*2),v);} }
  asm volatile("s_waitcnt lgkmcnt(0)\n\ts_barrier":::"memory");
  #undef DMA_K
  #undef DMA_V
  #undef CMASK
  #undef START
  #undef RESC
  #undef ROT
}
constexpr int ATTN_LDS_BYTES=LDS_BYTES;
struct AttnTensors { const bf16* Q; const bf16* K; const bf16* V; bf16* O; };
struct AttnUnit { int bhc; int qb; };
struct StaticOrder {
  int vcu;
  __device__ __forceinline__ explicit StaticOrder(int grid,int block):vcu((block%8)*(grid/8)+block/8){}
  __device__ __forceinline__ bool next(int i,AttnUnit&u)const{ if(i>=2)return false; const int s=vcu&7; u.bhc=vcu>>3; u.qb=(i==0)?s:15-s; return true; }
};
template<class Sched,class Mid,int THRL=8> __device__ __forceinline__ void attn_phase(char*lds,const AttnTensors&T,const Sched&S,const Mid&mid){
  AttnUnit u;
  for(int i=0;S.next(i,u);++i){ if(i==1)mid(); const int b=u.bhc>>3,hh=(u.bhc>>1)&3,c=u.bhc&1; attn_unit<THRL>(b,hh*2+c,hh,u.qb,T.Q,T.K,T.V,T.O+(long)c*16384*512,lds); }
}
#undef SBAR
#undef WAIT_BAR
}


template <int PART> __device__ __forceinline__ void phase2b(const Params& p, const Ctx& c) {
    const bf16_t* PROJ = (const bf16_t*)(p.ws + WS_PROJ); const bf16_t* ATT = (const bf16_t*)p.out; const rsrc_t mixr = wt_rsrc(p.ws + WS_XN, (unsigned)(T * D * 2));
    const int lane = c.lane;
    const float d1 = wave_sum(p.lq1[lane] * p.lk1[lane]), d2 = wave_sum(p.lq2[lane] * p.lk2[lane]);
    const float lam = expf(d1) - expf(d2) + LAM_INIT;
    float sg[8], w0[8], w1[8], w2[8], cgn[8];
#pragma unroll
    for (int i = 0; i < 8; ++i) { sg[i] = p.subln_g[(8 * lane + i) & 127] * (1.f - LAM_INIT); w0[i] = p.conv_w[8 * lane + i]; w1[i] = p.conv_w[512 + 8 * lane + i]; w2[i] = p.conv_w[1024 + 8 * lane + i]; cgn[i] = p.conv_out_g[8 * lane + i]; }
    if constexpr ((PART & 1) != 0) {
        for (int t0 = c.gw; t0 < T; t0 += 4 * c.ngw) {
            u32x4 A0[4], A1[4];
#pragma unroll
            for (int r = 0; r < 4; ++r) { const int t = (t0 + r * c.ngw < T) ? t0 + r * c.ngw : t0; A0[r] = *(const u32x4*)(ATT + (size_t)t * 512 + 8 * lane); A1[r] = *(const u32x4*)(ATT + ((size_t)T + t) * 512 + 8 * lane); }
#pragma unroll
            for (int r = 0; r < 4; ++r) { const int t = t0 + r * c.ngw; if (t < T) {
                float a0[8], a1[8], o[8]; unpack8(A0[r], a0); unpack8(A1[r], a1);
                float ss = 0.f;
#pragma unroll
                for (int i = 0; i < 8; ++i) { o[i] = a0[i] - lam * a1[i]; ss += o[i] * o[i]; }
                ss += lane_get(ss, lane ^ 1); ss += lane_get(ss, lane ^ 2); ss += lane_get(ss, lane ^ 4); ss += lane_get(ss, lane ^ 8);
                const float rinv = rsqrtf(ss * (1.f / 128.f) + EPS);
                u32x4 w; w.x = pk2(o[0] * rinv * sg[0], o[1] * rinv * sg[1]); w.y = pk2(o[2] * rinv * sg[2], o[3] * rinv * sg[3]);
                w.z = pk2(o[4] * rinv * sg[4], o[5] * rinv * sg[5]); w.w = pk2(o[6] * rinv * sg[6], o[7] * rinv * sg[7]);
                st16_wt(mixr, (unsigned)((t * D + 512 + 8 * lane) * 2), w); } }
        }
    }
    if constexpr ((PART & 2) != 0) {
        for (int t0 = c.gw; t0 < T; t0 += 2 * c.ngw) {
            u32x4 X0[2], B0[2], C0[2], X1[2], C1[2], X2[2], C2[2];
#pragma unroll
            for (int r = 0; r < 2; ++r) { const int t = (t0 + r * c.ngw < T) ? t0 + r * c.ngw : t0, s = t & (SEQ - 1);
                const bf16_t* r0 = PROJ + (size_t)t * DIN + 8 * lane; const bf16_t* r1 = r0 - (s >= 1 ? DIN : 0); const bf16_t* r2 = r0 - (s >= 2 ? 2 * DIN : 0);
                X0[r] = *(const u32x4*)(r0 + COL_XC); B0[r] = *(const u32x4*)(r0 + COL_BG); C0[r] = *(const u32x4*)(r0 + COL_CG);
                X1[r] = *(const u32x4*)(r1 + COL_XC); C1[r] = *(const u32x4*)(r1 + COL_CG); X2[r] = *(const u32x4*)(r2 + COL_XC); C2[r] = *(const u32x4*)(r2 + COL_CG); }
#pragma unroll
            for (int r = 0; r < 2; ++r) { const int t = t0 + r * c.ngw; if (t < T) {
                const int s = t & (SEQ - 1); const float m1 = s >= 1 ? 1.f : 0.f, m2 = s >= 2 ? 1.f : 0.f;
                float xc[8], bg[8], cgt[8], xa[8], ca[8], xb[8], cb[8], y[8];
                unpack8(X0[r], xc); unpack8(B0[r], bg); unpack8(C0[r], cgt); unpack8(X1[r], xa); unpack8(C1[r], ca); unpack8(X2[r], xb); unpack8(C2[r], cb);
                float ss = 0.f;
#pragma unroll
                for (int i = 0; i < 8; ++i) { const float u0 = cgt[i] * xc[i], u1 = ca[i] * xa[i] * m1, u2 = cb[i] * xb[i] * m2; y[i] = bg[i] * (w0[i] * u2 + w1[i] * u1 + w2[i] * u0); ss += y[i] * y[i]; }
                ss += lane_get(ss, lane ^ 1); ss += lane_get(ss, lane ^ 2); ss += lane_get(ss, lane ^ 4);
                const float rinv = rsqrtf(ss * (1.f / 64.f) + EPS);
                u32x4 w; w.x = pk2(y[0] * rinv * cgn[0], y[1] * rinv * cgn[1]); w.y = pk2(y[2] * rinv * cgn[2], y[3] * rinv * cgn[3]);
                w.z = pk2(y[4] * rinv * cgn[4], y[5] * rinv * cgn[5]); w.w = pk2(y[6] * rinv * cgn[6], y[7] * rinv * cgn[7]);
                st16_wt(mixr, (unsigned)((t * D + 8 * lane) * 2), w); } }
        }
    }
}

constexpr int WR_PITCH = 2048 + 64;
constexpr int P3B_X_OFF = 48 * WR_PITCH;
constexpr int P3B_H_OFF = P3B_X_OFF + 16384 + 4096;
constexpr int P3B_G_OFF = P3B_X_OFF + 16384;
template <int VAR = 0> __device__ __forceinline__ void phase3b(const Params& p, const Ctx& c) {
    unsigned char* HN2 = p.ws + WS_XN;
    const bf16_t* Wr = (const bf16_t*)(p.ws + WS_WR); float* RSTD = (float*)(p.ws + WS_RSTD);
    const int fr = c.lane & 15, fq = c.lane >> 4, tg = c.wave & 3, kh = c.wave >> 2;
    unsigned char* wlds = c.lds; float* xch = (float*)(c.lds + P3B_X_OFF); float* glds = (float*)(c.lds + P3B_G_OFF);
    unsigned* hist = (unsigned*)(c.lds + P3B_H_OFF); u32x4* ENT = (u32x4*)(p.ws + WS_ENT); unsigned* HIST = (unsigned*)(p.ws + WS_HIST);
    if (c.tid < 64) hist[c.tid] = 0u;
    __syncthreads();
    { u32x4 tw[12]; f32x4 tg = (f32x4){0.f, 0.f, 0.f, 0.f};
#pragma unroll
      for (int q = 0; q < 12; ++q) { const int i = c.tid + q * NTHREADS, row = i >> 7, ch = i & 127; tw[q] = *(const u32x4*)(Wr + (size_t)row * D + ch * 8); }
      if (c.tid < D / 4) tg = *(const f32x4*)(p.ffn_norm_g + 4 * c.tid);
#pragma unroll
      for (int q = 0; q < 12; ++q) { const int i = c.tid + q * NTHREADS, row = i >> 7, ch = i & 127; *(u32x4*)(wlds + row * WR_PITCH + ch * 16) = tw[q]; }
      if (c.tid < D / 4) *(f32x4*)(glds + 4 * c.tid) = tg; }
    __syncthreads();
    for (int blk = c.bid; blk < T / 64; blk += c.nb) {
        const int t = blk * 64 + tg * 16 + fr, kbase = kh * 512;
        const float* hrow = p.x + (size_t)t * D + kbase + 8 * fq; const float* grow = glds + kbase + 8 * fq;
        const bf16_t* arow = (const bf16_t*)(p.ws + WS_AO) + (size_t)t * D + kbase + 8 * fq;
        unsigned char* orow = HN2 + (size_t)t * D + kbase + 8 * fq;
        f32x4 hb[16][2]; u32x4 ab[16];
#pragma unroll
        for (int st = 0; st < 16; ++st) { hb[st][0] = __builtin_nontemporal_load((const f32x4*)(hrow + st * 32)); hb[st][1] = __builtin_nontemporal_load((const f32x4*)(hrow + st * 32 + 4)); ab[st] = *(const u32x4*)(arow + st * 32); }
        f32x4 acc[3]; acc[0] = (f32x4){0.f, 0.f, 0.f, 0.f}; acc[1] = acc[0]; acc[2] = acc[0];
        float ss = 0.f;
        const unsigned char* wb = wlds + fr * WR_PITCH + (kbase + 8 * fq) * 2;
#pragma unroll
        for (int st = 0; st < 16; ++st) {
            const u32x4 aw = ab[st];
            const f32x4 h0 = hb[st][0] + (f32x4){bflo(aw.x), bfhi(aw.x), bflo(aw.y), bfhi(aw.y)}, h1 = hb[st][1] + (f32x4){bflo(aw.z), bfhi(aw.z), bflo(aw.w), bfhi(aw.w)};
            const f32x4 g0 = *(const f32x4*)(grow + st * 32), g1 = *(const f32x4*)(grow + st * 32 + 4);
            ss += (h0.x * h0.x + h0.y * h0.y) + (h0.z * h0.z + h0.w * h0.w) + (h1.x * h1.x + h1.y * h1.y) + (h1.z * h1.z + h1.w * h1.w);
            float a[8] = {h0.x * g0.x, h0.y * g0.y, h0.z * g0.z, h0.w * g0.w, h1.x * g1.x, h1.y * g1.y, h1.z * g1.z, h1.w * g1.w};
            u32x4 hw, lw;
#pragma unroll
            for (int i = 0; i < 4; ++i) { const unsigned ha = f2bf(a[2 * i]), hb2 = f2bf(a[2 * i + 1]); hw[i] = ha | (hb2 << 16); lw[i] = pk2(a[2 * i] - bf2f((unsigned short)ha), a[2 * i + 1] - bf2f((unsigned short)hb2)); }
            if (!(VAR & 2)) { u32x2 o8; o8.x = pk4_fp8(a[0], a[1], a[2], a[3]); o8.y = pk4_fp8(a[4], a[5], a[6], a[7]); *(u32x2*)(orow + st * 32) = o8; }
            const bf16x8 Ahi = __builtin_bit_cast(bf16x8, hw), Alo = __builtin_bit_cast(bf16x8, lw);
#pragma unroll
            for (int nf = 0; nf < 3; ++nf) {
                const bf16x8 w1 = *(const bf16x8*)(wb + nf * 16 * WR_PITCH + st * 64);
                acc[nf] = __builtin_amdgcn_mfma_f32_16x16x32_bf16(w1, Ahi, acc[nf], 0, 0, 0);
                acc[nf] = __builtin_amdgcn_mfma_f32_16x16x32_bf16(w1, Alo, acc[nf], 0, 0, 0);
            }
        }
        float* xs = xch + (tg * 64 + c.lane) * 16;
        if (kh == 1) { *(f32x4*)(xs) = acc[0]; *(f32x4*)(xs + 4) = acc[1]; *(f32x4*)(xs + 8) = acc[2]; xs[12] = ss; }
        __syncthreads();
        if (kh == 0) {
            acc[0] += *(const f32x4*)(xs); acc[1] += *(const f32x4*)(xs + 4); acc[2] += *(const f32x4*)(xs + 8); ss += xs[12];
            { const int ln = fr + 16 * fq; ss += lane_get(ss, ln ^ 16); ss += lane_get(ss, ln ^ 32); }
            const float rstd = rsqrtf(ss * (1.f / D) + EPS);
            float le[8];
#pragma unroll
            for (int j = 0; j < 4; ++j) { le[j] = acc[0][j] * rstd; le[4 + j] = acc[1][j] * rstd; }
            const float lg = acc[2][0] * rstd;
            float gl[4];
#pragma unroll
            for (int g = 0; g < 4; ++g) gl[g] = lane_get(lg, fr + 16 * g);
            int gi = 0; float gm = gl[0];
#pragma unroll
            for (int g = 1; g < 4; ++g) if (gl[g] > gm) { gm = gl[g]; gi = g; }
            float gs = 0.f;
#pragma unroll
            for (int g = 0; g < 4; ++g) gs += expf(gl[g] - gm);
            const float ggate = 1.f / gs;
            int i1 = 0; float v1 = le[0];
#pragma unroll
            for (int e = 1; e < 8; ++e) if (le[e] > v1) { v1 = le[e]; i1 = e; }
            int i2 = 0; float v2 = -INFINITY;
#pragma unroll
            for (int e = 0; e < 8; ++e) if (e != i1 && le[e] > v2) { v2 = le[e]; i2 = e; }
            const float ex = expf(v2 - v1), wa = 1.f / (1.f + ex), wb2 = ex * wa;
            if (fq == 0) RSTD[t] = rstd;
            if (!(VAR & 1) && fq == gi) {
                const int l1 = ((gi * 8 + i1) << 1), l2 = ((gi * 8 + i2) << 1) + 1;
                const unsigned r1 = __hip_atomic_fetch_add(hist + l1, 1u, __ATOMIC_RELAXED, __HIP_MEMORY_SCOPE_WORKGROUP), r2 = __hip_atomic_fetch_add(hist + l2, 1u, __ATOMIC_RELAXED, __HIP_MEMORY_SCOPE_WORKGROUP);
                u32x4* e = ENT + (size_t)blk * 128 + (tg * 16 + fr) * 2;
                e[0] = (u32x4){(unsigned)l1, r1, (unsigned)t, __builtin_bit_cast(unsigned, wa * ggate)};
                e[1] = (u32x4){(unsigned)l2, r2, (unsigned)t, __builtin_bit_cast(unsigned, wb2 * ggate)};
            }
        }
        __syncthreads();
        if (!(VAR & 1) && c.tid < 64) { HIST[blk * 64 + c.tid] = hist[c.tid]; hist[c.tid] = 0u; }
        __syncthreads();
    }
}

__device__ __forceinline__ void phase3c(const Params& p, const Ctx& c) {
    const unsigned* HIST = (const unsigned*)(p.ws + WS_HIST); const u32x4* ENT = (const u32x4*)(p.ws + WS_ENT);
    unsigned* cnt = (unsigned*)(p.ws + WS_CTL); int* list = (int*)(p.ws + WS_LIST); float* wl = (float*)(p.ws + WS_WL);
    unsigned* part = (unsigned*)c.lds;
    const int l = c.tid & 63, pt = c.tid >> 6;
    for (int blk = c.bid; blk < T / 64; blk += c.nb) {
        unsigned pre = 0u, tot = 0u;
#pragma unroll 8
        for (int b = pt * 32; b < pt * 32 + 32; ++b) { const unsigned v = HIST[b * 64 + l]; tot += v; pre += (b < blk) ? v : 0u; }
        __syncthreads();
        part[pt * 64 + l] = pre; part[512 + pt * 64 + l] = tot;
        __syncthreads();
        if (c.tid < 128) {
            const u32x4 e = ENT[(size_t)blk * 128 + c.tid];
            unsigned base = 0u;
#pragma unroll
            for (int q = 0; q < 8; ++q) base += part[q * 64 + e.x];
            const size_t pos = (size_t)e.x * T + base + e.y;
            const unsigned ez = e.z, ew = e.w;
            st4_wt(list + pos, ez); st4_wt(wl + pos, ew);
        }
        if (blk == 0 && c.tid < 64) { unsigned t2 = 0u;
#pragma unroll
            for (int q = 0; q < 8; ++q) t2 += part[512 + q * 64 + c.tid];
            st4_wt(cnt + c.tid, t2); }
    }
}

constexpr int TAB_OFF = 131072, UT_OFF = TAB_OFF + 2048, BARST_OFF = LDS_BYTES - 64;
template <bool GATHERA> struct GroupSched {
    struct Unit { int l, mt, pn, ui; bool hf; };
    const int* tab; const unsigned* ut; const char* Abase; const char* Bbase; int K, G, vcu, l0, lstep, nl; int lane_;
    __device__ __forceinline__ bool next(int i, Unit& u) const {
        const int L = i * G + vcu, totF = tab[129 + nl], totH = tab[194 + nl];
        if (L >= (totF + totH) * 4) return false;
        const int tile = L >> 2, lane = lane_, ln = lane < nl ? lane : 0;
        int j, mt; bool hf;
        if (tile < totF) { const int pv = tab[130 + ln]; j = __builtin_popcountll(__ballot(lane < nl && pv <= tile)); mt = tile - tab[129 + j]; hf = false; }
        else { const int t2 = tile - totF, pv = tab[195 + ln]; j = __builtin_popcountll(__ballot(lane < nl && pv <= t2)); mt = tab[130 + j] - tab[129 + j]; hf = true; }
        u.l = l0 + j * lstep; u.mt = __builtin_amdgcn_readfirstlane(mt); u.pn = L & 3; u.ui = i; u.hf = hf; return true;
    }
    __device__ __forceinline__ bool half(const Unit& u) const { return u.hf; }
    __device__ __forceinline__ const char* a_base(const Unit& u) const { return GATHERA ? Abase : Abase + (size_t)(__builtin_amdgcn_readfirstlane(tab[64 + u.l]) + u.mt * 256) * K * 2; }
    __device__ __forceinline__ const char* b_base(const Unit& u) const { return Bbase + (size_t)((u.l >> 1) * 1024 + u.pn * 256) * K * 2; }
    __device__ __forceinline__ unsigned rowoff(const Unit& u, int r) const { return ut[u.ui * 768 + r]; }
    __device__ __forceinline__ void a_ready(const Unit&) const {}
    __device__ __forceinline__ void done(const Unit&) const {}
};
template <bool GATHERA> __device__ __forceinline__ void group_tables(const Params& p, const Ctx& c, GroupSched<GATHERA>& S, int l0, int lstep, int nl, int K, const void* Abase, const void* Bbase) {
    int* tab = (int*)(c.lds + TAB_OFF); unsigned* ut = (unsigned*)(c.lds + UT_OFF);
    const unsigned* cnt = (const unsigned*)(p.ws + WS_CTL); const int* list = (const int*)(p.ws + WS_LIST); const float* wl = (const float*)(p.ws + WS_WL); const float* RSTD = (const float*)(p.ws + WS_RSTD);
    __syncthreads();
    if (c.wave == 0) {
        const int l = c.lane, n = (int)cnt[l], rem = n & 255, hfl = (rem >= 1 && rem <= 128) ? 1 : 0, tiles = (n + 255) >> 8;
        int rb = tiles << 8, mf = tiles - hfl, mh = hfl;
#pragma unroll
        for (int o = 1; o < 64; o <<= 1) { const int sl = (l - o) & 63, a = lane_geti(rb, sl), b2 = lane_geti(mf, sl), c2 = lane_geti(mh, sl); if (l >= o) { rb += a; mf += b2; mh += c2; } }
        tab[l] = n; tab[64 + l] = rb - (tiles << 8); tab[129 + l] = mf - (tiles - hfl); tab[194 + l] = mh - hfl;
        if (l == 63) { tab[64 + 64] = rb; tab[129 + 64] = mf; tab[194 + 64] = mh; }
    }
    __syncthreads();
    S.tab = tab; S.ut = ut; S.Abase = (const char*)Abase; S.Bbase = (const char*)Bbase; S.K = K; S.G = c.nb; S.vcu = (c.nb % 8 == 0) ? (c.bid % 8) * (c.nb / 8) + c.bid / 8 : c.bid; S.l0 = l0; S.lstep = lstep; S.nl = nl; S.lane_ = c.lane;
    typename GroupSched<GATHERA>::Unit u0, u1, u2, u3;
    const bool h0 = S.next(0, u0), h1 = S.next(1, u1), h2 = S.next(2, u2), h3 = S.next(3, u3);
    if (c.tid < 256) {
        const int r = c.tid; int tok[4]; float wv[4], rs[4]; bool vd[4];
#define GT_LOAD(i, h, u) do { tok[i] = 0; wv[i] = 0.f; vd[i] = false; if (h) { const int n = tab[u.l], pos = u.mt * 256 + r; vd[i] = pos < n; const int idx = vd[i] ? pos : n - 1; \
            tok[i] = list[(size_t)u.l * T + idx]; const float w_ = wl[(size_t)u.l * T + idx]; wv[i] = vd[i] ? w_ : 0.f; } } while (0)
        GT_LOAD(0, h0, u0); GT_LOAD(1, h1, u1); GT_LOAD(2, h2, u2); GT_LOAD(3, h3, u3);
#undef GT_LOAD
        rs[0] = h0 ? RSTD[tok[0]] : 0.f; rs[1] = h1 ? RSTD[tok[1]] : 0.f; rs[2] = h2 ? RSTD[tok[2]] : 0.f; rs[3] = h3 ? RSTD[tok[3]] : 0.f;
        const bool hh[4] = {h0, h1, h2, h3};
#pragma unroll
        for (int i = 0; i < 4; ++i) if (hh[i]) {
            ut[i * 768 + r] = GATHERA ? (unsigned)tok[i] * (unsigned)(K * 2) : (vd[i] ? (unsigned)tok[i] : 0xffffffffu);
            ut[i * 768 + 256 + r] = __builtin_bit_cast(unsigned, wv[i]);
            ut[i * 768 + 512 + r] = __builtin_bit_cast(unsigned, rs[i]);
        }
    }
    __syncthreads();
}
__device__ __forceinline__ void group_tables_reuse(const Ctx& c, GroupSched<false>& S, int nl, int K, const void* Abase, const void* Bbase) {
    int* tab = (int*)(c.lds + TAB_OFF); unsigned* ut = (unsigned*)(c.lds + UT_OFF);
    S.tab = tab; S.ut = ut; S.Abase = (const char*)Abase; S.Bbase = (const char*)Bbase; S.K = K; S.G = c.nb; S.vcu = (c.nb % 8 == 0) ? (c.bid % 8) * (c.nb / 8) + c.bid / 8 : c.bid; S.l0 = 0; S.lstep = 1; S.nl = nl; S.lane_ = c.lane;
    GroupSched<false>::Unit u0, u1, u2, u3;
    const bool h0 = S.next(0, u0), h1 = S.next(1, u1), h2 = S.next(2, u2), h3 = S.next(3, u3);
    if (c.tid < 256) {
        const int r = c.tid;
#define GT_FIX(i, h, u) do { if (h) { const bool vd_ = u.mt * 256 + r < tab[u.l]; const unsigned w0_ = ut[i * 768 + r]; ut[i * 768 + r] = vd_ ? (w0_ >> 10) : 0xffffffffu; } } while (0)
        GT_FIX(0, h0, u0); GT_FIX(1, h1, u1); GT_FIX(2, h2, u2); GT_FIX(3, h3, u3);
#undef GT_FIX
    }
    __syncthreads();
}
struct EpiAct {
    static constexpr bool PERM = true, AFTER_DRAIN = false;
    unsigned char* ACT; const int* tab; const unsigned* ut;
    __device__ __forceinline__ void operator()(const f32x4 (&acc)[2][2][4][2], const GroupSched<true>::Unit& u, int wr, int wc, int fr, int fq) const {
        const int rb = tab[64 + u.l] + u.mt * 256;
#pragma unroll
        for (int ai = 0; ai < 2; ++ai)
#pragma unroll
            for (int m = 0; m < 4; ++m) {
                const int r = ai * 128 + wr * 64 + m * 16 + fr;
                const float w = __builtin_bit_cast(float, ut[u.ui * 768 + 256 + r]), rs = __builtin_bit_cast(float, ut[u.ui * 768 + 512 + r]);
                float a[8];
#pragma unroll
                for (int n = 0; n < 2; ++n)
#pragma unroll
                    for (int j = 0; j < 4; ++j) { const float g = acc[ai][0][m][n][j] * rs, up = acc[ai][1][m][n][j] * rs; a[4 * n + j] = g * __builtin_amdgcn_rcpf(1.f + __expf(-g)) * up * (w * ACT8_SCALE); }
                u32x2 o; o.x = pk4_fp8(a[0], a[1], a[2], a[3]); o.y = pk4_fp8(a[4], a[5], a[6], a[7]);
                *(u32x2*)(ACT + (size_t)(rb + r) * F + u.pn * 128 + wc * 32 + 8 * fq) = o;
            }
    }
};
struct EpiY {
    static constexpr bool PERM = true, AFTER_DRAIN = false;
    bf16_t* Y0; size_t ydelta; const unsigned* ut; const bf16_t* AO;
    __device__ __forceinline__ void operator()(const f32x4 (&acc)[2][2][4][2], const GroupSched<false>::Unit& u, int wr, int wc, int fr, int fq) const {
        bf16_t* Y = Y0 + (size_t)(u.l & 1) * ydelta;
        const int col0 = u.pn * 256 + wc * 32 + 8 * fq;
        const bool addao = !(u.l & 1);
        unsigned tok[2][4]; u32x4 aw[2][4][2];
#pragma unroll
        for (int ai = 0; ai < 2; ++ai)
#pragma unroll
            for (int m = 0; m < 4; ++m) tok[ai][m] = ut[u.ui * 768 + ai * 128 + wr * 64 + m * 16 + fr];
        if (addao) {
#pragma unroll
            for (int ai = 0; ai < 2; ++ai)
#pragma unroll
                for (int m = 0; m < 4; ++m) { const unsigned tk = tok[ai][m] != 0xffffffffu ? tok[ai][m] : 0u;
                    const bf16_t* arow = AO + (size_t)tk * D + col0; aw[ai][m][0] = *(const u32x4*)(arow); aw[ai][m][1] = *(const u32x4*)(arow + 128); }
            __builtin_amdgcn_s_waitcnt(0x0F70);
        }
#pragma unroll
        for (int ai = 0; ai < 2; ++ai)
#pragma unroll
            for (int m = 0; m < 4; ++m) {
                if (tok[ai][m] != 0xffffffffu) {
                    const rsrc_t yr = wt_rsrc(Y, (unsigned)(T * D * 2)); const unsigned yoff = (unsigned)((tok[ai][m] * D + col0) * 2);
#pragma unroll
                    for (int bj = 0; bj < 2; ++bj) {
                        f32x4 v0 = acc[ai][bj][m][0], v1 = acc[ai][bj][m][1];
                        if (addao) { const u32x4 a4 = aw[ai][m][bj];
                            v0 += (f32x4){bflo(a4.x), bfhi(a4.x), bflo(a4.y), bfhi(a4.y)}; v1 += (f32x4){bflo(a4.z), bfhi(a4.z), bflo(a4.w), bfhi(a4.w)}; }
                        u32x4 w; w.x = pg8::cvt_pk_bf16(v0.x, v0.y); w.y = pg8::cvt_pk_bf16(v0.z, v0.w); w.z = pg8::cvt_pk_bf16(v1.x, v1.y); w.w = pg8::cvt_pk_bf16(v1.z, v1.w);
                        st16_wt(yr, yoff + 256u * bj, w);
                    }
                }
            }
    }
};
__device__ __forceinline__ void phase4_fast(const Params& p, const Ctx& c) {
    GroupSched<true> S; group_tables<true>(p, c, S, 0, 1, NLIST, D / 2, p.ws + WS_XN, p.ws + WS_WGU);
    EpiAct E{(unsigned char*)p.out, S.tab, S.ut};
    pg8::gemm_phase<EpiAct, GroupSched<true>, true, true, true, 122, 127>((PG8_LAS unsigned char*)c.lds, D / 2, S, E, c.wave);
}
__device__ __forceinline__ void phase5_fast(const Params& p, const Ctx& c) {
    GroupSched<false> S; group_tables_reuse(c, S, NLIST, F / 2, p.out, p.ws + WS_WD);
    EpiY E{(bf16_t*)(p.ws + WS_XN), (WS_YB1 - WS_XN) / 2, S.ut, (const bf16_t*)(p.ws + WS_AO)};
    pg8::gemm_phase<EpiY, GroupSched<false>, true, true, false, 122, 123>((PG8_LAS unsigned char*)c.lds, F / 2, S, E, c.wave);
}
__device__ __forceinline__ void phase6(const Params& p, const Ctx& c) {
    const bf16_t* Y0 = (const bf16_t*)(p.ws + WS_XN); const bf16_t* Y1 = (const bf16_t*)(p.ws + WS_YB1);
    for (int t0 = c.gw; t0 < T; t0 += 2 * c.ngw) {
        f32x4 xv[2][2][2]; u32x4 ya[2][2], yb[2][2];
#pragma unroll
        for (int rr = 0; rr < 2; ++rr) { const int t = (t0 + rr * c.ngw < T) ? t0 + rr * c.ngw : t0;
#pragma unroll
            for (int hf = 0; hf < 2; ++hf) { const size_t o = (size_t)t * D + hf * 512 + 8 * c.lane;
                xv[rr][hf][0] = *(const f32x4*)(p.x + o); xv[rr][hf][1] = *(const f32x4*)(p.x + o + 4); ya[rr][hf] = *(const u32x4*)(Y0 + o); yb[rr][hf] = *(const u32x4*)(Y1 + o); } }
#pragma unroll
        for (int rr = 0; rr < 2; ++rr) { const int t = t0 + rr * c.ngw; if (t < T) {
#pragma unroll
            for (int hf = 0; hf < 2; ++hf) { const size_t o = (size_t)t * D + hf * 512 + 8 * c.lane;
                float y0[8], y1[8]; unpack8(ya[rr][hf], y0); unpack8(yb[rr][hf], y1);
                const f32x4 x0 = xv[rr][hf][0], x1 = xv[rr][hf][1]; f32x4 r0, r1;
                r0.x = x0.x + (y0[0] + y1[0]); r0.y = x0.y + (y0[1] + y1[1]); r0.z = x0.z + (y0[2] + y1[2]); r0.w = x0.w + (y0[3] + y1[3]);
                r1.x = x1.x + (y0[4] + y1[4]); r1.y = x1.y + (y0[5] + y1[5]); r1.z = x1.z + (y0[6] + y1[6]); r1.w = x1.w + (y0[7] + y1[7]);
                *(f32x4*)(p.out + o) = r0; *(f32x4*)(p.out + o + 4) = r1; } } }
    }
}

#define LAS __attribute__((address_space(3)))
#define XB_TMO      128
#define XB_XCNT(j)  (256  + 64 * (j))
#define XB_XSUB(j)  (1280 + 64 * (j))
#define XB_XGEN(j)  (2304 + 64 * (j))
#define XB_TOP      3328
#define XB_TOPGEN   3392
#define XCD_BAR_WORDS 3456
#define XB_SPIN_CAP (1u << 18)

__device__ __forceinline__ unsigned xb_ld(unsigned* p)              { return __hip_atomic_load(p, __ATOMIC_RELAXED, __HIP_MEMORY_SCOPE_AGENT); }
__device__ __forceinline__ unsigned xb_add(unsigned* p, unsigned v) { return __hip_atomic_fetch_add(p, v, __ATOMIC_RELAXED, __HIP_MEMORY_SCOPE_AGENT); }
__device__ __forceinline__ unsigned xb_xcc_id() { return (unsigned)__builtin_amdgcn_s_getreg((3 << 11) | 20) & 0xFu; }
#define XB_SPIN(cond, bar) do { unsigned _sp = 0; while (cond) { __builtin_amdgcn_s_sleep(1); \
    if ((++_sp & 255u) == 0u) { if (xb_ld(&(bar)[XB_TMO])) break; if (_sp > XB_SPIN_CAP) { atomicAdd(&(bar)[XB_TMO], 1u); break; } } } } while (0)

struct XcdBarrier {
    int w0;
    unsigned* bar; unsigned x;
    volatile LAS unsigned* st;
};

__device__ __forceinline__ XcdBarrier xcd_barrier_post(unsigned* bar, volatile LAS unsigned* st) {
    XcdBarrier b; b.bar = bar; b.x = xb_xcc_id(); b.st = st; b.w0 = __builtin_amdgcn_readfirstlane(threadIdx.x >> 6);
    if (threadIdx.x == 0) (void)xb_add(&bar[XB_XCNT(b.x)], 1u);
    return b;
}
__device__ __forceinline__ void xcd_barrier_complete(unsigned* bar, unsigned x, unsigned& nloc, unsigned& nx) {
    const unsigned G = gridDim.x * gridDim.y * gridDim.z;
    unsigned sum, cnt, mine, sp = 0u;
    for (;;) {
        sum = 0u; cnt = 0u; mine = 0u;
#pragma unroll
        for (unsigned j = 0; j < 16; ++j) { const unsigned c = xb_ld(&bar[XB_XCNT(j)]); sum += c; cnt += (c > 0u) ? 1u : 0u; mine = (j == x) ? c : mine; }
        if (sum == G) break;
        __builtin_amdgcn_s_sleep(1);
        if ((++sp & 255u) == 0u) { if (xb_ld(&bar[XB_TMO])) break; if (sp > XB_SPIN_CAP) { atomicAdd(&bar[XB_TMO], 1u); break; } }
    }
    nloc = mine > 0u ? mine : 1u; nx = cnt > 0u ? cnt : 1u;
}

__device__ __forceinline__ void xcd_barrier(const XcdBarrier& b, const bool wb) {
    asm volatile("s_waitcnt vmcnt(0)" ::: "memory");
    __syncthreads();
    if (b.w0 == 0 && my_lane() == 0) {
        unsigned* bar = b.bar;
        __builtin_amdgcn_s_waitcnt(0);
        unsigned nloc = b.st[0], nx = b.st[1];
        if (nloc == 0u) { xcd_barrier_complete(bar, b.x, nloc, nx); b.st[0] = nloc; b.st[1] = nx; }
        const unsigned old = xb_add(&bar[XB_XSUB(b.x)], 1u);
        const unsigned gen = old / nloc;
        if (old + 1u == (gen + 1u) * nloc) {
            if (wb) __builtin_amdgcn_fence(__ATOMIC_RELEASE, "agent");
            asm volatile("s_waitcnt vmcnt(0)" ::: "memory");
            const unsigned og = xb_add(&bar[XB_TOP], 1u);
            const unsigned tg = og / nx;
            if (og + 1u != (tg + 1u) * nx) XB_SPIN((int)(xb_ld(&bar[XB_TOP]) - (tg + 1u) * nx) < 0, bar);
            __builtin_amdgcn_fence(__ATOMIC_ACQUIRE, "agent");
            xb_add(&bar[XB_XGEN(b.x)], 1u);
            asm volatile("s_waitcnt vmcnt(0)" ::: "memory");
        } else {
            XB_SPIN(xb_ld(&bar[XB_XGEN(b.x)]) == gen, bar);
            __builtin_amdgcn_fence(__ATOMIC_ACQUIRE, "agent");
            asm volatile("s_waitcnt vmcnt(0)" ::: "memory");
        }
    }
    __syncthreads();
}

__device__ __forceinline__ Ctx make_ctx(unsigned char* lds, int wave0) {
    const int tid = (wave0 & 7) * 64 + my_lane();
    Ctx c; c.tid = tid; c.lane = tid & 63; c.wave = wave0 & 7; c.bid = blockIdx.x; c.nb = gridDim.x;
    c.gw = c.bid * NWAVES + c.wave; c.ngw = c.nb * NWAVES; c.lds = lds; return c;
}
template <int PH> __device__ __forceinline__ void run_phase(const Params& p, unsigned char* lds, int wave0) {
    const Ctx c = make_ctx(lds, wave0);
    if constexpr (PH == 0) phase0(p, c);
    if constexpr (PH == 1) phase1_fast(p, c);
    if constexpr (PH == 2) {
        const attn128::bf16* PROJ = (const attn128::bf16*)(p.ws + WS_PROJ);
        const attn128::AttnTensors AT{PROJ + COL_Q, PROJ + COL_K, PROJ + COL_V, (attn128::bf16*)p.out};
        const attn128::StaticOrder S((int)gridDim.x, (int)blockIdx.x);
        struct SideJob { const Params& p; unsigned char* lds; int wave0; bool on;
            __device__ __forceinline__ void operator()() const { if (on) { __syncthreads(); const Ctx c2 = make_ctx(lds, wave0); convert_experts(p, c2); convert_late(p, c2); phase2b<2>(p, c2); __syncthreads(); } } };
        const int mode = EXPERTS_IN_ATTN ? S.vcu % 3 : 3;
        SideJob{p, lds, wave0, mode == 0}();
        attn128::attn_phase<attn128::StaticOrder, SideJob>((char*)c.lds, AT, S, SideJob{p, lds, wave0, mode == 1});
        SideJob{p, lds, wave0, mode == 2}();
    }
    if constexpr (PH == 3) phase2b<EXPERTS_IN_ATTN ? 1 : 3>(p, c);
    if constexpr (PH == 4) phase3_fast(p, c);
    if constexpr (PH == 5) phase3b<0>(p, c);
    if constexpr (PH == 6) phase4_fast(p, c);
    if constexpr (PH == 7) phase5_fast(p, c);
    if constexpr (PH == 8) phase6(p, c);
    if constexpr (PH == 9) phase3c(p, c);
}
__global__ void __launch_bounds__(NTHREADS, 2) mega_kernel(Params p) {
    extern __shared__ __attribute__((aligned(16))) unsigned char lds[];
    volatile LAS unsigned* bst = (volatile LAS unsigned*)((LAS unsigned char*)lds + BARST_OFF);
    if (threadIdx.x < 4) bst[threadIdx.x] = 0u;
    __syncthreads();
    const XcdBarrier bar = xcd_barrier_post((unsigned*)(p.ws + WS_BAR), bst);
    const int wave0 = bar.w0;
#define GSYNC() xcd_barrier(bar, false)
#define GSYNC_WB() xcd_barrier(bar, true)
#define PH_(k) run_phase<k>(p, lds, wave0)
    PH_(0); GSYNC();
    PH_(1); GSYNC();
    PH_(2); GSYNC();
    PH_(3); GSYNC();
    PH_(4); GSYNC();
    PH_(5); GSYNC_WB();
    PH_(9); GSYNC();
    PH_(6); GSYNC_WB();
    PH_(7); GSYNC();
    PH_(8);
#undef PH_
#undef GSYNC
#undef GSYNC_WB
}

extern "C" void kernel_launch(void* const* d_in, const int* in_sizes, int n_in, void* d_out, int out_size, void* d_ws, size_t ws_size, hipStream_t stream) {
    static int grid = 0;
    if (grid == 0) {
        if (n_in != 19 || in_sizes[0] != T * D || out_size != T * D || ws_size < WS_END) { fprintf(stderr, "kernel_launch: unexpected shapes (n_in %d, in0 %d, out %d, ws %zu)\n", n_in, n_in > 0 ? in_sizes[0] : -1, out_size, ws_size); grid = -1; return; }
        int dev = 0, cus = 0;
        if (hipGetDevice(&dev) != hipSuccess || hipDeviceGetAttribute(&cus, hipDeviceAttributeMultiprocessorCount, dev) != hipSuccess) { grid = -1; return; }
        int per_cu = 0;
        (void)hipFuncSetAttribute((const void*)mega_kernel, hipFuncAttributeMaxDynamicSharedMemorySize, LDS_BYTES);
        if (hipOccupancyMaxActiveBlocksPerMultiprocessor(&per_cu, (const void*)mega_kernel, NTHREADS, LDS_BYTES) != hipSuccess || per_cu < 1) { fprintf(stderr, "kernel_launch: occupancy query failed (%d)\n", per_cu); (void)hipGetLastError(); per_cu = 1; }
        grid = cus;
        if (cus != 256) fprintf(stderr, "kernel_launch: built for 256 CUs (attention deal), device has %d\n", cus);
    }
    if (grid < 0) return;
    Params p{};
    const float** pf = (const float**)&p;
    for (int i = 0; i < 19; ++i) pf[i] = (const float*)d_in[i];
    p.out = (float*)d_out; p.ws = (unsigned char*)d_ws;
    if (hipMemsetAsync((char*)d_ws + WS_CTL, 0, CTL_ZERO_BYTES, stream) != hipSuccess) { fprintf(stderr, "kernel_launch: memset of the control words failed\n"); return; }
    void* args[] = {&p};
    hipError_t e = hipLaunchCooperativeKernel((const void*)mega_kernel, dim3(grid), dim3(NTHREADS), args, LDS_BYTES, stream);
    if (e != hipSuccess) fprintf(stderr, "cooperative launch failed: %s (grid %d)\n", hipGetErrorString(e), grid);
}
```

```cpp
#include <hip/hip_runtime.h>
#include <cstdio>
#include <cstdint>

#define EXPERTS_IN_ATTN 1

typedef unsigned short bf16_t;
typedef short bf16x8 __attribute__((ext_vector_type(8)));
typedef float f32x4 __attribute__((ext_vector_type(4)));
typedef unsigned u32x2 __attribute__((ext_vector_type(2)));
typedef unsigned u32x4 __attribute__((ext_vector_type(4)));
typedef int i32x4 __attribute__((ext_vector_type(4)));
typedef int i32x8 __attribute__((ext_vector_type(8)));

constexpr int BATCH = 4, SEQ = 4096, T = BATCH * SEQ, D = 1024, DIN = 3072, DCONV = 512;
constexpr int NH = 4, HD = 64, VD = 128;
constexpr int COL_XC = 0, COL_BG = 512, COL_CG = 1024, COL_Q = 1536, COL_K = 2048, COL_V = 2560;
constexpr int NG = 4, NE = 8, NEXP = NG * NE, F = 512, NLIST = NEXP * 2;
constexpr float EPS = 1e-6f;
constexpr float LOG2E = 1.4426950408889634f;
constexpr float QSCALE = 0.125f * LOG2E;
constexpr float LAM_INIT = 0.2f;
constexpr int NWAVES = 8, NTHREADS = NWAVES * 64;
constexpr int LDS_BYTES = 147456;

constexpr size_t MiB = 1u << 20;
constexpr size_t WS_CTL = 0;
constexpr size_t WS_BAR = 16384;
constexpr size_t CTL_ZERO_BYTES = 32768;
constexpr size_t WS_HIST = 384 * 1024;
constexpr size_t WS_WR = 65536;
constexpr size_t WS_RSTD = 512 * 1024;
constexpr size_t WS_SEG = 1 * MiB;
constexpr size_t WS_LIST = 1 * MiB;
constexpr size_t WS_WL = 5 * MiB;
constexpr size_t WS_WIN = 9 * MiB;
constexpr size_t WS_WOUT = 15 * MiB;
constexpr size_t WS_WGU = 17 * MiB;
constexpr size_t WS_WD = 81 * MiB;
constexpr size_t WS_XB = 49 * MiB;
constexpr size_t WS_RSTD0 = 640 * 1024;
constexpr size_t WS_XN = 113 * MiB;
constexpr size_t WS_PROJ = 145 * MiB;
constexpr size_t WS_AO = 145 * MiB;
constexpr size_t WS_YB1 = 177 * MiB;
constexpr size_t WS_ENT = 241 * MiB;
constexpr size_t WS_END = 242 * MiB;
constexpr int ACT_ROWS_MAX = 2 * T + NLIST * 256;

struct Params {
    const float* x; const float* attn_norm_g; const float* w_in; const float* conv_w; const float* conv_out_g;
    const float* q_norm_g; const float* k_norm_g; const float* lq1; const float* lk1; const float* lq2; const float* lk2;
    const float* subln_g; const float* w_out; const float* ffn_norm_g; const float* w_rg; const float* w_re;
    const float* w_gate; const float* w_up; const float* w_down;
    float* out; unsigned char* ws;
};

__device__ __forceinline__ unsigned f2bf(float f) { unsigned u = __builtin_bit_cast(unsigned, f); return (u + 0x7fffu + ((u >> 16) & 1u)) >> 16; }
__device__ __forceinline__ unsigned pk2(float lo, float hi) { return f2bf(lo) | (f2bf(hi) << 16); }
__device__ __forceinline__ float bf2f(unsigned short b) { return __builtin_bit_cast(float, (unsigned)b << 16); }
__device__ __forceinline__ float bflo(unsigned w) { return __builtin_bit_cast(float, w << 16); }
__device__ __forceinline__ float bfhi(unsigned w) { return __builtin_bit_cast(float, w & 0xffff0000u); }
__device__ __forceinline__ int my_lane() { int l; asm volatile("v_mbcnt_lo_u32_b32 %0, -1, 0\n\tv_mbcnt_hi_u32_b32 %0, -1, %0" : "=v"(l)); return l & 63; }
__device__ __forceinline__ float lane_get(float v, int src) { return __builtin_bit_cast(float, __builtin_amdgcn_ds_bpermute(src << 2, __builtin_bit_cast(int, v))); }
__device__ __forceinline__ int lane_geti(int v, int src) { return __builtin_amdgcn_ds_bpermute(src << 2, v); }
__device__ __forceinline__ float wave_sum(float v) {
    const int ln = my_lane();
#pragma unroll
    for (int o = 1; o < 64; o <<= 1) v += lane_get(v, ln ^ o);
    return v;
}
__device__ __forceinline__ void unpack8(const u32x4 w, float (&o)[8]) {
    o[0] = bflo(w.x); o[1] = bfhi(w.x); o[2] = bflo(w.y); o[3] = bfhi(w.y); o[4] = bflo(w.z); o[5] = bfhi(w.z); o[6] = bflo(w.w); o[7] = bfhi(w.w);
}

constexpr float W8_SCALE = 32.f, ACT8_SCALE = 16.f, Y8_SCALE = 16.f;
typedef float f32x2_ __attribute__((ext_vector_type(2)));
__device__ __forceinline__ void unpack8_fp8(const u32x2 w, float (&o)[8]) {
    const f32x2_ a = __builtin_amdgcn_cvt_pk_f32_fp8((int)w.x, false), b = __builtin_amdgcn_cvt_pk_f32_fp8((int)w.x, true), c = __builtin_amdgcn_cvt_pk_f32_fp8((int)w.y, false), d = __builtin_amdgcn_cvt_pk_f32_fp8((int)w.y, true);
    o[0] = a.x; o[1] = a.y; o[2] = b.x; o[3] = b.y; o[4] = c.x; o[5] = c.y; o[6] = d.x; o[7] = d.y; }
__device__ __forceinline__ unsigned pk4_fp8(float a, float b, float c, float d) { int v = 0; v = __builtin_amdgcn_cvt_pk_fp8_f32(a, b, v, false); v = __builtin_amdgcn_cvt_pk_fp8_f32(c, d, v, true); return (unsigned)v; }
typedef __amdgpu_buffer_rsrc_t rsrc_t;
__device__ __forceinline__ rsrc_t wt_rsrc(const void* base, unsigned bytes) { return __builtin_amdgcn_make_buffer_rsrc((void*)base, 0, bytes, 0x00020000); }
__device__ __forceinline__ void st16_wt(rsrc_t r, unsigned off, u32x4 v) { __builtin_amdgcn_raw_buffer_store_b128(v, r, off, 0, 16); }
__device__ __forceinline__ u32x4 ld16_sc1(rsrc_t r, unsigned off) { return __builtin_amdgcn_raw_buffer_load_b128(r, off, 0, 16); }
struct Ctx { int gw, ngw, lane, wave, bid, nb, tid; unsigned char* lds; };

struct TrItem { const float* W; bf16_t* WT; int K, N, k0, n0; };
__device__ __forceinline__ TrItem tr_item(const float* W, int K, int N, bf16_t* WT, int item) { const int nblk = N / 32, kb = item / nblk, nb = item % nblk; return TrItem{W, WT, K, N, 64 * kb, 32 * nb}; }
__device__ __forceinline__ void tr_load(const TrItem& t, f32x4 (&v)[8], int lane) {
#pragma unroll
    for (int i = 0; i < 8; ++i) v[i] = __builtin_nontemporal_load((const f32x4*)(t.W + (size_t)(t.k0 + 8 * i + (lane >> 3)) * t.N + t.n0 + 4 * (lane & 7)));
}
template <class RowFn> __device__ __forceinline__ void tr_finish(const TrItem& t, const f32x4 (&v)[8], RowFn rowfn, float* scr, int lane) {
#pragma unroll
    for (int i = 0; i < 8; ++i) { float* d = scr + (8 * i + (lane >> 3)) * 33 + 4 * (lane & 7); d[0] = v[i].x; d[1] = v[i].y; d[2] = v[i].z; d[3] = v[i].w; }
    asm volatile("s_waitcnt lgkmcnt(0)" ::: "memory");
    const int c = lane & 7;
#pragma unroll
    for (int j = 0; j < 4; ++j) {
        const int n = (lane >> 3) + 8 * j; const float* sp = scr + (8 * c) * 33 + n;
        u32x4 o; o.x = pk2(sp[0 * 33], sp[1 * 33]); o.y = pk2(sp[2 * 33], sp[3 * 33]); o.z = pk2(sp[4 * 33], sp[5 * 33]); o.w = pk2(sp[6 * 33], sp[7 * 33]);
        *(u32x4*)(t.WT + (size_t)rowfn(t.n0 + n) * t.K + t.k0 + 8 * c) = o;
    }
    asm volatile("s_waitcnt lgkmcnt(0)" ::: "memory");
}
template <class RowFn> __device__ __forceinline__ void tr_finish_g(const TrItem& t, const f32x4 (&v)[8], RowFn rowfn, float* scr, int lane, const float* gk) {
#pragma unroll
    for (int i = 0; i < 8; ++i) { float* d = scr + (8 * i + (lane >> 3)) * 33 + 4 * (lane & 7); d[0] = v[i].x; d[1] = v[i].y; d[2] = v[i].z; d[3] = v[i].w; }
    asm volatile("s_waitcnt lgkmcnt(0)" ::: "memory");
    const int c = lane & 7;
    const f32x4 g0 = *(const f32x4*)(gk + t.k0 + 8 * c), g1 = *(const f32x4*)(gk + t.k0 + 8 * c + 4);
#pragma unroll
    for (int j = 0; j < 4; ++j) {
        const int n = (lane >> 3) + 8 * j; const float* sp = scr + (8 * c) * 33 + n;
        u32x4 o; o.x = pk2(sp[0 * 33] * g0.x, sp[1 * 33] * g0.y); o.y = pk2(sp[2 * 33] * g0.z, sp[3 * 33] * g0.w); o.z = pk2(sp[4 * 33] * g1.x, sp[5 * 33] * g1.y); o.w = pk2(sp[6 * 33] * g1.z, sp[7 * 33] * g1.w);
        *(u32x4*)(t.WT + (size_t)rowfn(t.n0 + n) * t.K + t.k0 + 8 * c) = o;
    }
    asm volatile("s_waitcnt lgkmcnt(0)" ::: "memory");
}
template <class RowFn> __device__ __forceinline__ void tr_finish8(const TrItem& t, const f32x4 (&v)[8], RowFn rowfn, float* scr, int lane) {
#pragma unroll
    for (int i = 0; i < 8; ++i) { float* d = scr + (8 * i + (lane >> 3)) * 33 + 4 * (lane & 7); d[0] = v[i].x; d[1] = v[i].y; d[2] = v[i].z; d[3] = v[i].w; }
    asm volatile("s_waitcnt lgkmcnt(0)" ::: "memory");
    const int c = lane & 7; unsigned char* WT8 = (unsigned char*)t.WT;
#pragma unroll
    for (int j = 0; j < 4; ++j) {
        const int n = (lane >> 3) + 8 * j; const float* sp = scr + (8 * c) * 33 + n;
        u32x2 o; o.x = pk4_fp8(sp[0 * 33] * W8_SCALE, sp[1 * 33] * W8_SCALE, sp[2 * 33] * W8_SCALE, sp[3 * 33] * W8_SCALE); o.y = pk4_fp8(sp[4 * 33] * W8_SCALE, sp[5 * 33] * W8_SCALE, sp[6 * 33] * W8_SCALE, sp[7 * 33] * W8_SCALE);
        *(u32x2*)(WT8 + (size_t)rowfn(t.n0 + n) * t.K + t.k0 + 8 * c) = o;
    }
    asm volatile("s_waitcnt lgkmcnt(0)" ::: "memory");
}
template <class RowFn>
__device__ __forceinline__ void transpose_item(const float* __restrict__ W, int K, int N, bf16_t* __restrict__ WT, RowFn rowfn, float* scr, int item, int lane) {
    const TrItem t = tr_item(W, K, N, WT, item); f32x4 v[8]; tr_load(t, v, lane); tr_finish(t, v, rowfn, scr, lane);
}
struct RowId { __device__ __forceinline__ int operator()(int n) const { return n; } };
struct RowWin { __device__ __forceinline__ int operator()(int L) const { return (L & ~255) + ((L >> 5) & 1) * 128 + ((L >> 6) & 3) * 32 + (L & 31); } };
struct RowGU { int isup; __device__ __forceinline__ int operator()(int f) const { return (f >> 7) * 256 + isup * 128 + (f & 127); } };

struct RowGen { int kind; __device__ __forceinline__ int operator()(int f) const { return kind == 0 ? f : (f >> 7) * 256 + (kind - 1) * 128 + (f & 127); } };
__device__ __forceinline__ TrItem expert_item(const Params& p, int it, int& kind) {
    constexpr int I_G = (D / 64) * (F / 32), I_D = (F / 64) * (D / 32);
    unsigned char* Wgu8 = p.ws + WS_WGU; unsigned char* Wd8 = p.ws + WS_WD;
    const int e = it / (2 * I_G + I_D); int r = it - e * (2 * I_G + I_D);
    if (r < I_G) { kind = 1; return tr_item(p.w_gate + (size_t)e * D * F, D, F, (bf16_t*)(Wgu8 + (size_t)e * 1024 * D), r); } r -= I_G;
    if (r < I_G) { kind = 2; return tr_item(p.w_up + (size_t)e * D * F, D, F, (bf16_t*)(Wgu8 + (size_t)e * 1024 * D), r); } r -= I_G;
    kind = 0; return tr_item(p.w_down + (size_t)e * F * D, F, D, (bf16_t*)(Wd8 + (size_t)e * D * F), r);
}
__device__ __forceinline__ void convert_experts(const Params& p, const Ctx& c) {
    float* scr = (float*)(c.lds) + c.wave * (64 * 33);
    constexpr int I_G = (D / 64) * (F / 32), I_D = (F / 64) * (D / 32), NITEMS = NEXP * (2 * I_G + I_D);
    int it = c.gw;
    if (it >= NITEMS) return;
    int ka0, ka1; TrItem ta0 = expert_item(p, it, ka0); const bool ha1 = it + c.ngw < NITEMS; TrItem ta1 = expert_item(p, ha1 ? it + c.ngw : it, ka1);
    f32x4 va0[8], va1[8]; tr_load(ta0, va0, c.lane); tr_load(ta1, va1, c.lane);
    bool hcur1 = ha1;
    for (;;) {
        const int nx = it + 2 * c.ngw; const bool hn0 = nx < NITEMS, hn1 = nx + c.ngw < NITEMS;
        int kb0 = 0, kb1 = 0; TrItem tb0 = ta0, tb1 = ta1; f32x4 vb0[8], vb1[8];
        if (hn0) { tb0 = expert_item(p, nx, kb0); tb1 = expert_item(p, hn1 ? nx + c.ngw : nx, kb1); tr_load(tb0, vb0, c.lane); tr_load(tb1, vb1, c.lane); }
        tr_finish8(ta0, va0, RowGen{ka0}, scr, c.lane);
        if (hcur1) tr_finish8(ta1, va1, RowGen{ka1}, scr, c.lane);
        if (!hn0) break;
        ta0 = tb0; ta1 = tb1; ka0 = kb0; ka1 = kb1; hcur1 = hn1; it = nx;
#pragma unroll
        for (int q = 0; q < 8; ++q) { va0[q] = vb0[q]; va1[q] = vb1[q]; }
    }
}
__device__ __forceinline__ void convert_late(const Params& p, const Ctx& c) {
    float* scr = (float*)(c.lds) + c.wave * (64 * 33);
    bf16_t* Wout_t = (bf16_t*)(p.ws + WS_WOUT);
    constexpr int I_OUT = (D / 64) * (D / 32);
    for (int it = c.gw; it < I_OUT; it += c.ngw) transpose_item(p.w_out, D, D, Wout_t, RowId{}, scr, it, c.lane);
    bf16_t* Wr = (bf16_t*)(p.ws + WS_WR);
    for (int i = c.gw * 64 + c.lane; i < 48 * D; i += c.ngw * 64) {
        const int row = i >> 10, k = i & (D - 1), nf = row >> 4, q = (row >> 2) & 3, j = row & 3;
        float v = 0.f;
        if (nf < 2) v = p.w_re[(size_t)k * 32 + q * 8 + nf * 4 + j]; else if (j == 0) v = p.w_rg[(size_t)k * 4 + q];
        v *= p.ffn_norm_g[k];
        const unsigned hi = f2bf(v); Wr[i] = (bf16_t)hi; Wr[48 * D + i] = (bf16_t)f2bf(v - bf2f((unsigned short)hi));
    }
}
__device__ __forceinline__ void phase0(const Params& p, const Ctx& c) {
    float* scr = (float*)(c.lds) + c.wave * (64 * 33);
    bf16_t* Win_t = (bf16_t*)(p.ws + WS_WIN);
    constexpr int I_IN = (D / 64) * (DIN / 32);
    for (int it = c.gw; it < I_IN; it += c.ngw) { const TrItem t = tr_item(p.w_in, D, DIN, Win_t, it); f32x4 v[8]; tr_load(t, v, c.lane); tr_finish_g(t, v, RowWin{}, scr, c.lane, p.attn_norm_g); }
#if !EXPERTS_IN_ATTN
    convert_experts(p, c); convert_late(p, c);
#endif
    bf16_t* XB = (bf16_t*)(p.ws + WS_XB); float* RSTD0 = (float*)(p.ws + WS_RSTD0);
    for (int m = c.gw; m < T; m += 2 * c.ngw) {
        const int m2 = m + c.ngw;
        const f32x4* xa = (const f32x4*)(p.x + (size_t)m * D) + c.lane; const f32x4* xb = (const f32x4*)(p.x + (size_t)(m2 < T ? m2 : m) * D) + c.lane;
        f32x4 va[4], vb[4]; float sa = 0.f, sb = 0.f;
#pragma unroll
        for (int j = 0; j < 4; ++j) { va[j] = __builtin_nontemporal_load(xa + 64 * j); vb[j] = __builtin_nontemporal_load(xb + 64 * j); }
#pragma unroll
        for (int j = 0; j < 4; ++j) { sa += (va[j].x * va[j].x + va[j].y * va[j].y) + (va[j].z * va[j].z + va[j].w * va[j].w); sb += (vb[j].x * vb[j].x + vb[j].y * vb[j].y) + (vb[j].z * vb[j].z + vb[j].w * vb[j].w); }
        const float ra = rsqrtf(wave_sum(sa) * (1.f / D) + EPS), rb = rsqrtf(wave_sum(sb) * (1.f / D) + EPS);
        if (c.lane == 0) { RSTD0[m] = ra; if (m2 < T) RSTD0[m2] = rb; }
        u32x2* oa = (u32x2*)(XB + (size_t)m * D) + c.lane; u32x2* ob = (u32x2*)(XB + (size_t)m2 * D) + c.lane;
#pragma unroll
        for (int j = 0; j < 4; ++j) {
            u32x2 w; w.x = pk2(va[j].x, va[j].y); w.y = pk2(va[j].z, va[j].w); oa[64 * j] = w;
            if (m2 < T) { u32x2 w2; w2.x = pk2(vb[j].x, vb[j].y); w2.y = pk2(vb[j].z, vb[j].w); ob[64 * j] = w2; } }
    }
}

namespace pg8 {
#define PG8_LAS __attribute__((address_space(3)))
typedef unsigned short bf16_t;
typedef short bf16x8 __attribute__((ext_vector_type(8)));
typedef float f32x4 __attribute__((ext_vector_type(4)));
typedef unsigned u32x4 __attribute__((ext_vector_type(4)));
constexpr int BM = 256, BK = 64, HALF = 128, HTB = HALF * BK * 2  , STAGE_BYTES = 8 * HTB, NXCD = 8, WGM = 8;

__host__ __device__ __forceinline__ int lds_byte(int r, int c) { const int st = (r >> 4) * 2 + (c >> 5), rr = r & 15, cc = c & 31, ob = rr * 64 + cc * 2; return st * 1024 + (ob ^ (((ob >> 9) & 1) << 5)); }
__host__ __device__ __forceinline__ void stage_rc(int b, int& R, int& C) { const int st = b / 1024, sb = b % 1024, swz = sb ^ (((sb >> 9) & 1) << 5); R = (st >> 1) * 16 + swz / 64; C = (st & 1) * 32 + (swz % 64) / 2; }
__host__ __device__ __forceinline__ int perm32(int rho) { const int n = rho >> 4, i = rho & 15; return 8 * (i >> 2) + 4 * n + (i & 3); }

__device__ __forceinline__ unsigned cvt_pk_bf16(float lo, float hi) { unsigned r; asm volatile("v_cvt_pk_bf16_f32 %0, %1, %2" : "=v"(r) : "v"(lo), "v"(hi)); return r; }
typedef float f32x2 __attribute__((ext_vector_type(2)));

struct DenseSched {
    struct Unit { int pm, pn; };
    const char* A; const char* Bt; int K, nM, nN, nwg, G, c;
    __device__ __forceinline__ void init(const void* A_, const void* Bt_, int M, int N, int K_, int G_, int c_) { A = (const char*)A_; Bt = (const char*)Bt_; K = K_; nM = M / BM; nN = N / BM; nwg = nM * nN; G = G_; c = c_; }
    __device__ __forceinline__ bool next(int i, Unit& u) const {
        const long L = (long)i * G + c; if (L >= nwg) return false;
        int wgid = (int)L; { const int q = nwg / NXCD, r = nwg % NXCD, xcd = wgid % NXCD, off = wgid / NXCD; wgid = (xcd < r ? xcd * (q + 1) : r * (q + 1) + (xcd - r) * q) + off; }
        const int nig = WGM * nN, gid = wgid / nig, fm = gid * WGM, gsz = (nM - fm) < WGM ? (nM - fm) : WGM;
        u.pm = fm + ((wgid % nig) % gsz); u.pn = (wgid % nig) / gsz; return true;
    }
    __device__ __forceinline__ const char* a_base(const Unit& u) const { return A + (size_t)u.pm * BM * K * 2; }
    __device__ __forceinline__ const char* b_base(const Unit& u) const { return Bt + (size_t)u.pn * BM * K * 2; }
    __device__ __forceinline__ unsigned rowoff(const Unit&, int) const { return 0u; }
    __device__ __forceinline__ bool half(const Unit&) const { return false; }
    __device__ __forceinline__ void a_ready(const Unit&) const {}
    __device__ __forceinline__ void done(const Unit&) const {}
};
template <class Epi, class Sched, bool ALIGN_EPI = false, bool SP2 = false, bool GATHER = false, int SC_W = 0, int SC_T = 0>
__device__ __forceinline__ void gemm_phase(PG8_LAS unsigned char* lds, const int K, const Sched& S, const Epi& E, const int wave_id) {
    typedef typename Sched::Unit Unit;
    const int tid_ = (wave_id & 7) * 64 + my_lane();
    const int tid = tid_, wid = __builtin_amdgcn_readfirstlane(tid >> 6), lane = tid & 63, wr = wid >> 2, wc = wid & 3, fr = lane & 15, fq = lane >> 4;
    int nt_ = K / BK; if constexpr (SC_W != 0) asm volatile("" : "+s"(nt_));
    const int nt = nt_;
    unsigned voffA[2], voffB[2]; int Rr[2]; unsigned Cc2[2];
#pragma unroll
    for (int i = 0; i < 2; ++i) { int R, C; stage_rc(tid * 16 + i * 8192, R, C); const int Rb = Epi::PERM ? ((R & ~31) + perm32(R & 31)) : R;
        voffA[i] = (unsigned)(R * K + C) * 2u; voffB[i] = (unsigned)(Rb * K + C) * 2u; Rr[i] = R; Cc2[i] = (unsigned)C * 2u; }
    unsigned cv[2][2], nv[2][2];
#define PG8_GATHER(dst, u) do { if constexpr (GATHER) { _Pragma("unroll") for (int h_ = 0; h_ < 2; ++h_) _Pragma("unroll") for (int i_ = 0; i_ < 2; ++i_) dst[h_][i_] = S.rowoff(u, Rr[i_] + HALF * h_) + Cc2[i_]; } } while (0)
    const size_t kstep = (size_t)(BK * 2);
    const size_t hstep = (size_t)HALF * K * 2;
    const unsigned ldsw = (unsigned)wid * 1024u;
    const int aoff = lds_byte(wr * 64 + fr, fq * 8), boff = lds_byte(wc * 32 + fr, fq * 8);
#define PG8_SA(b, h) (((b) * 2 + (h)) * HTB)
#define PG8_SB(b, h) ((4 + (b) * 2 + (h)) * HTB)
#define PG8_STAGE_V(bufoff, gbase, v0, v1) do { \
        __builtin_amdgcn_global_load_lds((const unsigned*)((const char*)(gbase) + (v0)), (PG8_LAS unsigned*)(lds + (bufoff) + ldsw), 16, 0, 0); \
        __builtin_amdgcn_global_load_lds((const unsigned*)((const char*)(gbase) + (v1)), (PG8_LAS unsigned*)(lds + (bufoff) + ldsw + 8192), 16, 0, 0); } while (0)
#define PG8_STAGE_B(bufoff, gbase) PG8_STAGE_V(bufoff, gbase, voffB[0], voffB[1])
#define PG8_STAGE_A(bufoff, gbase, h, nx) do { if constexpr (GATHER) { PG8_STAGE_V(bufoff, gbase, (nx) ? nv[h][0] : cv[h][0], (nx) ? nv[h][1] : cv[h][1]); } \
        else { PG8_STAGE_V(bufoff, (gbase) + (h) * hstep, voffA[0], voffA[1]); } } while (0)
#define PG8_LDA(dst, b, h) do { _Pragma("unroll") for (int m = 0; m < 4; ++m) _Pragma("unroll") for (int k = 0; k < 2; ++k) dst[m][k] = *(const PG8_LAS bf16x8*)(lds + PG8_SA(b, h) + aoff + m * 2048 + k * 1024); } while (0)
#define PG8_LDB(dst, b, h) do { _Pragma("unroll") for (int n = 0; n < 2; ++n) _Pragma("unroll") for (int k = 0; k < 2; ++k) dst[n][k] = *(const PG8_LAS bf16x8*)(lds + PG8_SB(b, h) + boff + n * 2048 + k * 1024); } while (0)
#define PG8_CAT8(x) __builtin_shufflevector(__builtin_bit_cast(i32x4, x[0]), __builtin_bit_cast(i32x4, x[1]), 0, 1, 2, 3, 4, 5, 6, 7)
#define PG8_MMA(ai, bj, At, Bt) do { __builtin_amdgcn_s_setprio(1); _Pragma("unroll") for (int m = 0; m < 4; ++m) _Pragma("unroll") for (int n = 0; n < 2; ++n) { \
        if constexpr (SC_W != 0) { const i32x8 b8_ = PG8_CAT8(Bt[n]), a8_ = PG8_CAT8(At[m]); \
            asm volatile("v_mfma_scale_f32_16x16x128_f8f6f4 %0, %1, %2, %0, %3, %4 op_sel_hi:[0,0,0]" : "+v"(acc[ai][bj][m][n]) : "v"(b8_), "v"(a8_), "v"(sc_w), "v"(sc_t)); } \
        else { _Pragma("unroll") for (int k = 0; k < 2; ++k) acc[ai][bj][m][n] = __builtin_amdgcn_mfma_f32_16x16x32_bf16(Bt[n][k], At[m][k], acc[ai][bj][m][n], 0, 0, 0); } } __builtin_amdgcn_s_setprio(0); } while (0)
#define PG8_WAIT_V(n) asm volatile("s_waitcnt vmcnt(" #n ")" ::: "memory")
#define PG8_WAIT_L(n) asm volatile("s_waitcnt lgkmcnt(" #n ")" ::: "memory")
#define PG8_BAR __builtin_amdgcn_s_barrier()
#define PG8_SCHED __builtin_amdgcn_sched_barrier(0)
    Unit cur, nxt; int ui = 0;
    if (!S.next(0, cur)) return;
    const int sc_w = SC_W * 0x01010101, sc_t = SC_T * 0x01010101;
    bool hf = S.half(cur);
    f32x4 acc[2][2][4][2];
#pragma unroll
    for (int a = 0; a < 2; ++a)
#pragma unroll
        for (int b = 0; b < 2; ++b)
#pragma unroll
            for (int m = 0; m < 4; ++m)
#pragma unroll
                for (int n = 0; n < 2; ++n) acc[a][b][m][n] = (f32x4){0.f, 0.f, 0.f, 0.f};
    bf16x8 At[4][2], B0[2][2], B1[2][2];
    const char* cA = S.a_base(cur); const char* cB = S.b_base(cur);
    S.a_ready(cur); PG8_GATHER(cv, cur);
    if constexpr (SP2) {
        PG8_STAGE_B(PG8_SB(0, 0), cB); PG8_STAGE_B(PG8_SB(0, 1), cB + hstep); PG8_STAGE_A(PG8_SA(0, 0), cA, 0, false); PG8_STAGE_A(PG8_SA(0, 1), cA, 1, false);
        if (wr == 1) PG8_BAR;
        PG8_WAIT_V(2); PG8_BAR;
        PG8_STAGE_B(PG8_SB(1, 0), cB + kstep); PG8_STAGE_A(PG8_SA(1, 0), cA + kstep, 0, false); PG8_STAGE_B(PG8_SB(1, 1), cB + hstep + kstep);
        PG8_WAIT_V(6); PG8_BAR;
    } else {
        PG8_STAGE_B(PG8_SB(0, 0), cB); PG8_STAGE_A(PG8_SA(0, 0), cA, 0, false); PG8_STAGE_B(PG8_SB(0, 1), cB + hstep); PG8_STAGE_A(PG8_SA(0, 1), cA, 1, false);
        if (wr == 1) PG8_BAR;
        PG8_WAIT_V(4); PG8_BAR;
        PG8_STAGE_B(PG8_SB(1, 0), cB + kstep); PG8_STAGE_A(PG8_SA(1, 0), cA + kstep, 0, false); PG8_STAGE_B(PG8_SB(1, 1), cB + hstep + kstep);
        PG8_WAIT_V(6); PG8_BAR;
    }
    for (;;) {
        const bool has_next = S.next(ui + 1, nxt);
        const char* nA = has_next ? S.a_base(nxt) : cA; const char* nB = has_next ? S.b_base(nxt) : cB;
        if constexpr (GATHER) { if (has_next) { PG8_GATHER(nv, nxt); } else { _Pragma("unroll") for (int h_ = 0; h_ < 2; ++h_) { nv[h_][0] = cv[h_][0]; nv[h_][1] = cv[h_][1]; } } }
        for (int t = 0; t < nt; t += 2) {
            const bool last = (t == nt - 2);
            const char* a1 = cA + (size_t)(t + 1) * kstep;
            const char* a2 = last ? nA : cA + (size_t)(t + 2) * kstep; const char* b2 = last ? nB : cB + (size_t)(t + 2) * kstep;
            const char* a3 = a2 + kstep; const char* b3 = b2 + kstep;
            if (last && has_next) S.a_ready(nxt);
            if constexpr (SP2) {
            PG8_LDB(B0, 0, 0); PG8_LDB(B1, 0, 1); PG8_SCHED; PG8_LDA(At, 0, 0); PG8_STAGE_A(PG8_SA(1, 1), a1, 1, false);
            PG8_WAIT_V(8); PG8_WAIT_L(0); PG8_BAR; PG8_MMA(0, 0, At, B0); PG8_MMA(0, 1, At, B1); PG8_BAR; PG8_SCHED;
            PG8_LDA(At, 0, 1); PG8_STAGE_B(PG8_SB(0, 0), b2); PG8_STAGE_B(PG8_SB(0, 1), b2 + hstep); PG8_STAGE_A(PG8_SA(0, 0), a2, 0, last);
            PG8_WAIT_V(8); PG8_WAIT_L(0); PG8_BAR; if (!hf) { PG8_MMA(1, 0, At, B0); PG8_MMA(1, 1, At, B1); } PG8_BAR; PG8_SCHED;
            PG8_LDB(B0, 1, 0); PG8_LDB(B1, 1, 1); PG8_SCHED; PG8_LDA(At, 1, 0); PG8_STAGE_A(PG8_SA(0, 1), a2, 1, last);
            PG8_WAIT_V(8); PG8_WAIT_L(0); PG8_BAR; PG8_MMA(0, 0, At, B0); PG8_MMA(0, 1, At, B1); PG8_BAR; PG8_SCHED;
            PG8_LDA(At, 1, 1); PG8_STAGE_B(PG8_SB(1, 0), b3); PG8_STAGE_B(PG8_SB(1, 1), b3 + hstep); PG8_STAGE_A(PG8_SA(1, 0), a3, 0, last);
            PG8_WAIT_V(8); PG8_WAIT_L(0); PG8_BAR; if (!hf) { PG8_MMA(1, 0, At, B0); PG8_MMA(1, 1, At, B1); } PG8_BAR; PG8_SCHED;
            } else {
            PG8_LDB(B0, 0, 0); PG8_SCHED; PG8_LDA(At, 0, 0); PG8_STAGE_A(PG8_SA(1, 1), a1, 1, false);
            PG8_WAIT_L(8); PG8_BAR; PG8_WAIT_L(0); PG8_MMA(0, 0, At, B0); PG8_BAR; PG8_SCHED;
            PG8_LDB(B1, 0, 1); PG8_STAGE_B(PG8_SB(0, 0), b2);
            PG8_BAR; PG8_WAIT_L(0); PG8_MMA(0, 1, At, B1); PG8_BAR;
            PG8_LDA(At, 0, 1); PG8_STAGE_A(PG8_SA(0, 0), a2, 0, last);
            PG8_BAR; PG8_WAIT_L(0); PG8_MMA(1, 0, At, B0); PG8_BAR; PG8_SCHED;
            PG8_STAGE_B(PG8_SB(0, 1), b2 + hstep);
            PG8_WAIT_V(6); PG8_BAR; PG8_MMA(1, 1, At, B1); PG8_BAR;
            PG8_LDB(B0, 1, 0); PG8_SCHED; PG8_LDA(At, 1, 0); PG8_STAGE_A(PG8_SA(0, 1), a2, 1, last);
            PG8_WAIT_L(8); PG8_BAR; PG8_WAIT_L(0); PG8_MMA(0, 0, At, B0); PG8_BAR; PG8_SCHED;
            PG8_LDB(B1, 1, 1); PG8_STAGE_B(PG8_SB(1, 0), b3);
            PG8_BAR; PG8_WAIT_L(0); PG8_MMA(0, 1, At, B1); PG8_BAR;
            PG8_LDA(At, 1, 1); PG8_STAGE_A(PG8_SA(1, 0), a3, 0, last);
            PG8_BAR; PG8_WAIT_L(0); PG8_MMA(1, 0, At, B0); PG8_BAR; PG8_SCHED;
            PG8_STAGE_B(PG8_SB(1, 1), b3 + hstep);
            PG8_WAIT_V(6); PG8_BAR; PG8_MMA(1, 1, At, B1); PG8_BAR;
            }
        }
        if constexpr (SC_W != 0) asm volatile("s_nop 15\n\ts_nop 15" ::: "memory");
        if constexpr (ALIGN_EPI) { if (wr == 0) PG8_BAR; }
        if constexpr (!Epi::AFTER_DRAIN) { E(acc, cur, wr, wc, fr, fq); S.done(cur); }
        if (!has_next) break;
#pragma unroll
        for (int a = 0; a < 2; ++a)
#pragma unroll
            for (int b = 0; b < 2; ++b)
#pragma unroll
                for (int m = 0; m < 4; ++m)
#pragma unroll
                    for (int n = 0; n < 2; ++n) acc[a][b][m][n] = (f32x4){0.f, 0.f, 0.f, 0.f};
        cur = nxt; cA = nA; cB = nB; ++ui; hf = S.half(cur);
        if constexpr (GATHER) { _Pragma("unroll") for (int h_ = 0; h_ < 2; ++h_) { cv[h_][0] = nv[h_][0]; cv[h_][1] = nv[h_][1]; } }
        if constexpr (ALIGN_EPI) { if (wr == 1) PG8_BAR; }
    }
    PG8_WAIT_V(0);
    if constexpr (!ALIGN_EPI) { if (wr == 0) PG8_BAR; }
    PG8_BAR;
    if constexpr (Epi::AFTER_DRAIN) { E.fused(acc, cur, wr, wc, fr, fq, lds, wid, lane); S.done(cur); }
#undef PG8_SA
#undef PG8_SB
#undef PG8_STAGE_V
#undef PG8_STAGE_A
#undef PG8_STAGE_B
#undef PG8_GATHER
#undef PG8_LDA
#undef PG8_LDB
#undef PG8_MMA
#undef PG8_CAT8
#undef PG8_WAIT_V
#undef PG8_WAIT_L
#undef PG8_BAR
#undef PG8_SCHED
}
}

struct EpiProj {
    static constexpr bool PERM = true, AFTER_DRAIN = false;
    bf16_t* O; const float* qg; const float* kg; const float* rs0;
    __device__ __forceinline__ void operator()(const f32x4 (&acc)[2][2][4][2], const pg8::DenseSched::Unit& u, int wr, int wc, int fr, int fq) const {
        const int cb = u.pn * 256 + wc * 64;
        const bool isq = (cb >= COL_Q) && (cb < COL_K), isk = (cb >= COL_K) && (cb < COL_V);
        f32x4 sc[2][2];
#pragma unroll
        for (int bj = 0; bj < 2; ++bj)
#pragma unroll
            for (int n = 0; n < 2; ++n) sc[bj][n] = (f32x4){1.f, 1.f, 1.f, 1.f};
        if (isq || isk) {
            const float* gn = isq ? qg : kg; const float mlt = isq ? QSCALE : 1.f;
#pragma unroll
            for (int bj = 0; bj < 2; ++bj)
#pragma unroll
                for (int n = 0; n < 2; ++n) sc[bj][n] = *(const f32x4*)(gn + 32 * bj + 8 * fq + 4 * n) * mlt;
        }
#pragma unroll
        for (int ai = 0; ai < 2; ++ai)
#pragma unroll
            for (int m = 0; m < 4; ++m) {
                const int row = u.pm * 256 + ai * 128 + wr * 64 + m * 16 + fr;
                const float r0 = rs0[row];
                float mul = r0;
                if (isq || isk) {
                    float ss = 0.f;
#pragma unroll
                    for (int bj = 0; bj < 2; ++bj)
#pragma unroll
                        for (int n = 0; n < 2; ++n) { const f32x4 x = acc[ai][bj][m][n]; ss += (x.x * x.x + x.y * x.y) + (x.z * x.z + x.w * x.w); }
                    { const int ln = fr + 16 * fq; ss += lane_get(ss, ln ^ 16); ss += lane_get(ss, ln ^ 32); }
                    mul = r0 * rsqrtf(ss * (r0 * r0) * (1.f / 64.f) + EPS);
                }
                bf16_t* rowp = O + (size_t)row * DIN + cb + 8 * fq;
#pragma unroll
                for (int bj = 0; bj < 2; ++bj) {
                    const f32x4 v0 = acc[ai][bj][m][0] * sc[bj][0] * mul, v1 = acc[ai][bj][m][1] * sc[bj][1] * mul;
                    u32x4 w; w.x = pg8::cvt_pk_bf16(v0.x, v0.y); w.y = pg8::cvt_pk_bf16(v0.z, v0.w); w.z = pg8::cvt_pk_bf16(v1.x, v1.y); w.w = pg8::cvt_pk_bf16(v1.z, v1.w);
                    *(u32x4*)(rowp + 32 * bj) = w;
                }
            }
    }
};
struct EpiAO {
    static constexpr bool PERM = true, AFTER_DRAIN = false;
    bf16_t* O; const bf16_t* XB;
    __device__ __forceinline__ void operator()(const f32x4 (&acc)[2][2][4][2], const pg8::DenseSched::Unit& u, int wr, int wc, int fr, int fq) const {
        const int col0 = u.pn * 256 + wc * 32 + 8 * fq;
        u32x4 xw[2][4][2];
#pragma unroll
        for (int ai = 0; ai < 2; ++ai)
#pragma unroll
            for (int m = 0; m < 4; ++m) { const bf16_t* xr = XB + (size_t)(u.pm * 256 + ai * 128 + wr * 64 + m * 16 + fr) * D + col0; xw[ai][m][0] = *(const u32x4*)(xr); xw[ai][m][1] = *(const u32x4*)(xr + 128); }
        __builtin_amdgcn_s_waitcnt(0x0F70);
#pragma unroll
        for (int ai = 0; ai < 2; ++ai)
#pragma unroll
            for (int m = 0; m < 4; ++m) {
                bf16_t* rowp = O + (size_t)(u.pm * 256 + ai * 128 + wr * 64 + m * 16 + fr) * D + col0;
#pragma unroll
                for (int bj = 0; bj < 2; ++bj) {
                    const u32x4 a4 = xw[ai][m][bj];
                    const f32x4 v0 = acc[ai][bj][m][0] + (f32x4){bflo(a4.x), bfhi(a4.x), bflo(a4.y), bfhi(a4.y)}, v1 = acc[ai][bj][m][1] + (f32x4){bflo(a4.z), bfhi(a4.z), bflo(a4.w), bfhi(a4.w)};
                    u32x4 w; w.x = pg8::cvt_pk_bf16(v0.x, v0.y); w.y = pg8::cvt_pk_bf16(v0.z, v0.w); w.z = pg8::cvt_pk_bf16(v1.x, v1.y); w.w = pg8::cvt_pk_bf16(v1.z, v1.w);
                    *(u32x4*)(rowp + bj * 128) = w;
                }
            }
    }
};
__device__ __forceinline__ void phase1_fast(const Params& p, const Ctx& c) {
    pg8::DenseSched S; S.init(p.ws + WS_XB, p.ws + WS_WIN, T, DIN, D, c.nb, c.bid);
    EpiProj E{(bf16_t*)(p.ws + WS_PROJ), p.q_norm_g, p.k_norm_g, (const float*)(p.ws + WS_RSTD0)};
    pg8::gemm_phase<EpiProj, pg8::DenseSched, true, true, false>((PG8_LAS unsigned char*)c.lds, D, S, E, c.wave);
}
__device__ __forceinline__ void phase3_fast(const Params& p, const Ctx& c) {
    pg8::DenseSched S; S.init(p.ws + WS_XN, p.ws + WS_WOUT, T, D, D, c.nb, c.bid);
    EpiAO E{(bf16_t*)(p.ws + WS_AO), (const bf16_t*)(p.ws + WS_XB)};
    pg8::gemm_phase<EpiAO, pg8::DenseSched, true, true, false>((PG8_LAS unsigned char*)c.lds, D, S, E, c.wave);
}

#include <hip/hip_bf16.h>
#include <cmath>
namespace attn128 {
using bf16=__hip_bfloat16;
using bf16x8=__attribute__((ext_vector_type(8)))short;
using s16x4=__attribute__((ext_vector_type(4)))short;
using f32x16=__attribute__((ext_vector_type(16)))float;
using u32x4=__attribute__((ext_vector_type(4)))unsigned;
constexpr int BATCH=4,NHEAD=16,SEQ=4096,D=64,DM=3072;
constexpr int NW=8,QBLK=32,QB=QBLK*NW,KVBLK=64,NQB=SEQ/QB;
constexpr int ATTN_PITCH=DM, ATTN_UNIT_ROWS=QB;
__device__ __forceinline__ int crow(int r,int hi){return (r&3)+8*(r>>2)+4*hi;}
#define SBAR() __builtin_amdgcn_sched_barrier(0)
__device__ __forceinline__ void cmask(f32x16&p0,f32x16&p1,int jb,int qrel,int hi){
  const float NEG=-INFINITY; int kb=64*jb+4*hi;
  #pragma unroll
  for(int r=0;r<16;++r){int kv=kb+(r&3)+8*(r>>2); if(kv>qrel)p0[r]=NEG; if(kv+32>qrel)p1[r]=NEG;}
}

constexpr int NSLOT=3, SLOTB=8192, VSLOTB=16384;
constexpr int LDS_K=0, LDS_V=NSLOT*SLOTB, LDS_WS=LDS_V+NSLOT*VSLOTB, LDS_OST=LDS_WS+NW*64*4, LDS_BYTES=LDS_OST+NW*8192;
constexpr float C2=0.125f*1.4426950408889634f;
__device__ __forceinline__ void glds16(const void*gbase,unsigned voff,unsigned lds_dst){unsigned keep;
  asm volatile("s_mov_b32 %0, m0\n\ts_mov_b32 m0, %3\n\ts_nop 0\n\tglobal_load_lds_dwordx4 %1, %2\n\ts_mov_b32 m0, %0":"=&s"(keep):"v"(voff),"s"(gbase),"s"(lds_dst):"memory");}
__device__ __forceinline__ float max3f(float a,float b,float c){float r;asm("v_max3_f32 %0, %1, %2, %3":"=v"(r):"v"(a),"v"(b),"v"(c));return r;}
__device__ __forceinline__ float max2f(float a,float b){float r;asm("v_max_f32_e32 %0, %1, %2":"=v"(r):"v"(a),"v"(b));return r;}
__device__ __forceinline__ float fadd_s(float a,float b){float r;asm("v_add_f32_e32 %0, %1, %2":"=v"(r):"v"(a),"v"(b));return r;}
__device__ __forceinline__ float fsub_s(float a,float b){float r;asm("v_sub_f32_e32 %0, %1, %2":"=v"(r):"v"(a),"v"(b));return r;}
typedef float f32x2_t __attribute__((ext_vector_type(2))); typedef __bf16 bf16x2_t __attribute__((ext_vector_type(2)));
__device__ __forceinline__ unsigned cvtpk_s(float lo,float hi){f32x2_t v={lo,hi};bf16x2_t b=__builtin_convertvector(v,bf16x2_t);return __builtin_bit_cast(unsigned,b);}
#define WAIT_BAR(N) asm volatile("s_waitcnt vmcnt(" #N ") lgkmcnt(0)\n\ts_barrier":::"memory")

__device__ __forceinline__ void qkt(f32x16&p0,f32x16&p1,const char*Kslot,const bf16x8*qr,int r32,int hi){ const f32x16 negm=f32x16{};
  const char*kb=Kslot+hi*1024+r32*16;
  #pragma unroll
  for(int d0=0;d0<4;++d0){
    const bf16x8 b0=*reinterpret_cast<const bf16x8*>(kb+d0*2048);
    const bf16x8 b1=*reinterpret_cast<const bf16x8*>(kb+d0*2048+512);
    if(d0==0){p0=__builtin_amdgcn_mfma_f32_32x32x16_bf16(b0,qr[0],negm,0,0,0);p1=__builtin_amdgcn_mfma_f32_32x32x16_bf16(b1,qr[0],negm,0,0,0);}
    else{p0=__builtin_amdgcn_mfma_f32_32x32x16_bf16(b0,qr[d0],p0,0,0,0);p1=__builtin_amdgcn_mfma_f32_32x32x16_bf16(b1,qr[d0],p1,0,0,0);}}
}
typedef __attribute__((address_space(3))) const char* lds_cptr;
typedef short v4i16_t __attribute__((ext_vector_type(4)));
__device__ __forceinline__ void kload8(bf16x8*kf,lds_cptr kp){
  kf[0]=*(const __attribute__((address_space(3))) bf16x8*)(kp);      kf[1]=*(const __attribute__((address_space(3))) bf16x8*)(kp+512);
  kf[2]=*(const __attribute__((address_space(3))) bf16x8*)(kp+2048); kf[3]=*(const __attribute__((address_space(3))) bf16x8*)(kp+2560);
  kf[4]=*(const __attribute__((address_space(3))) bf16x8*)(kp+4096); kf[5]=*(const __attribute__((address_space(3))) bf16x8*)(kp+4608);
  kf[6]=*(const __attribute__((address_space(3))) bf16x8*)(kp+6144); kf[7]=*(const __attribute__((address_space(3))) bf16x8*)(kp+6656);
}
__device__ __forceinline__ void kload2(bf16x8*kf,lds_cptr kp,int j){ kf[2*j]=*(const __attribute__((address_space(3))) bf16x8*)(kp+j*2048); kf[2*j+1]=*(const __attribute__((address_space(3))) bf16x8*)(kp+j*2048+512); }
__device__ __forceinline__ s16x4 vtr(lds_cptr p){ return __builtin_bit_cast(s16x4,__builtin_amdgcn_ds_read_tr16_b64_v4i16((__attribute__((address_space(3))) v4i16_t*)p)); }
__device__ __forceinline__ float rowmax(const f32x16&p0,const f32x16&p1){
  float a=max3f(p0[0],p0[1],p1[0]),b=max3f(p0[2],p0[3],p1[1]);a=max3f(a,p1[2],p1[3]);
  #pragma unroll
  for(int r=4;r<16;r+=4){a=max3f(a,p0[r],p0[r+1]);b=max3f(b,p0[r+2],p0[r+3]);a=max3f(a,p1[r],p1[r+1]);b=max3f(b,p1[r+2],p1[r+3]);}
  const float m=max2f(a,b);
  auto rr=__builtin_amdgcn_permlane32_swap(__float_as_uint(m),__float_as_uint(m),false,false);
  return max2f(__uint_as_float(rr[0]),__uint_as_float(rr[1]));
}
__device__ __forceinline__ void pv(f32x16*o,int vb,bf16x8 pa0,bf16x8 pa1,bf16x8 pa2,bf16x8 pa3){
  #pragma unroll
  for(int d0=0;d0<4;++d0){s16x4 lo[4],hi[4];
    #pragma unroll
    for(int ks=0;ks<4;++ks){
      asm volatile("ds_read_b64_tr_b16 %0,%1 offset:%c2":"=&v"(lo[ks]):"v"(vb),"i"(d0*4096+ks*1024):"memory");
      asm volatile("ds_read_b64_tr_b16 %0,%1 offset:%c2":"=&v"(hi[ks]):"v"(vb),"i"(d0*4096+ks*1024+512):"memory");}
    asm volatile("s_waitcnt lgkmcnt(0)":::"memory");SBAR();
    #define PK(k) (bf16x8){lo[k][0],lo[k][1],lo[k][2],lo[k][3],hi[k][0],hi[k][1],hi[k][2],hi[k][3]}
    o[d0]=__builtin_amdgcn_mfma_f32_32x32x16_bf16(pa0,PK(0),o[d0],0,0,0);
    o[d0]=__builtin_amdgcn_mfma_f32_32x32x16_bf16(pa1,PK(1),o[d0],0,0,0);
    o[d0]=__builtin_amdgcn_mfma_f32_32x32x16_bf16(pa2,PK(2),o[d0],0,0,0);
    o[d0]=__builtin_amdgcn_mfma_f32_32x32x16_bf16(pa3,PK(3),o[d0],0,0,0);
    #undef PK
  }
}

#ifndef ATTN_STORE16
#define ATTN_STORE16(p,v) (*(u32x4*)(p)=(v))
#endif
struct DiffCtx { int comp; int act; int qbP; bf16* Oo; unsigned char* mix; const float* sg; float lam; unsigned* flags; int pub; };
template<int THRL,bool NOREF> __device__ __forceinline__ void attn_unit(int b,int h,int hv,int qb,const bf16*Q,const bf16*__restrict__ K,const bf16*__restrict__ V,bf16*O,char*shm,const DiffCtx&dc){
  const int tid=threadIdx.x,lane=tid&63,r32=lane&31,hi=lane>>5; const int wid=__builtin_amdgcn_readfirstlane(tid>>6);
  const long rowbase=(long)b*SEQ; const int q0=qb*QB;
  const bf16*Qw=Q+(rowbase+q0+wid*QBLK)*DM+h*D;
  const bf16*Kh=K+rowbase*DM+h*D,*Vh=V+rowbase*DM+hv*128;
  const unsigned lds0=(unsigned)(uintptr_t)shm;
  float*wsf=(float*)(shm+LDS_WS)+wid*64;
  const unsigned koff=(unsigned)(lane*DM+wid*8)*2u;
  const unsigned voff=(unsigned)((16*(wid&3)+(lane>>2))*DM+(wid>>2)*32+(lane&3)*8)*2u;
  const unsigned kdst=lds0+LDS_K+wid*1024, vdst=lds0+LDS_V+wid*1024;
  #define DMA_K(t,slot) glds16(Kh+(long)(t)*KVBLK*DM,koff,(unsigned)__builtin_amdgcn_readfirstlane(kdst+(slot)))
  #define DMA_V(t,slot) do{ glds16(Vh+(long)(t)*KVBLK*DM,voff,(unsigned)__builtin_amdgcn_readfirstlane(vdst+(slot))); glds16(Vh+(long)(t)*KVBLK*DM+64,voff,(unsigned)__builtin_amdgcn_readfirstlane(vdst+(slot)+8192)); }while(0)
  const char*Kbase=shm+LDS_K; bf16x8 kf[8];
  const lds_cptr shm3=(lds_cptr)shm; const lds_cptr kp0=shm3+LDS_K+hi*1024+r32*16; const lds_cptr vp0=shm3+LDS_V+((lane>>4)&1)*32+(lane&3)*8+(4*hi+((lane&15)>>2))*64;
  const int NT=(q0+QB)/KVBLK;
  DMA_K(0,0);DMA_V(0,0);DMA_K(1,SLOTB);
  bf16x8 qr[4];
  #pragma unroll
  for(int d0=0;d0<4;++d0)qr[d0]=*reinterpret_cast<const bf16x8*>(&Qw[(long)r32*DM+d0*16+hi*8]);
  float mhat=0.f,l_reg=0.f;
  const int qrel=wid*QBLK+r32;
  #define CMASK(P0,P1,t) do{int jb_=(t)-(NT-4); if(jb_>=0)cmask(P0,P1,jb_,qrel,hi);}while(0)
  bool resc=false;
  #define START(P0,P1) do{ resc=false; if constexpr(!NOREF){ const float rm=rowmax(P0,P1); \
    { const float dl=rm; mhat=fadd_s(mhat,dl); \
      _Pragma("unroll") for(int r=0;r<16;++r){P0[r]=fsub_s(P0[r],dl);P1[r]=fsub_s(P1[r],dl);} } } \
    _Pragma("unroll") for(int r=0;r<16;++r)P0[r]=__builtin_amdgcn_exp2f(P0[r]); }while(0)
  #define RESC() do{ if(resc){ asm volatile("s_waitcnt lgkmcnt(0)":::"memory"); \
      _Pragma("unroll") for(int d_=0;d_<4;++d_) _Pragma("unroll") for(int r=0;r<16;++r)o[d_][r]*=wsf[crow(r,hi)]; } }while(0)
  f32x16 pA0,pA1,pB0,pB1;
  int sl_prev=0,sl_cur=0,sl_next=SLOTB;
  #define ROT() do{sl_prev=sl_cur;sl_cur=sl_next;sl_next=(sl_next==(NSLOT-1)*SLOTB)?0:sl_next+SLOTB;}while(0)
  DMA_K(2,2*SLOTB);
  WAIT_BAR(4);
  qkt(pA0,pA1,Kbase,qr,r32,hi);asm volatile("s_nop 15\n\ts_nop 7":"+v"(pA0),"+v"(pA1));CMASK(pA0,pA1,0);
  START(pA0,pA1);
  _Pragma("unroll") for(int r=0;r<16;++r)pA1[r]=__builtin_amdgcn_exp2f(pA1[r]);
  WAIT_BAR(0);
  if(dc.pub>=0&&wid==0){ int l_; asm volatile("v_mbcnt_lo_u32_b32 %0, -1, 0\n\tv_mbcnt_hi_u32_b32 %0, -1, %0":"=v"(l_)); if((l_&63)==0)__hip_atomic_store(dc.flags+dc.pub,1u,__ATOMIC_RELAXED,__HIP_MEMORY_SCOPE_AGENT); }
  DMA_K(3,0);DMA_V(1,VSLOTB);
  ROT();
  kload8(kf,kp0+sl_cur);
  WAIT_BAR(3);
  s16x4 vlo[8],vhi[8],wlo[8],whi[8]; u32x4 pw0,pw1,pw2,pw3;
  #define PKW(P,B) cvtpk_s(P[B],P[B+1])
  #define PAF(k) __builtin_bit_cast(bf16x8,pw##k)
  #define VFR(i) (bf16x8){vlo[i][0],vlo[i][1],vlo[i][2],vlo[i][3],vhi[i][0],vhi[i][1],vhi[i][2],vhi[i][3]}
  #define WFR(i) (bf16x8){wlo[i][0],wlo[i][1],wlo[i][2],wlo[i][3],whi[i][0],whi[i][1],whi[i][2],whi[i][3]}
  #define PIN(x) asm volatile("":"+v"(x))
  #define MX3(a,b,c) __builtin_fmaxf(__builtin_fmaxf((a),(b)),(c))
  #define GAPA(MF,A0,A1,A2,A3,W0,W1,PW) do{ MF; sacc+=A0; sacc+=A1; sacc+=A2; sacc+=A3; PIN(sacc); W0; W1; PIN(PW); SBAR(); }while(0)
  #define EX(v) __builtin_amdgcn_exp2f(v)
  #define GAPB(MF,X,B) do{ MF; X[B]=NOREF?EX(X[B]):EX(X[B]-mhat); X[B+1]=NOREF?EX(X[B+1]):EX(X[B+1]-mhat); PIN(X); SBAR(); }while(0)
  #define VOFF(s_) ((((s_)&3)*4096)+(((s_)>>2)*1024))
  #define VRD(i) do{ vlo[i]=vtr(vp_+VOFF(i)); vhi[i]=vtr(vp_+VOFF(i)+512); }while(0)
  #define WRD(i) do{ wlo[i]=vtr(vp_+VOFF(8+(i))); whi[i]=vtr(vp_+VOFF(8+(i))+512); SBAR(); }while(0)
  #define KRD(G,j) do{ if(G){ kload2(kf,kp0+sl_next,j); SBAR(); } }while(0)
  #define ZC f32x16{}
  #define STEP(C0,C1,P0,P1,t,GK,GV,GL) do{ SBAR(); \
    const lds_cptr vp_=vp0+2*sl_prev; \
    VRD(0); SBAR(); float sacc=(P0[0]+P0[1]); \
    GAPA(C0=__builtin_amdgcn_mfma_f32_32x32x16_bf16(kf[0],qr[0],ZC,0,0,0), P0[2],P0[3],P0[4],P0[5],     pw0[0]=PKW(P0,0), pw0[1]=PKW(P0,2), pw0); \
    VRD(1); SBAR(); GAPA(C1=__builtin_amdgcn_mfma_f32_32x32x16_bf16(kf[1],qr[0],ZC,0,0,0), P0[6],P0[7],P0[8],P0[9],     pw0[2]=PKW(P0,4), pw0[3]=PKW(P0,6), pw0); \
    VRD(2); SBAR(); GAPA(C0=__builtin_amdgcn_mfma_f32_32x32x16_bf16(kf[2],qr[1],C0,0,0,0),   P0[10],P0[11],P0[12],P0[13], pw1[0]=PKW(P0,8), pw1[1]=PKW(P0,10), pw1); \
    VRD(3); SBAR(); GAPA(C1=__builtin_amdgcn_mfma_f32_32x32x16_bf16(kf[3],qr[1],C1,0,0,0),   P0[14],P0[15],P1[0],P1[1],   pw1[2]=PKW(P0,12),pw1[3]=PKW(P0,14), pw1); \
    VRD(4); SBAR(); GAPA(C0=__builtin_amdgcn_mfma_f32_32x32x16_bf16(kf[4],qr[2],C0,0,0,0),   P1[2],P1[3],P1[4],P1[5],     pw2[0]=PKW(P1,0), pw2[1]=PKW(P1,2), pw2); \
    VRD(5); SBAR(); GAPA(C1=__builtin_amdgcn_mfma_f32_32x32x16_bf16(kf[5],qr[2],C1,0,0,0),   P1[6],P1[7],P1[8],P1[9],     pw2[2]=PKW(P1,4), pw2[3]=PKW(P1,6), pw2); \
    VRD(6); SBAR(); GAPA(C0=__builtin_amdgcn_mfma_f32_32x32x16_bf16(kf[6],qr[3],C0,0,0,0),   P1[10],P1[11],P1[12],P1[13], pw3[0]=PKW(P1,8), pw3[1]=PKW(P1,10), pw3); \
    VRD(7); SBAR(); GAPA(C1=__builtin_amdgcn_mfma_f32_32x32x16_bf16(kf[7],qr[3],C1,0,0,0),   P1[14],P1[15],0.f,0.f,       pw3[2]=PKW(P1,12),pw3[3]=PKW(P1,14), pw3); \
    l_reg+=sacc; \
    if(GK){DMA_K((t)+3,sl_cur);} if(GV){DMA_V((t)+1,2*sl_next);} \
    CMASK(C0,C1,t); \
    if constexpr(!NOREF){ float a=MX3(C0[0],C0[1],C1[0]),b=MX3(C0[2],C0[3],C1[1]); a=MX3(a,C1[2],C1[3]); \
      _Pragma("unroll") for(int r=4;r<16;r+=4){a=MX3(a,C0[r],C0[r+1]);b=MX3(b,C0[r+2],C0[r+3]);a=MX3(a,C1[r],C1[r+1]);b=MX3(b,C1[r+2],C1[r+3]);} \
      float rm=__builtin_fmaxf(a,b); { auto rr=__builtin_amdgcn_permlane32_swap(__float_as_uint(rm),__float_as_uint(rm),false,false); rm=__builtin_fmaxf(__uint_as_float(rr[0]),__uint_as_float(rr[1])); } \
      rm-=mhat;                                      \
      resc=false; \
      if(__builtin_expect(__any(rm>(float)THRL),0)){ const float dl=__builtin_fmaxf(rm,0.f); mhat+=dl; \
        const float f=__builtin_amdgcn_exp2f(-dl); l_reg*=f; if(hi==0)wsf[r32]=f; resc=true; } } \
    SBAR(); \
    WRD(0); GAPB(o[0]=__builtin_amdgcn_mfma_f32_32x32x16_bf16(PAF(0),VFR(0),o[0],0,0,0), C0,0); \
    WRD(1); GAPB(o[1]=__builtin_amdgcn_mfma_f32_32x32x16_bf16(PAF(0),VFR(1),o[1],0,0,0), C0,2); \
    WRD(2); KRD(GL,0); GAPB(o[2]=__builtin_amdgcn_mfma_f32_32x32x16_bf16(PAF(0),VFR(2),o[2],0,0,0), C0,4); \
    WRD(3); KRD(GL,1); GAPB(o[3]=__builtin_amdgcn_mfma_f32_32x32x16_bf16(PAF(0),VFR(3),o[3],0,0,0), C0,6); \
    WRD(4); KRD(GL,2); GAPB(o[0]=__builtin_amdgcn_mfma_f32_32x32x16_bf16(PAF(1),VFR(4),o[0],0,0,0), C0,8); \
    WRD(5); KRD(GL,3); GAPB(o[1]=__builtin_amdgcn_mfma_f32_32x32x16_bf16(PAF(1),VFR(5),o[1],0,0,0), C0,10); \
    WRD(6); GAPB(o[2]=__builtin_amdgcn_mfma_f32_32x32x16_bf16(PAF(1),VFR(6),o[2],0,0,0), C0,12); \
    WRD(7); GAPB(o[3]=__builtin_amdgcn_mfma_f32_32x32x16_bf16(PAF(1),VFR(7),o[3],0,0,0), C0,14); \
    GAPB(o[0]=__builtin_amdgcn_mfma_f32_32x32x16_bf16(PAF(2),WFR(0),o[0],0,0,0), C1,0); \
    GAPB(o[1]=__builtin_amdgcn_mfma_f32_32x32x16_bf16(PAF(2),WFR(1),o[1],0,0,0), C1,2); \
    GAPB(o[2]=__builtin_amdgcn_mfma_f32_32x32x16_bf16(PAF(2),WFR(2),o[2],0,0,0), C1,4); \
    GAPB(o[3]=__builtin_amdgcn_mfma_f32_32x32x16_bf16(PAF(2),WFR(3),o[3],0,0,0), C1,6); \
    GAPB(o[0]=__builtin_amdgcn_mfma_f32_32x32x16_bf16(PAF(3),WFR(4),o[0],0,0,0), C1,8); \
    GAPB(o[1]=__builtin_amdgcn_mfma_f32_32x32x16_bf16(PAF(3),WFR(5),o[1],0,0,0), C1,10); \
    GAPB(o[2]=__builtin_amdgcn_mfma_f32_32x32x16_bf16(PAF(3),WFR(6),o[2],0,0,0), C1,12); \
    GAPB(o[3]=__builtin_amdgcn_mfma_f32_32x32x16_bf16(PAF(3),WFR(7),o[3],0,0,0), C1,14); \
    }while(0)
  f32x16 o[4];o[0]=f32x16{};o[1]=f32x16{};o[2]=f32x16{};o[3]=f32x16{};
  int t=1;
  #undef CMASK
  #define CMASK(P0,P1,t) do{}while(0)
  for(;t+5<NT;t+=2){
    STEP(pB0,pB1,pA0,pA1,t,true,true,true);     WAIT_BAR(3); RESC(); ROT();
    STEP(pA0,pA1,pB0,pB1,t+1,true,true,true);   WAIT_BAR(3); RESC(); ROT();
  }
  #undef CMASK
  #define CMASK(P0,P1,t) do{int jb_=(t)-(NT-4); if(jb_>=0)cmask(P0,P1,jb_,qrel,hi);}while(0)
  #define ENDW(tt) do{ if((tt)+3<NT){WAIT_BAR(3);} else if((tt)+2<NT){WAIT_BAR(2);} else {WAIT_BAR(0);} }while(0)
  for(;t+1<NT;t+=2){
    STEP(pB0,pB1,pA0,pA1,t,(t+3<NT),(t+1<NT),(t+1<NT));       ENDW(t);   RESC(); ROT();
    STEP(pA0,pA1,pB0,pB1,t+1,(t+4<NT),(t+2<NT),(t+2<NT));     ENDW(t+1); RESC(); ROT();
  }
  STEP(pB0,pB1,pA0,pA1,NT-1,false,false,false); RESC();
  { float sacc=pB0[0]+pB0[1]; _Pragma("unroll") for(int r=2;r<16;++r)sacc+=pB0[r]; _Pragma("unroll") for(int r=0;r<16;++r)sacc+=pB1[r]; l_reg+=sacc;
    pw0=(u32x4){PKW(pB0,0),PKW(pB0,2),PKW(pB0,4),PKW(pB0,6)};pw1=(u32x4){PKW(pB0,8),PKW(pB0,10),PKW(pB0,12),PKW(pB0,14)};pw2=(u32x4){PKW(pB1,0),PKW(pB1,2),PKW(pB1,4),PKW(pB1,6)};pw3=(u32x4){PKW(pB1,8),PKW(pB1,10),PKW(pB1,12),PKW(pB1,14)};
    int ln_; asm volatile("v_mbcnt_lo_u32_b32 %0, -1, 0\n\tv_mbcnt_hi_u32_b32 %0, -1, %0":"=v"(ln_)); ln_&=63;
    const int vb0=(int)(lds0+LDS_V)+((ln_>>4)&1)*32+(ln_&3)*8+(4*((ln_>>5)&1)+((ln_&15)>>2))*64;
    SBAR(); pv(o,vb0+2*sl_cur,PAF(0),PAF(1),PAF(2),PAF(3)); }
  #undef PKW
  #undef PAF
  #undef VFR
  #undef WFR
  #undef VOFF
  #undef WRD
  #undef ZC
  #undef PIN
  #undef MX3
  #undef GAPA
  #undef GAPB
  #undef EX
  #undef VRD
  #undef KRD
  #undef STEP
  #undef ENDW
  {auto rr=__builtin_amdgcn_permlane32_swap(__float_as_uint(l_reg),__float_as_uint(l_reg),false,false);l_reg=__uint_as_float(rr[0])+__uint_as_float(rr[1]);}
  int le_; asm volatile("v_mbcnt_lo_u32_b32 %0, -1, 0\n\tv_mbcnt_hi_u32_b32 %0, -1, %0":"=v"(le_)); le_&=63; const int r32e=le_&31,hie=(le_>>5)&1;
  float*wsfe=(float*)(shm+LDS_WS)+wid*64;
  if(hie==0)wsfe[32+r32e]=l_reg;asm volatile("s_waitcnt lgkmcnt(0)":::"memory");
  float rli[16];
  #pragma unroll
  for(int r=0;r<16;++r)rli[r]=__builtin_amdgcn_rcpf(wsfe[32+crow(r,hie)]);
  bf16*Ow=O+(rowbase+q0+wid*QBLK)*512+hv*128;
  u32x4 otv[8];
  if(dc.act==3){
    unsigned*flagoth=dc.flags+(((1-dc.comp)*16+b*4+hv)*16+qb);
    if(wid==0&&le_==0){ unsigned sp_=0u; while(__hip_atomic_load(flagoth,__ATOMIC_RELAXED,__HIP_MEMORY_SCOPE_AGENT)!=1u){ __builtin_amdgcn_s_sleep(2); if(++sp_>(1u<<22))break; } }
    asm volatile("s_waitcnt lgkmcnt(0)\n\ts_barrier":::"memory");
    const rsrc_t oor_=wt_rsrc(dc.Oo,(unsigned)(16384*512*2)); const unsigned ooff_=(unsigned)(((rowbase+(long)qb*QB+wid*QBLK)*512+hv*128)*2);
    #pragma unroll
    for(int i=0;i<8;++i){const int row=i*4+((le_>>4)&3); otv[i]=ld16_sc1(oor_,ooff_+(unsigned)((row*512+(le_&15)*8)*2));}
  }
  { bf16*stg=(bf16*)(shm+LDS_OST)+wid*4096;
    #pragma unroll
    for(int r=0;r<16;++r){const int orow=crow(r,hie);
      #pragma unroll
      for(int d0=0;d0<4;++d0)stg[orow*128+d0*32+r32e]=__float2bfloat16(o[d0][r]*rli[r]);}
    asm volatile("s_waitcnt lgkmcnt(0)":::"memory");
    unsigned*flagown=dc.flags+((dc.comp*16+b*4+hv)*16+qb);
    const int ch=le_&15;
    if(dc.act==0){
      #pragma unroll
      for(int i=0;i<8;++i){const int row=i*4+((le_>>4)&3); const u32x4 v=*(const u32x4*)(stg+row*128+ch*8); ATTN_STORE16(Ow+(long)row*512+ch*8,v);}
      asm volatile("s_waitcnt lgkmcnt(0)\n\ts_barrier":::"memory");
    }else{
      if(dc.act==1||dc.act==2){
        const rsrc_t orr_=wt_rsrc(O,(unsigned)(16384*512*2)); const unsigned owoff_=(unsigned)(((rowbase+q0+wid*QBLK)*512+hv*128)*2);
        #pragma unroll
        for(int i=0;i<8;++i){const int row=i*4+((le_>>4)&3); const u32x4 v=*(const u32x4*)(stg+row*128+ch*8); st16_wt(orr_,owoff_+(unsigned)((row*512+ch*8)*2),v);}
        if(dc.act==2){
        asm volatile("s_waitcnt vmcnt(0) lgkmcnt(0)\n\ts_barrier":::"memory");
        if(wid==0&&le_==0)__hip_atomic_store(flagown,1u,__ATOMIC_RELAXED,__HIP_MEMORY_SCOPE_AGENT);
        }else asm volatile("s_waitcnt lgkmcnt(0)\n\ts_barrier":::"memory");
      }
      if(dc.act>=2){
        const int qbc=(dc.act==2)?dc.qbP:qb;
        unsigned*flagoth=dc.flags+(((1-dc.comp)*16+b*4+hv)*16+qbc);
        if(dc.act==2){
        if(wid==0&&le_==0){ unsigned sp_=0u; while(__hip_atomic_load(flagoth,__ATOMIC_RELAXED,__HIP_MEMORY_SCOPE_AGENT)!=1u){ __builtin_amdgcn_s_sleep(2); if(++sp_>(1u<<22))break; } }
        asm volatile("s_waitcnt vmcnt(0) lgkmcnt(0)\n\ts_barrier":::"memory");
        }
        const rsrc_t oor_=wt_rsrc(dc.Oo,(unsigned)(16384*512*2));
        const f32x4 g0=*(const f32x4*)(dc.sg+ch*8),g1=*(const f32x4*)(dc.sg+ch*8+4); const float lam=dc.lam;
        const long qrow=rowbase+(long)qbc*QB+wid*QBLK; const unsigned ooff_=(unsigned)((qrow*512+hv*128)*2);
        u32x4 owv[8];
        #pragma unroll
        for(int i=0;i<8;++i){const int row=i*4+((le_>>4)&3); if(dc.act==2)otv[i]=ld16_sc1(oor_,ooff_+(unsigned)((row*512+ch*8)*2));
          owv[i]=(dc.act==3)?*(const u32x4*)(stg+row*128+ch*8):*(const u32x4*)(O+(qrow+row)*512+hv*128+ch*8);}
        #pragma unroll
        for(int i=0;i<8;++i){const int row=i*4+((le_>>4)&3);
          float a0[8],a1[8],oo[8];
          if(dc.comp==0){unpack8(owv[i],a0);unpack8(otv[i],a1);}else{unpack8(otv[i],a0);unpack8(owv[i],a1);}
          float ss=0.f;
          #pragma unroll
          for(int k=0;k<8;++k){oo[k]=a0[k]-lam*a1[k];ss+=oo[k]*oo[k];}
          ss+=lane_get(ss,le_^1);ss+=lane_get(ss,le_^2);ss+=lane_get(ss,le_^4);ss+=lane_get(ss,le_^8);
          const float ri=rsqrtf(ss*(1.f/128.f)+EPS)*(1.f-LAM_INIT);
          u32x4 w; w.x=pk2(oo[0]*ri*g0.x,oo[1]*ri*g0.y); w.y=pk2(oo[2]*ri*g0.z,oo[3]*ri*g0.w); w.z=pk2(oo[4]*ri*g1.x,oo[5]*ri*g1.y); w.w=pk2(oo[6]*ri*g1.z,oo[7]*ri*g1.w);
          *(u32x4*)(dc.mix+((size_t)(qrow+row)*1024+512+hv*128+ch*8)*2)=w;}
        asm volatile("s_waitcnt lgkmcnt(0)\n\ts_barrier":::"memory");
      }
    } }
  #undef DMA_K
  #undef DMA_V
  #undef CMASK
  #undef START
  #undef RESC
  #undef ROT
}
constexpr int ATTN_LDS_BYTES=LDS_BYTES;
struct AttnTensors { const bf16* Q; const bf16* K; const bf16* V; bf16* O; };
struct AttnUnit { int bhc; int qb; };
struct StaticOrder {
  int vcu;
  __device__ __forceinline__ explicit StaticOrder(int grid,int block):vcu((block%8)*(grid/8)+block/8){}
  __device__ __forceinline__ bool next(int i,AttnUnit&u)const{ if(i>=2)return false; const int s=vcu&7; u.bhc=vcu>>3; u.qb=((i==0)!=((u.bhc&1)!=0))?s:15-s; return true; }
};
template<class Sched,class Mid,bool NOREF,int THRL=8> __device__ __forceinline__ void attn_phase(char*lds,const AttnTensors&T,const Sched&S,const Mid&mid,unsigned char*mix,const float*sg,float lam,unsigned*flags){
  AttnUnit u;
  for(int i=0;S.next(i,u);++i){ if(i==1)mid(); const int b=u.bhc>>3,hh=(u.bhc>>1)&3,c=u.bhc&1; AttnUnit u0; S.next(0,u0); const DiffCtx dc{c,(i==0)?1:3,u0.qb,T.O+(long)(1-c)*16384*512,mix,sg,lam,flags,(i==1)?((c*16+b*4+hh)*16+u0.qb):-1}; attn_unit<THRL,NOREF>(b,hh*2+c,hh,u.qb,T.Q,T.K,T.V,T.O+(long)c*16384*512,lds,dc); }
}
#undef SBAR
#undef WAIT_BAR
}


template <int PART> __device__ __forceinline__ void phase2b(const Params& p, const Ctx& c) {
    const bf16_t* PROJ = (const bf16_t*)(p.ws + WS_PROJ); const bf16_t* ATT = (const bf16_t*)p.out; bf16_t* MIX = (bf16_t*)(p.ws + WS_XN);
    const int lane = c.lane;
    const float d1 = wave_sum(p.lq1[lane] * p.lk1[lane]), d2 = wave_sum(p.lq2[lane] * p.lk2[lane]);
    const float lam = expf(d1) - expf(d2) + LAM_INIT;
    float sg[8], w0[8], w1[8], w2[8], cgn[8];
#pragma unroll
    for (int i = 0; i < 8; ++i) { sg[i] = p.subln_g[(8 * lane + i) & 127] * (1.f - LAM_INIT); w0[i] = p.conv_w[8 * lane + i]; w1[i] = p.conv_w[512 + 8 * lane + i]; w2[i] = p.conv_w[1024 + 8 * lane + i]; cgn[i] = p.conv_out_g[8 * lane + i]; }
    if constexpr ((PART & 1) != 0) {
        for (int t0 = c.gw; t0 < T; t0 += 4 * c.ngw) {
            u32x4 A0[4], A1[4];
#pragma unroll
            for (int r = 0; r < 4; ++r) { const int t = (t0 + r * c.ngw < T) ? t0 + r * c.ngw : t0; A0[r] = *(const u32x4*)(ATT + (size_t)t * 512 + 8 * lane); A1[r] = *(const u32x4*)(ATT + ((size_t)T + t) * 512 + 8 * lane); }
#pragma unroll
            for (int r = 0; r < 4; ++r) { const int t = t0 + r * c.ngw; if (t < T) {
                float a0[8], a1[8], o[8]; unpack8(A0[r], a0); unpack8(A1[r], a1);
                float ss = 0.f;
#pragma unroll
                for (int i = 0; i < 8; ++i) { o[i] = a0[i] - lam * a1[i]; ss += o[i] * o[i]; }
                ss += lane_get(ss, lane ^ 1); ss += lane_get(ss, lane ^ 2); ss += lane_get(ss, lane ^ 4); ss += lane_get(ss, lane ^ 8);
                const float rinv = rsqrtf(ss * (1.f / 128.f) + EPS);
                u32x4 w; w.x = pk2(o[0] * rinv * sg[0], o[1] * rinv * sg[1]); w.y = pk2(o[2] * rinv * sg[2], o[3] * rinv * sg[3]);
                w.z = pk2(o[4] * rinv * sg[4], o[5] * rinv * sg[5]); w.w = pk2(o[6] * rinv * sg[6], o[7] * rinv * sg[7]);
                *(u32x4*)(MIX + (size_t)t * D + 512 + 8 * lane) = w; } }
        }
    }
    if constexpr ((PART & 2) != 0) {
        for (int t0 = c.gw * 8; t0 < T; t0 += c.ngw * 8) {
            const int s0 = t0 & (SEQ - 1);
            u32x4 X[10], Cg[10], Bg[8];
#pragma unroll
            for (int j = 0; j < 10; ++j) { const int row = (j < 2 && s0 == 0) ? t0 : t0 - 2 + j;
                const bf16_t* rp = PROJ + (size_t)row * DIN + 8 * lane; X[j] = *(const u32x4*)(rp + COL_XC); Cg[j] = *(const u32x4*)(rp + COL_CG); if (j >= 2) Bg[j - 2] = *(const u32x4*)(rp + COL_BG); }
#pragma unroll
            for (int i = 0; i < 8; ++i) { const int t = t0 + i, s = s0 + i; const float m1 = s >= 1 ? 1.f : 0.f, m2 = s >= 2 ? 1.f : 0.f;
                float xc[8], bg[8], cgt[8], xa[8], ca[8], xb[8], cb[8], y[8];
                unpack8(X[i + 2], xc); unpack8(Bg[i], bg); unpack8(Cg[i + 2], cgt); unpack8(X[i + 1], xa); unpack8(Cg[i + 1], ca); unpack8(X[i], xb); unpack8(Cg[i], cb);
                float ss = 0.f;
#pragma unroll
                for (int k = 0; k < 8; ++k) { const float u0 = cgt[k] * xc[k], u1 = ca[k] * xa[k] * m1, u2 = cb[k] * xb[k] * m2; y[k] = bg[k] * (w0[k] * u2 + w1[k] * u1 + w2[k] * u0); ss += y[k] * y[k]; }
                ss += lane_get(ss, lane ^ 1); ss += lane_get(ss, lane ^ 2); ss += lane_get(ss, lane ^ 4);
                const float rinv = rsqrtf(ss * (1.f / 64.f) + EPS);
                u32x4 w; w.x = pk2(y[0] * rinv * cgn[0], y[1] * rinv * cgn[1]); w.y = pk2(y[2] * rinv * cgn[2], y[3] * rinv * cgn[3]);
                w.z = pk2(y[4] * rinv * cgn[4], y[5] * rinv * cgn[5]); w.w = pk2(y[6] * rinv * cgn[6], y[7] * rinv * cgn[7]);
                *(u32x4*)(MIX + (size_t)t * D + 8 * lane) = w; }
        }
    }
}

constexpr int WR_PITCH = 2048 + 64;
constexpr int P3B_X_OFF = 48 * WR_PITCH;
constexpr int P3B_H_OFF = P3B_X_OFF + 16384 + 4096;
constexpr int P3B_G_OFF = P3B_X_OFF + 16384;
template <int VAR = 0> __device__ __forceinline__ void phase3b(const Params& p, const Ctx& c) {
    unsigned char* HN2 = p.ws + WS_XN;
    const bf16_t* Wr = (const bf16_t*)(p.ws + WS_WR); float* RSTD = (float*)(p.ws + WS_RSTD);
    const int fr = c.lane & 15, fq = c.lane >> 4, tg = c.wave & 3, kh = c.wave >> 2;
    unsigned char* wlds = c.lds; float* xch = (float*)(c.lds + P3B_X_OFF); float* glds = (float*)(c.lds + P3B_G_OFF);
    unsigned* hist = (unsigned*)(c.lds + P3B_H_OFF); u32x2* SEG = (u32x2*)(p.ws + WS_SEG); unsigned* HIST = (unsigned*)(p.ws + WS_HIST);
    if (c.tid < 64) hist[c.tid] = 0u;
    __syncthreads();
    { const unsigned wl0 = (unsigned)(size_t)(PG8_LAS unsigned char*)wlds;
#pragma unroll
      for (int q = 0; q < 12; ++q) { const int pc = c.wave * 12 + q, row = pc >> 1, hf = pc & 1; attn128::glds16((const char*)Wr + (size_t)row * 2048 + hf * 1024, (unsigned)c.lane * 16u, wl0 + (unsigned)(row * WR_PITCH + hf * 1024)); } }
    f32x4 tgv = (f32x4){0.f, 0.f, 0.f, 0.f};
    if (c.tid < D / 4) tgv = *(const f32x4*)(p.ffn_norm_g + 4 * c.tid);
    bool staged = false;
    for (int blk = c.bid; blk < T / 64; blk += c.nb) {
        const int t = blk * 64 + tg * 16 + fr, kbase = kh * 512;
        const float* grow = glds + kbase + 8 * fq;
        const bf16_t* arow = (const bf16_t*)(p.ws + WS_AO) + (size_t)t * D + kbase + 8 * fq;
        unsigned char* orow = HN2 + (size_t)t * D + kbase + 8 * fq;
        u32x4 ab[16];
#pragma unroll
        for (int st = 0; st < 16; ++st) ab[st] = *(const u32x4*)(arow + st * 32);
        if (!staged) {
            if (c.tid < D / 4) *(f32x4*)(glds + 4 * c.tid) = tgv;
            asm volatile("s_waitcnt vmcnt(16)" ::: "memory"); __syncthreads(); staged = true; }
        f32x4 acc[3]; acc[0] = (f32x4){0.f, 0.f, 0.f, 0.f}; acc[1] = acc[0]; acc[2] = acc[0];
        float ss = 0.f;
        const unsigned char* wb = wlds + fr * WR_PITCH + (kbase + 8 * fq) * 2;
#pragma unroll
        for (int st = 0; st < 16; ++st) {
            const u32x4 aw = ab[st];
            const f32x4 h0 = (f32x4){bflo(aw.x), bfhi(aw.x), bflo(aw.y), bfhi(aw.y)}, h1 = (f32x4){bflo(aw.z), bfhi(aw.z), bflo(aw.w), bfhi(aw.w)};
            const f32x4 g0 = *(const f32x4*)(grow + st * 32), g1 = *(const f32x4*)(grow + st * 32 + 4);
            ss += (h0.x * h0.x + h0.y * h0.y) + (h0.z * h0.z + h0.w * h0.w) + (h1.x * h1.x + h1.y * h1.y) + (h1.z * h1.z + h1.w * h1.w);
            float a[8] = {h0.x * g0.x, h0.y * g0.y, h0.z * g0.z, h0.w * g0.w, h1.x * g1.x, h1.y * g1.y, h1.z * g1.z, h1.w * g1.w};
            if (!(VAR & 2)) { u32x2 o8; o8.x = pk4_fp8(a[0], a[1], a[2], a[3]); o8.y = pk4_fp8(a[4], a[5], a[6], a[7]); *(u32x2*)(orow + st * 32) = o8; }
            const bf16x8 Ahi = __builtin_bit_cast(bf16x8, aw);
#pragma unroll
            for (int nf = 0; nf < 3; ++nf) {
                const bf16x8 w1 = *(const bf16x8*)(wb + nf * 16 * WR_PITCH + st * 64);
                acc[nf] = __builtin_amdgcn_mfma_f32_16x16x32_bf16(w1, Ahi, acc[nf], 0, 0, 0);
            }
        }
        float* xs = xch + (tg * 64 + c.lane) * 16;
        if (kh == 1) { *(f32x4*)(xs) = acc[0]; *(f32x4*)(xs + 4) = acc[1]; *(f32x4*)(xs + 8) = acc[2]; xs[12] = ss; }
        __syncthreads();
        if (kh == 0) {
            acc[0] += *(const f32x4*)(xs); acc[1] += *(const f32x4*)(xs + 4); acc[2] += *(const f32x4*)(xs + 8); ss += xs[12];
            { const int ln = fr + 16 * fq; ss += lane_get(ss, ln ^ 16); ss += lane_get(ss, ln ^ 32); }
            const float rstd = rsqrtf(ss * (1.f / D) + EPS);
            float le[8];
#pragma unroll
            for (int j = 0; j < 4; ++j) { le[j] = acc[0][j] * rstd; le[4 + j] = acc[1][j] * rstd; }
            const float lg = acc[2][0] * rstd;
            float gl[4];
#pragma unroll
            for (int g = 0; g < 4; ++g) gl[g] = lane_get(lg, fr + 16 * g);
            int gi = 0; float gm = gl[0];
#pragma unroll
            for (int g = 1; g < 4; ++g) if (gl[g] > gm) { gm = gl[g]; gi = g; }
            float gs = 0.f;
#pragma unroll
            for (int g = 0; g < 4; ++g) gs += expf(gl[g] - gm);
            const float ggate = 1.f / gs;
            int i1 = 0; float v1 = le[0];
#pragma unroll
            for (int e = 1; e < 8; ++e) if (le[e] > v1) { v1 = le[e]; i1 = e; }
            int i2 = 0; float v2 = -INFINITY;
#pragma unroll
            for (int e = 0; e < 8; ++e) if (e != i1 && le[e] > v2) { v2 = le[e]; i2 = e; }
            const float ex = expf(v2 - v1), wa = 1.f / (1.f + ex), wb2 = ex * wa;
            if (fq == 0) RSTD[t] = rstd;
            if (!(VAR & 1) && fq == gi) {
                const int l1 = ((gi * 8 + i1) << 1), l2 = ((gi * 8 + i2) << 1) + 1;
                const unsigned r1 = __hip_atomic_fetch_add(hist + l1, 1u, __ATOMIC_RELAXED, __HIP_MEMORY_SCOPE_WORKGROUP), r2 = __hip_atomic_fetch_add(hist + l2, 1u, __ATOMIC_RELAXED, __HIP_MEMORY_SCOPE_WORKGROUP);
                const unsigned rsb = f2bf(rstd);
                SEG[((size_t)blk * 64 + l1) * 64 + r1] = (u32x2){(unsigned)t, (f2bf(wa * ggate) << 16) | rsb};
                SEG[((size_t)blk * 64 + l2) * 64 + r2] = (u32x2){(unsigned)t, (f2bf(wb2 * ggate) << 16) | rsb};
            }
        }
        __syncthreads();
        if (!(VAR & 1) && c.tid < 64) { HIST[blk * 64 + c.tid] = hist[c.tid]; hist[c.tid] = 0u; }
        __syncthreads();
    }
}

__device__ __forceinline__ void phase3c(const Params& p, const Ctx& c) {
    const unsigned* HIST = (const unsigned*)(p.ws + WS_HIST); const u32x4* ENT = (const u32x4*)(p.ws + WS_ENT);
    unsigned* cnt = (unsigned*)(p.ws + WS_CTL); int* list = (int*)(p.ws + WS_LIST); float* wl = (float*)(p.ws + WS_WL);
    unsigned* part = (unsigned*)c.lds;
    const int l = c.tid & 63, pt = c.tid >> 6;
    for (int blk = c.bid; blk < T / 64; blk += c.nb) {
        unsigned pre = 0u, tot = 0u;
        u32x4 e = (u32x4){0u, 0u, 0u, 0u};
        if (c.tid < 128) e = ENT[(size_t)blk * 128 + c.tid];
        unsigned hv[32];
#pragma unroll
        for (int i = 0; i < 32; ++i) hv[i] = HIST[(pt * 32 + i) * 64 + l];
#pragma unroll
        for (int i = 0; i < 32; ++i) { tot += hv[i]; pre += (pt * 32 + i < blk) ? hv[i] : 0u; }
        __syncthreads();
        part[pt * 64 + l] = pre; part[512 + pt * 64 + l] = tot;
        __syncthreads();
        if (c.tid < 128) {
            unsigned base = 0u;
#pragma unroll
            for (int q = 0; q < 8; ++q) base += part[q * 64 + e.x];
            const size_t pos = (size_t)e.x * T + base + e.y;
            const unsigned ez = e.z, ew = e.w;
            list[pos] = (int)ez; wl[pos] = __uint_as_float(ew);
        }
        if (blk == 0 && c.tid < 64) { unsigned t2 = 0u;
#pragma unroll
            for (int q = 0; q < 8; ++q) t2 += part[512 + q * 64 + c.tid];
            cnt[c.tid] = t2; }
    }
}

constexpr int TAB_OFF = 131072, UT_OFF = TAB_OFF + 2048, BARST_OFF = LDS_BYTES - 64;
template <bool GATHERA> struct GroupSched {
    struct Unit { int l, mt, pn, ui; bool hf; };
    const int* tab; const unsigned* ut; const char* Abase; const char* Bbase; int K, G, vcu, l0, lstep, nl; int lane_;
    __device__ __forceinline__ bool next(int i, Unit& u) const {
        const int L = i * G + vcu, totF = tab[129 + nl], totH = tab[194 + nl];
        if (L >= (totF + totH) * 4) return false;
        const int tile = L >> 2, lane = lane_, ln = lane < nl ? lane : 0;
        int j, mt; bool hf;
        if (tile < totF) { const int pv = tab[130 + ln]; j = __builtin_popcountll(__ballot(lane < nl && pv <= tile)); mt = tile - tab[129 + j]; hf = false; }
        else { const int t2 = tile - totF, pv = tab[195 + ln]; j = __builtin_popcountll(__ballot(lane < nl && pv <= t2)); mt = tab[130 + j] - tab[129 + j]; hf = true; }
        u.l = l0 + j * lstep; u.mt = __builtin_amdgcn_readfirstlane(mt); u.pn = L & 3; u.ui = i; u.hf = hf; return true;
    }
    __device__ __forceinline__ bool half(const Unit& u) const { return u.hf; }
    __device__ __forceinline__ const char* a_base(const Unit& u) const { return GATHERA ? Abase : Abase + (size_t)(__builtin_amdgcn_readfirstlane(tab[64 + u.l]) + u.mt * 256) * K * 2; }
    __device__ __forceinline__ const char* b_base(const Unit& u) const { return Bbase + (size_t)((u.l >> 1) * 1024 + u.pn * 256) * K * 2; }
    __device__ __forceinline__ unsigned rowoff(const Unit& u, int r) const { return ut[u.ui * 768 + r]; }
    __device__ __forceinline__ void a_ready(const Unit&) const {}
    __device__ __forceinline__ void done(const Unit&) const {}
};
template <bool GATHERA> __device__ __forceinline__ void group_tables(const Params& p, const Ctx& c, GroupSched<GATHERA>& S, int l0, int lstep, int nl, int K, const void* Abase, const void* Bbase) {
    int* tab = (int*)(c.lds + TAB_OFF); unsigned* ut = (unsigned*)(c.lds + UT_OFF);
    const unsigned* HIST = (const unsigned*)(p.ws + WS_HIST); const u32x2* SEG = (const u32x2*)(p.ws + WS_SEG); const float* RSTD = (const float*)(p.ws + WS_RSTD);
    unsigned* part = (unsigned*)c.lds;
    unsigned* pre = part + 512;
    const int hl = c.tid & 63, pt = c.tid >> 6;
    unsigned hv[32], tot = 0u;
#pragma unroll
    for (int i = 0; i < 32; ++i) hv[i] = HIST[(pt * 32 + i) * 64 + hl];
#pragma unroll
    for (int i = 0; i < 32; ++i) tot += hv[i];
    __syncthreads();
    part[pt * 64 + hl] = tot;
    __syncthreads();
    if (c.wave == 0) {
        const int l = c.lane; int n = 0;
#pragma unroll
        for (int q = 0; q < 8; ++q) n += (int)part[q * 64 + l];
        const int rem = n & 255, hfl = (rem >= 1 && rem <= 128) ? 1 : 0, tiles = (n + 255) >> 8;
        int rb = tiles << 8, mf = tiles - hfl, mh = hfl;
#pragma unroll
        for (int o = 1; o < 64; o <<= 1) { const int sl = (l - o) & 63, a = lane_geti(rb, sl), b2 = lane_geti(mf, sl), c2 = lane_geti(mh, sl); if (l >= o) { rb += a; mf += b2; mh += c2; } }
        tab[l] = n; tab[64 + l] = rb - (tiles << 8); tab[129 + l] = mf - (tiles - hfl); tab[194 + l] = mh - hfl;
        if (l == 63) { tab[64 + 64] = rb; tab[129 + 64] = mf; tab[194 + 64] = mh; }
    }
    __syncthreads();
    S.tab = tab; S.ut = ut; S.Abase = (const char*)Abase; S.Bbase = (const char*)Bbase; S.K = K; S.G = c.nb; S.vcu = (c.nb % 8 == 0) ? (c.bid % 8) * (c.nb / 8) + c.bid / 8 : c.bid; S.l0 = l0; S.lstep = lstep; S.nl = nl; S.lane_ = c.lane;
    typename GroupSched<GATHERA>::Unit u0, u1, u2, u3;
    const bool h0 = S.next(0, u0), h1 = S.next(1, u1), h2 = S.next(2, u2), h3 = S.next(3, u3);
    { unsigned base = 0u;
#pragma unroll
      for (int q = 0; q < 8; ++q) base += (q < pt) ? part[q * 64 + hl] : 0u;
#define GT_PRE(i, h, u) do { if ((h) && hl == u.l) { unsigned run = base; _Pragma("unroll") for (int j = 0; j < 32; ++j) { pre[(i) * 256 + pt * 32 + j] = run; run += hv[j]; } } } while (0)
      GT_PRE(0, h0, u0); GT_PRE(1, h1, u1); GT_PRE(2, h2, u2); GT_PRE(3, h3, u3);
#undef GT_PRE
    }
    __syncthreads();
    if (c.tid < 256) {
        const int r = c.tid; int tok[4]; float wv[4], rs[4]; bool vd[4];
#define GT_LOAD(i, h, u) do { tok[i] = 0; wv[i] = 0.f; rs[i] = 0.f; vd[i] = false; if (h) { const int n = tab[u.l], pos = u.mt * 256 + r; vd[i] = pos < n; const unsigned idx = (unsigned)(vd[i] ? pos : n - 1); \
            int b_ = 0; _Pragma("unroll") for (int st_ = 128; st_ >= 1; st_ >>= 1) b_ += (pre[(i) * 256 + b_ + st_] <= idx) ? st_ : 0; \
            const u32x2 e_ = SEG[((size_t)b_ * 64 + u.l) * 64 + (idx - pre[(i) * 256 + b_])]; tok[i] = (int)e_.x; wv[i] = vd[i] ? __uint_as_float(e_.y & 0xffff0000u) : 0.f; rs[i] = __uint_as_float(e_.y << 16); } } while (0)
        GT_LOAD(0, h0, u0); GT_LOAD(1, h1, u1); GT_LOAD(2, h2, u2); GT_LOAD(3, h3, u3);
#undef GT_LOAD
        const bool hh[4] = {h0, h1, h2, h3};
#pragma unroll
        for (int i = 0; i < 4; ++i) if (hh[i]) {
            ut[i * 768 + r] = GATHERA ? (unsigned)tok[i] * (unsigned)(K * 2) : (vd[i] ? (unsigned)tok[i] : 0xffffffffu);
            ut[i * 768 + 256 + r] = __builtin_bit_cast(unsigned, wv[i]);
            ut[i * 768 + 512 + r] = __builtin_bit_cast(unsigned, rs[i]);
        }
    }
    __syncthreads();
}
__device__ __forceinline__ void group_tables_reuse(const Ctx& c, GroupSched<false>& S, int nl, int K, const void* Abase, const void* Bbase) {
    int* tab = (int*)(c.lds + TAB_OFF); unsigned* ut = (unsigned*)(c.lds + UT_OFF);
    S.tab = tab; S.ut = ut; S.Abase = (const char*)Abase; S.Bbase = (const char*)Bbase; S.K = K; S.G = c.nb; S.vcu = (c.nb % 8 == 0) ? (c.bid % 8) * (c.nb / 8) + c.bid / 8 : c.bid; S.l0 = 0; S.lstep = 1; S.nl = nl; S.lane_ = c.lane;
    GroupSched<false>::Unit u0, u1, u2, u3;
    const bool h0 = S.next(0, u0), h1 = S.next(1, u1), h2 = S.next(2, u2), h3 = S.next(3, u3);
    if (c.tid < 256) {
        const int r = c.tid;
#define GT_FIX(i, h, u) do { if (h) { const bool vd_ = u.mt * 256 + r < tab[u.l]; const unsigned w0_ = ut[i * 768 + r]; ut[i * 768 + r] = vd_ ? (w0_ >> 10) : 0xffffffffu; } } while (0)
        GT_FIX(0, h0, u0); GT_FIX(1, h1, u1); GT_FIX(2, h2, u2); GT_FIX(3, h3, u3);
#undef GT_FIX
    }
    __syncthreads();
}
struct EpiAct {
    static constexpr bool PERM = true, AFTER_DRAIN = false;
    unsigned char* ACT; const int* tab; const unsigned* ut;
    __device__ __forceinline__ void operator()(const f32x4 (&acc)[2][2][4][2], const GroupSched<true>::Unit& u, int wr, int wc, int fr, int fq) const {
        const int rb = tab[64 + u.l] + u.mt * 256;
#pragma unroll
        for (int ai = 0; ai < 2; ++ai)
#pragma unroll
            for (int m = 0; m < 4; ++m) {
                const int r = ai * 128 + wr * 64 + m * 16 + fr;
                const float w = __builtin_bit_cast(float, ut[u.ui * 768 + 256 + r]), rs = __builtin_bit_cast(float, ut[u.ui * 768 + 512 + r]);
                const float c1 = rs * -1.44269504f, c2 = rs * rs * (w * ACT8_SCALE);
                f32x4 a[2];
#pragma unroll
                for (int n = 0; n < 2; ++n) {
                    const f32x4 g = acc[ai][0][m][n], up = acc[ai][1][m][n];
                    f32x4 e = g * c1; e.x = __builtin_amdgcn_exp2f(e.x); e.y = __builtin_amdgcn_exp2f(e.y); e.z = __builtin_amdgcn_exp2f(e.z); e.w = __builtin_amdgcn_exp2f(e.w);
                    f32x4 d = e + 1.f; d.x = __builtin_amdgcn_rcpf(d.x); d.y = __builtin_amdgcn_rcpf(d.y); d.z = __builtin_amdgcn_rcpf(d.z); d.w = __builtin_amdgcn_rcpf(d.w);
                    a[n] = (g * up) * (d * c2);
                }
                u32x2 o; o.x = pk4_fp8(a[0].x, a[0].y, a[0].z, a[0].w); o.y = pk4_fp8(a[1].x, a[1].y, a[1].z, a[1].w);
                *(u32x2*)(ACT + (size_t)(rb + r) * F + u.pn * 128 + wc * 32 + 8 * fq) = o;
            }
    }
};
struct EpiY {
    static constexpr bool PERM = true, AFTER_DRAIN = false;
    unsigned char* Y0; size_t ydelta; const unsigned* ut;
    __device__ __forceinline__ void operator()(const f32x4 (&acc)[2][2][4][2], const GroupSched<false>::Unit& u, int wr, int wc, int fr, int fq) const {
        unsigned char* Y = Y0 + (size_t)(u.l & 1) * ydelta;
        const int col0 = u.pn * 256 + wc * 32 + 8 * fq;
#pragma unroll
        for (int ai = 0; ai < 2; ++ai)
#pragma unroll
            for (int m = 0; m < 4; ++m) {
                const unsigned tok = ut[u.ui * 768 + ai * 128 + wr * 64 + m * 16 + fr];
                if (tok != 0xffffffffu) {
                    unsigned char* rowp = Y + (size_t)tok * D + col0;
#pragma unroll
                    for (int bj = 0; bj < 2; ++bj) {
                        const f32x4 v0 = acc[ai][bj][m][0] * Y8_SCALE, v1 = acc[ai][bj][m][1] * Y8_SCALE;
                        u32x2 w; w.x = pk4_fp8(v0.x, v0.y, v0.z, v0.w); w.y = pk4_fp8(v1.x, v1.y, v1.z, v1.w);
                        *(u32x2*)(rowp + bj * 128) = w;
                    }
                }
            }
    }
};
__device__ __forceinline__ void phase4_fast(const Params& p, const Ctx& c) {
    GroupSched<true> S; group_tables<true>(p, c, S, 0, 1, NLIST, D / 2, p.ws + WS_XN, p.ws + WS_WGU);
    EpiAct E{(unsigned char*)p.out, S.tab, S.ut};
    pg8::gemm_phase<EpiAct, GroupSched<true>, true, true, true, 122, 127>((PG8_LAS unsigned char*)c.lds, D / 2, S, E, c.wave);
}
__device__ __forceinline__ void phase5_fast(const Params& p, const Ctx& c) {
    GroupSched<false> S; group_tables_reuse(c, S, NLIST, F / 2, p.out, p.ws + WS_WD);
    EpiY E{p.ws + WS_XN, WS_YB1 - WS_XN, S.ut};
    pg8::gemm_phase<EpiY, GroupSched<false>, true, true, false, 122, 123>((PG8_LAS unsigned char*)c.lds, F / 2, S, E, c.wave);
}
__device__ __forceinline__ void phase6(const Params& p, const Ctx& c) {
    const unsigned char* Y0 = p.ws + WS_XN; const unsigned char* Y1 = p.ws + WS_YB1; const bf16_t* XB = (const bf16_t*)(p.ws + WS_AO);
    for (int t0 = c.gw; t0 < T; t0 += 2 * c.ngw) {
        u32x4 xv[2][2]; u32x2 ya[2][2], yb[2][2];
#pragma unroll
        for (int rr = 0; rr < 2; ++rr) { const int t = (t0 + rr * c.ngw < T) ? t0 + rr * c.ngw : t0;
#pragma unroll
            for (int hf = 0; hf < 2; ++hf) { const size_t o = (size_t)t * D + hf * 512 + 8 * c.lane;
                xv[rr][hf] = *(const u32x4*)(XB + o); ya[rr][hf] = *(const u32x2*)(Y0 + o); yb[rr][hf] = *(const u32x2*)(Y1 + o); } }
#pragma unroll
        for (int rr = 0; rr < 2; ++rr) { const int t = t0 + rr * c.ngw; if (t < T) {
#pragma unroll
            for (int hf = 0; hf < 2; ++hf) { const size_t o = (size_t)t * D + hf * 512 + 8 * c.lane;
                float x8[8], y0[8], y1[8]; unpack8(xv[rr][hf], x8); unpack8_fp8(ya[rr][hf], y0); unpack8_fp8(yb[rr][hf], y1);
#pragma unroll
                for (int i = 0; i < 8; ++i) y0[i] = (y0[i] + y1[i]) * (1.f / Y8_SCALE);
#pragma unroll
                for (int i = 0; i < 8; ++i) y1[i] = 0.f;
                f32x4 r0, r1;
                r0.x = x8[0] + (y0[0] + y1[0]); r0.y = x8[1] + (y0[1] + y1[1]); r0.z = x8[2] + (y0[2] + y1[2]); r0.w = x8[3] + (y0[3] + y1[3]);
                r1.x = x8[4] + (y0[4] + y1[4]); r1.y = x8[5] + (y0[5] + y1[5]); r1.z = x8[6] + (y0[6] + y1[6]); r1.w = x8[7] + (y0[7] + y1[7]);
                *(f32x4*)(p.out + o) = r0; *(f32x4*)(p.out + o + 4) = r1; } } }
    }
}

#define LAS __attribute__((address_space(3)))
#define XB_TMO      128
#define XB_XCNT(j)  (256  + 64 * (j))
#define XB_XSUB(j)  (1280 + 64 * (j))
#define XB_XGEN(j)  (2304 + 64 * (j))
#define XB_TOP      3328
#define XB_TOPGEN   3392
#define XCD_BAR_WORDS 3456
#define XB_SPIN_CAP (1u << 18)

__device__ __forceinline__ unsigned xb_ld(unsigned* p)              { return __hip_atomic_load(p, __ATOMIC_RELAXED, __HIP_MEMORY_SCOPE_AGENT); }
__device__ __forceinline__ unsigned xb_add(unsigned* p, unsigned v) { return __hip_atomic_fetch_add(p, v, __ATOMIC_RELAXED, __HIP_MEMORY_SCOPE_AGENT); }
__device__ __forceinline__ unsigned xb_xcc_id() { return (unsigned)__builtin_amdgcn_s_getreg((3 << 11) | 20) & 0xFu; }
#define XB_SPIN(cond, bar) do { unsigned _sp = 0; while (cond) { __builtin_amdgcn_s_sleep(1); \
    if ((++_sp & 255u) == 0u) { if (xb_ld(&(bar)[XB_TMO])) break; if (_sp > XB_SPIN_CAP) { atomicAdd(&(bar)[XB_TMO], 1u); break; } } } } while (0)

struct XcdBarrier {
    int w0;
    unsigned* bar; unsigned x;
    volatile LAS unsigned* st;
};

__device__ __forceinline__ XcdBarrier xcd_barrier_post(unsigned* bar, volatile LAS unsigned* st) {
    XcdBarrier b; b.bar = bar; b.x = xb_xcc_id(); b.st = st; b.w0 = __builtin_amdgcn_readfirstlane(threadIdx.x >> 6);
    if (threadIdx.x == 0) (void)xb_add(&bar[XB_XCNT(b.x)], 1u);
    return b;
}
__device__ __forceinline__ void xcd_barrier_complete(unsigned* bar, unsigned x, unsigned& nloc, unsigned& nx) {
    const unsigned G = gridDim.x * gridDim.y * gridDim.z;
    unsigned sum, cnt, mine, sp = 0u;
    for (;;) {
        sum = 0u; cnt = 0u; mine = 0u;
#pragma unroll
        for (unsigned j = 0; j < 16; ++j) { const unsigned c = xb_ld(&bar[XB_XCNT(j)]); sum += c; cnt += (c > 0u) ? 1u : 0u; mine = (j == x) ? c : mine; }
        if (sum == G) break;
        __builtin_amdgcn_s_sleep(1);
        if ((++sp & 255u) == 0u) { if (xb_ld(&bar[XB_TMO])) break; if (sp > XB_SPIN_CAP) { atomicAdd(&bar[XB_TMO], 1u); break; } }
    }
    nloc = mine > 0u ? mine : 1u; nx = cnt > 0u ? cnt : 1u;
}

__device__ __forceinline__ void xcd_barrier(const XcdBarrier& b) {
    asm volatile("s_waitcnt vmcnt(0)" ::: "memory");
    __syncthreads();
    if (b.w0 == 0 && my_lane() == 0) {
        unsigned* bar = b.bar;
        __builtin_amdgcn_s_waitcnt(0);
        unsigned nloc = b.st[0], nx = b.st[1];
        if (nloc == 0u) { xcd_barrier_complete(bar, b.x, nloc, nx); b.st[0] = nloc; b.st[1] = nx; }
        const unsigned old = xb_add(&bar[XB_XSUB(b.x)], 1u);
        const unsigned gen = old / nloc;
        if (old + 1u == (gen + 1u) * nloc) {
            __builtin_amdgcn_fence(__ATOMIC_RELEASE, "agent");
            asm volatile("s_waitcnt vmcnt(0)" ::: "memory");
            const unsigned og = xb_add(&bar[XB_TOP], 1u);
            const unsigned tg = og / nx;
            if (og + 1u != (tg + 1u) * nx) XB_SPIN((int)(xb_ld(&bar[XB_TOP]) - (tg + 1u) * nx) < 0, bar);
            __builtin_amdgcn_fence(__ATOMIC_ACQUIRE, "agent");
            xb_add(&bar[XB_XGEN(b.x)], 1u);
            asm volatile("s_waitcnt vmcnt(0)" ::: "memory");
        } else {
            XB_SPIN(xb_ld(&bar[XB_XGEN(b.x)]) == gen, bar);
            __builtin_amdgcn_fence(__ATOMIC_ACQUIRE, "agent");
            asm volatile("s_waitcnt vmcnt(0)" ::: "memory");
        }
    }
    __syncthreads();
}

__device__ __forceinline__ Ctx make_ctx(unsigned char* lds, int wave0) {
    const int tid = (wave0 & 7) * 64 + my_lane();
    Ctx c; c.tid = tid; c.lane = tid & 63; c.wave = wave0 & 7; c.bid = blockIdx.x; c.nb = gridDim.x;
    c.gw = c.bid * NWAVES + c.wave; c.ngw = c.nb * NWAVES; c.lds = lds; return c;
}
template <int PH> __device__ __forceinline__ void run_phase(const Params& p, unsigned char* lds, int wave0) {
    const Ctx c = make_ctx(lds, wave0);
    if constexpr (PH == 0) phase0(p, c);
    if constexpr (PH == 1) phase1_fast(p, c);
    if constexpr (PH == 2) {
        const attn128::bf16* PROJ = (const attn128::bf16*)(p.ws + WS_PROJ);
        const attn128::AttnTensors AT{PROJ + COL_Q, PROJ + COL_K, PROJ + COL_V, (attn128::bf16*)p.out};
        const attn128::StaticOrder S((int)gridDim.x, (int)blockIdx.x);
        struct SideJob { const Params& p; unsigned char* lds; int wave0; bool on;
            __device__ __forceinline__ void operator()() const { if (on) { __syncthreads(); const Ctx c2 = make_ctx(lds, wave0); convert_experts(p, c2); convert_late(p, c2); phase2b<2>(p, c2); __syncthreads(); } } };
        const int mode = EXPERTS_IN_ATTN ? ((S.vcu >> 4) + (S.vcu & 7)) % 3 : 3;
        float lam; { const float d1 = wave_sum(p.lq1[c.lane] * p.lk1[c.lane]), d2 = wave_sum(p.lq2[c.lane] * p.lk2[c.lane]); lam = __builtin_bit_cast(float, __builtin_amdgcn_readfirstlane(__builtin_bit_cast(int, expf(d1) - expf(d2) + LAM_INIT))); }
        SideJob{p, lds, wave0, mode == 0}();
        float gq = fabsf(p.q_norm_g[c.lane]), gk = fabsf(p.k_norm_g[c.lane]);
#pragma unroll
        for (int o = 1; o < 64; o <<= 1) { gq = fmaxf(gq, lane_get(gq, c.lane ^ o)); gk = fmaxf(gk, lane_get(gk, c.lane ^ o)); }
        const bool noref = __builtin_amdgcn_readfirstlane((QSCALE * 64.f * gq * gk <= 80.f) ? 1 : 0) != 0;
        if (noref) attn128::attn_phase<attn128::StaticOrder, SideJob, true>((char*)c.lds, AT, S, SideJob{p, lds, wave0, mode == 1}, p.ws + WS_XN, p.subln_g, lam, (unsigned*)(p.ws + WS_CTL + 12288));
        else       attn128::attn_phase<attn128::StaticOrder, SideJob, false>((char*)c.lds, AT, S, SideJob{p, lds, wave0, mode == 1}, p.ws + WS_XN, p.subln_g, lam, (unsigned*)(p.ws + WS_CTL + 12288));
        SideJob{p, lds, wave0, mode == 2}();
    }
    if constexpr (PH == 4) phase3_fast(p, c);
    if constexpr (PH == 5) phase3b<0>(p, c);
    if constexpr (PH == 6) phase4_fast(p, c);
    if constexpr (PH == 7) phase5_fast(p, c);
    if constexpr (PH == 8) phase6(p, c);
    if constexpr (PH == 9) phase3c(p, c);
}
__global__ void __launch_bounds__(NTHREADS, 2) mega_kernel(Params p) {
    extern __shared__ __attribute__((aligned(16))) unsigned char lds[];
    volatile LAS unsigned* bst = (volatile LAS unsigned*)((LAS unsigned char*)lds + BARST_OFF);
    if (threadIdx.x < 4) bst[threadIdx.x] = 0u;
    __syncthreads();
    const XcdBarrier bar = xcd_barrier_post((unsigned*)(p.ws + WS_BAR), bst);
    const int wave0 = bar.w0;
#define GSYNC() xcd_barrier(bar)
#define PH_(k) run_phase<k>(p, lds, wave0)
    PH_(0); GSYNC();
    PH_(1); GSYNC();
    PH_(2); GSYNC();
    PH_(4); GSYNC();
    PH_(5); GSYNC();
    PH_(6); GSYNC();
    PH_(7); GSYNC();
    PH_(8);
#undef PH_
#undef GSYNC
}

extern "C" void kernel_launch(void* const* d_in, const int* in_sizes, int n_in, void* d_out, int out_size, void* d_ws, size_t ws_size, hipStream_t stream) {
    static int grid = 0;
    if (grid == 0) {
        if (n_in != 19 || in_sizes[0] != T * D || out_size != T * D || ws_size < WS_END) { fprintf(stderr, "kernel_launch: unexpected shapes (n_in %d, in0 %d, out %d, ws %zu)\n", n_in, n_in > 0 ? in_sizes[0] : -1, out_size, ws_size); grid = -1; return; }
        int dev = 0, cus = 0;
        if (hipGetDevice(&dev) != hipSuccess || hipDeviceGetAttribute(&cus, hipDeviceAttributeMultiprocessorCount, dev) != hipSuccess) { grid = -1; return; }
        int per_cu = 0;
        (void)hipFuncSetAttribute((const void*)mega_kernel, hipFuncAttributeMaxDynamicSharedMemorySize, LDS_BYTES);
        if (hipOccupancyMaxActiveBlocksPerMultiprocessor(&per_cu, (const void*)mega_kernel, NTHREADS, LDS_BYTES) != hipSuccess || per_cu < 1) { fprintf(stderr, "kernel_launch: occupancy query failed (%d)\n", per_cu); (void)hipGetLastError(); per_cu = 1; }
        grid = cus;
        if (cus != 256) fprintf(stderr, "kernel_launch: built for 256 CUs (attention deal), device has %d\n", cus);
    }
    if (grid < 0) return;
    Params p{};
    const float** pf = (const float**)&p;
    for (int i = 0; i < 19; ++i) pf[i] = (const float*)d_in[i];
    p.out = (float*)d_out; p.ws = (unsigned char*)d_ws;
    if (hipMemsetAsync((char*)d_ws + WS_CTL, 0, CTL_ZERO_BYTES, stream) != hipSuccess) { fprintf(stderr, "kernel_launch: memset of the control words failed\n"); return; }
    void* args[] = {&p};
    hipError_t e = hipLaunchCooperativeKernel((const void*)mega_kernel, dim3(grid), dim3(NTHREADS), args, LDS_BYTES, stream);
    if (e != hipSuccess) fprintf(stderr, "cooperative launch failed: %s (grid %d)\n", hipGetErrorString(e), grid);
}
```
